# Optimizing an MI355X kernel written in HIP

```python
import math
import jax, jax.numpy as jnp
from jax import lax
import numpy as np

D_MODEL = 1024
BATCH = 4
SEQ = 4096
DEPTH = 1
DEC_BATCH = 128
DEC_SEQ = 8
PAST_LEN = 16384
PAGE_SIZE = 128

GDN_HEADS = 8
GDN_DK = 128
GDN_DV = 128
GDN_QK_DIM = GDN_HEADS * GDN_DK
GDN_V_DIM = GDN_HEADS * GDN_DV
CONV_W = 4
GDN_CHUNK = 64
CONV_DIM = 2 * GDN_QK_DIM + GDN_V_DIM
SWA_Q_HEADS = 16
SWA_KV_HEADS = 4
SWA_GROUP = SWA_Q_HEADS // SWA_KV_HEADS
SWA_HEAD_DIM = 64
WINDOW = 128
ROPE_DIM = SWA_HEAD_DIM // 4
ROPE_THETA = 500000.0
D_FF = 2816
EPS = 1e-6
IN_SPLITS = (CONV_DIM, GDN_V_DIM, GDN_HEADS, GDN_HEADS, SWA_Q_HEADS * SWA_HEAD_DIM,
             SWA_KV_HEADS * SWA_HEAD_DIM, SWA_KV_HEADS * SWA_HEAD_DIM, D_MODEL, D_MODEL)
D_IN = sum(IN_SPLITS)

kernel_name = 'hybrid_gdn_swa_macaron_step'


def rmsnorm(x, w):
    x32 = x.astype(jnp.float32)
    y = x32 * lax.rsqrt(jnp.mean(x32 * x32, axis=-1, keepdims=True) + EPS)
    return (y * w.astype(jnp.float32)).astype(x.dtype)


def l2norm(x):
    x32 = x.astype(jnp.float32)
    return x32 * lax.rsqrt(jnp.sum(x32 * x32, axis=-1, keepdims=True) + EPS)


def swiglu(x, w_in, w_out):
    gate, up = jnp.split(x @ w_in, 2, axis=-1)
    return (jax.nn.silu(gate) * up) @ w_out


def rope_partial(x, pos):
    inv = ROPE_THETA ** (-jnp.arange(0, ROPE_DIM, 2, dtype=jnp.float32) / ROPE_DIM)
    ang = pos.astype(jnp.float32)[:, None] * inv[None, :]
    cos = jnp.cos(ang)[None, :, None, :]
    sin = jnp.sin(ang)[None, :, None, :]
    xr = x[..., :ROPE_DIM].astype(jnp.float32)
    x1, x2 = xr[..., :ROPE_DIM // 2], xr[..., ROPE_DIM // 2:]
    rot = jnp.concatenate([x1 * cos - x2 * sin, x2 * cos + x1 * sin], axis=-1)
    return jnp.concatenate([rot.astype(x.dtype), x[..., ROPE_DIM:]], axis=-1)


def sink_attention(q, k, v, mask, sinks):
    s = jnp.einsum('...qhgd,...khd->...hgqk', q, k, preferred_element_type=jnp.float32)
    s = jnp.where(mask, s * (SWA_HEAD_DIM ** -0.5), -jnp.inf)
    sink = sinks.astype(jnp.float32)[:, :, None, None]
    m = jnp.maximum(jnp.max(s, axis=-1, keepdims=True), sink)
    p = jnp.exp(s - m)
    denom = jnp.sum(p, axis=-1, keepdims=True) + jnp.exp(sink - m)
    return jnp.einsum('...hgqk,...khd->...qhgd', (p / denom).astype(v.dtype), v)


def swa_prompt(q, k, v, sinks):
    B, L, _, D = q.shape
    nb = L // WINDOW
    qb = q.reshape(B, nb, WINDOW, SWA_KV_HEADS, SWA_GROUP, D)

    def with_prev(t):
        t = t.reshape(B, nb, WINDOW, SWA_KV_HEADS, D)
        prev = jnp.pad(t[:, :-1], ((0, 0), (1, 0), (0, 0), (0, 0), (0, 0)))
        return jnp.concatenate([prev, t], axis=2)

    qi = jnp.arange(WINDOW)
    kj = jnp.arange(2 * WINDOW) - WINDOW
    rel = qi[:, None] - kj[None, :]
    band = (rel >= 0) & (rel < WINDOW)
    has_prev = (jnp.arange(nb)[:, None] > 0) | (kj[None, :] >= 0)
    mask = band[None] & has_prev[:, None, :]
    o = sink_attention(qb, with_prev(k), with_prev(v), mask[None, :, None, None], sinks)
    return o.reshape(B, L, SWA_Q_HEADS, D)


def swa_sample(q, k, v, k_buf, v_buf, sinks):
    B, T, _, D = q.shape
    n_rows = k_buf.shape[1]
    kc = jnp.concatenate([k_buf.astype(k.dtype), k], axis=1)
    vc = jnp.concatenate([v_buf.astype(v.dtype), v], axis=1)
    qpos = PAST_LEN + jnp.arange(T)
    kpos = PAST_LEN - n_rows + jnp.arange(n_rows + T)
    rel = qpos[:, None] - kpos[None, :]
    mask = (rel >= 0) & (rel < WINDOW)
    o = sink_attention(q.reshape(B, T, SWA_KV_HEADS, SWA_GROUP, D), kc, vc, mask[None, None, None], sinks)
    return o.reshape(B, T, SWA_Q_HEADS, D), kc[:, -n_rows:], vc[:, -n_rows:]


def gated_delta_rule(q, k, v, g, beta, S0):
    f32 = jnp.float32
    B, L, H, DK = q.shape
    DV = v.shape[-1]
    C = min(GDN_CHUNK, L)
    N = -(-L // C)
    pad = N * C - L

    def blocks(t):
        t = jnp.moveaxis(t.astype(f32), 2, 1)
        t = jnp.pad(t, [(0, 0), (0, 0), (0, pad)] + [(0, 0)] * (t.ndim - 3))
        return t.reshape(t.shape[:2] + (N, C) + t.shape[3:])

    qc = blocks(q) * (DK ** -0.5)
    kc = blocks(k)
    vc = blocks(v)
    gc = jnp.cumsum(blocks(g), axis=-1)
    bc = blocks(beta)
    idx = jnp.arange(C)
    incl = idx[:, None] >= idx[None, :]
    strict = idx[:, None] > idx[None, :]
    decay = jnp.exp(jnp.where(incl, gc[..., :, None] - gc[..., None, :], -jnp.inf))
    kb = kc * bc[..., None]
    vb = vc * bc[..., None]
    A = jnp.where(strict, jnp.einsum('bhnid,bhnjd->bhnij', kb, kc) * decay, 0.0)
    eye = jnp.eye(C, dtype=f32)
    T = lax.linalg.triangular_solve(A + eye, jnp.broadcast_to(eye, A.shape), left_side=True, lower=True)
    u_val = jnp.einsum('bhnij,bhnjv->bhniv', T, vb)
    w_key = jnp.einsum('bhnij,bhnjd->bhnid', T, kb * jnp.exp(gc)[..., None])
    qk = jnp.einsum('bhnid,bhnjd->bhnij', qc, kc) * decay
    qg = qc * jnp.exp(gc)[..., None]
    kg = kc * jnp.exp(gc[..., -1:] - gc)[..., None]
    g_last = jnp.exp(gc[..., -1])

    def step(S, xs):
        qk_i, qg_i, kg_i, u_i, w_i, gl_i = xs
        v_new = u_i - jnp.einsum('bhcd,bhdv->bhcv', w_i, S)
        o = jnp.einsum('bhcd,bhdv->bhcv', qg_i, S) + jnp.einsum('bhij,bhjv->bhiv', qk_i, v_new)
        S = S * gl_i[..., None, None] + jnp.einsum('bhcd,bhcv->bhdv', kg_i, v_new)
        return S, o

    xs = tuple(jnp.moveaxis(t, 2, 0) for t in (qk, qg, kg, u_val, w_key, g_last))
    S, o = lax.scan(step, S0.astype(f32), xs)
    o = jnp.moveaxis(o, 0, 2).reshape(B, H, N * C, DV)[:, :, :L]
    return jnp.moveaxis(o, 1, 2), S


def decoder_layer(x, pos, conv_buf, S0, k_buf, v_buf, p):
    B, L, _ = x.shape
    x = x + 0.5 * swiglu(rmsnorm(x, p['norm_ffn1']), p['w_ffn1_in'], p['w_ffn1_out'])
    u = rmsnorm(x, p['norm_mix']) @ p['w_in']
    qkv_raw, z, a, b, q_s, k_s, v_s, gate_a, gate_b = jnp.split(u, np.cumsum(IN_SPLITS)[:-1].tolist(), axis=-1)
    ext = jnp.concatenate([conv_buf.astype(qkv_raw.dtype), qkv_raw], axis=1)
    new_conv = ext[:, -(CONV_W - 1):]
    conv_w = p['conv_w']
    qkv = jax.nn.silu(sum(conv_w[j] * ext[:, j:j + L] for j in range(CONV_W)))
    q_g, k_g, v_g = jnp.split(qkv, [GDN_QK_DIM, 2 * GDN_QK_DIM], axis=-1)
    q_g = l2norm(q_g.reshape(B, L, GDN_HEADS, GDN_DK))
    k_g = l2norm(k_g.reshape(B, L, GDN_HEADS, GDN_DK))
    v_g = v_g.reshape(B, L, GDN_HEADS, GDN_DV)
    g = -jnp.exp(p['gdn_a_log'].astype(jnp.float32)) * jax.nn.softplus(
        a.astype(jnp.float32) + p['gdn_dt_bias'].astype(jnp.float32))
    beta = jax.nn.sigmoid(b.astype(jnp.float32))
    o_g, new_S = gated_delta_rule(q_g, k_g, v_g, g, beta, S0)
    o_g = rmsnorm(o_g.astype(x.dtype), p['gdn_norm']) * jax.nn.silu(z.reshape(B, L, GDN_HEADS, GDN_DV))
    o_g = o_g.reshape(B, L, GDN_V_DIM)
    q_s = rope_partial(q_s.reshape(B, L, SWA_Q_HEADS, SWA_HEAD_DIM), pos)
    k_s = rope_partial(k_s.reshape(B, L, SWA_KV_HEADS, SWA_HEAD_DIM), pos)
    v_s = v_s.reshape(B, L, SWA_KV_HEADS, SWA_HEAD_DIM)
    sinks = p['swa_sinks'].reshape(SWA_KV_HEADS, SWA_GROUP)
    if k_buf is None:
        o_s = swa_prompt(q_s, k_s, v_s, sinks)
        n_keep = min(WINDOW, L)
        new_k, new_v = k_s[:, -n_keep:], v_s[:, -n_keep:]
    else:
        o_s, new_k, new_v = swa_sample(q_s, k_s, v_s, k_buf, v_buf, sinks)
    o_s = o_s.reshape(B, L, SWA_Q_HEADS * SWA_HEAD_DIM)
    mixed = jax.nn.sigmoid(gate_a) * o_g + jax.nn.sigmoid(gate_b) * o_s
    x = x + mixed @ p['w_out']
    x = x + 0.5 * swiglu(rmsnorm(x, p['norm_ffn2']), p['w_ffn2_in'], p['w_ffn2_out'])
    return x, new_conv, new_S, new_k, new_v


def setup_inputs(seed: int = 0) -> dict:
    key = jax.random.key(seed)
    ks = jax.random.split(key, 24)
    f32 = jnp.float32

    def nrm(k, shape, scale):
        return jax.random.normal(k, shape, f32) * scale

    def gain(k, shape):
        return 1.0 + 0.05 * jax.random.normal(k, shape, f32)

    n_rows = min(WINDOW, PAST_LEN)
    dt = jnp.exp(jax.random.uniform(ks[20], (DEPTH, GDN_HEADS), f32, math.log(1e-3), math.log(1e-1)))
    dt_bias = dt + jnp.log(-jnp.expm1(-dt))
    a_log = jnp.log(jax.random.uniform(ks[21], (DEPTH, GDN_HEADS), f32, 1.0, 16.0))
    return {
        'x_prompt': nrm(ks[0], (BATCH, SEQ, D_MODEL), 1.0),
        'x_sample': nrm(ks[1], (DEC_BATCH, DEC_SEQ, D_MODEL), 1.0),
        'state_conv': nrm(ks[2], (DEPTH, DEC_BATCH, CONV_W - 1, CONV_DIM), 1.0),
        'state_gdn': nrm(ks[3], (DEPTH, DEC_BATCH, GDN_HEADS, GDN_DK, GDN_DV), 0.1),
        'cache_swa_k': nrm(ks[4], (DEPTH, DEC_BATCH, n_rows, SWA_KV_HEADS, SWA_HEAD_DIM), 1.0),
        'cache_swa_v': nrm(ks[5], (DEPTH, DEC_BATCH, n_rows, SWA_KV_HEADS, SWA_HEAD_DIM), 1.0),
        'norm_ffn1': gain(ks[6], (DEPTH, D_MODEL)),
        'w_ffn1_in': nrm(ks[7], (DEPTH, D_MODEL, 2 * D_FF), D_MODEL ** -0.5),
        'w_ffn1_out': nrm(ks[8], (DEPTH, D_FF, D_MODEL), D_FF ** -0.5),
        'norm_mix': gain(ks[9], (DEPTH, D_MODEL)),
        'w_in': nrm(ks[10], (DEPTH, D_MODEL, D_IN), D_MODEL ** -0.5),
        'conv_w': nrm(ks[11], (DEPTH, CONV_W, CONV_DIM), CONV_W ** -0.5),
        'gdn_a_log': a_log,
        'gdn_dt_bias': dt_bias,
        'gdn_norm': gain(ks[12], (DEPTH, GDN_DV)),
        'swa_sinks': nrm(ks[13], (DEPTH, SWA_Q_HEADS), 0.5),
        'w_out': nrm(ks[14], (DEPTH, D_MODEL, D_MODEL), D_MODEL ** -0.5),
        'norm_ffn2': gain(ks[15], (DEPTH, D_MODEL)),
        'w_ffn2_in': nrm(ks[16], (DEPTH, D_MODEL, 2 * D_FF), D_MODEL ** -0.5),
        'w_ffn2_out': nrm(ks[17], (DEPTH, D_FF, D_MODEL), D_FF ** -0.5),
        'norm_final': gain(ks[18], (D_MODEL,)),
    }


def reference(x_prompt, x_sample, state_conv, state_gdn, cache_swa_k, cache_swa_v,
              norm_ffn1, w_ffn1_in, w_ffn1_out, norm_mix, w_in, conv_w, gdn_a_log, gdn_dt_bias,
              gdn_norm, swa_sinks, w_out, norm_ffn2, w_ffn2_in, w_ffn2_out, norm_final):
    xp, xs = x_prompt, x_sample
    B, L, _ = xp.shape
    pos_p = jnp.arange(L, dtype=jnp.int32)
    pos_s = PAST_LEN + jnp.arange(xs.shape[1], dtype=jnp.int32)
    conv_p, conv_s, gdn_p, gdn_s, k_p, k_s, v_p, v_s = [], [], [], [], [], [], [], []
    for l in range(DEPTH):
        p = {'norm_ffn1': norm_ffn1[l], 'w_ffn1_in': w_ffn1_in[l], 'w_ffn1_out': w_ffn1_out[l],
             'norm_mix': norm_mix[l], 'w_in': w_in[l], 'conv_w': conv_w[l],
             'gdn_a_log': gdn_a_log[l], 'gdn_dt_bias': gdn_dt_bias[l], 'gdn_norm': gdn_norm[l],
             'swa_sinks': swa_sinks[l], 'w_out': w_out[l], 'norm_ffn2': norm_ffn2[l],
             'w_ffn2_in': w_ffn2_in[l], 'w_ffn2_out': w_ffn2_out[l]}
        zero_conv = jnp.zeros((B, CONV_W - 1, CONV_DIM), xp.dtype)
        zero_S = jnp.zeros((B, GDN_HEADS, GDN_DK, GDN_DV), jnp.float32)
        xp, c1, s1, k1, v1 = decoder_layer(xp, pos_p, zero_conv, zero_S, None, None, p)
        xs, c2, s2, k2, v2 = decoder_layer(xs, pos_s, state_conv[l], state_gdn[l],
                                           cache_swa_k[l], cache_swa_v[l], p)
        conv_p.append(c1); conv_s.append(c2)
        gdn_p.append(s1); gdn_s.append(s2)
        k_p.append(k1); k_s.append(k2)
        v_p.append(v1); v_s.append(v2)
    y_prompt = rmsnorm(xp, norm_final)
    y_sample = rmsnorm(xs, norm_final)
    return (y_prompt, y_sample,
            jnp.stack(conv_p), jnp.stack(conv_s),
            jnp.stack(gdn_p), jnp.stack(gdn_s),
            jnp.stack(k_p), jnp.stack(k_s),
            jnp.stack(v_p), jnp.stack(v_s))
```

```cpp
#ifndef CPU_EMU
#include <hip/hip_runtime.h>
#endif
#include <cmath>
#include <cstdint>
#include <cstddef>

#ifndef CFG_D_MODEL
#define CFG_D_MODEL 1024
#define CFG_BATCH 4
#define CFG_SEQ 4096
#define CFG_DEC_BATCH 128
#define CFG_DEC_SEQ 8
#define CFG_D_FF 2816
#endif
namespace cfg {
constexpr int D = CFG_D_MODEL, BATCH = CFG_BATCH, SEQ = CFG_SEQ, DB = CFG_DEC_BATCH, DS = CFG_DEC_SEQ, FF = CFG_D_FF;
constexpr int PAST = 16384;
constexpr int MP = BATCH * SEQ, MS = DB * DS, M = MP + MS;
constexpr int H = 8, DK = 128, DV = 128, CONV = 3072, QH = 16, KVH = 4, HD = 64, WIN = 128;
constexpr int DIN = 3072 + 1024 + 16 + 1024 + 256 + 256 + 2 * D;
constexpr int U_RAW = 0, U_Z = 3072, U_A = 4096, U_B = 4104, U_QS = 4112, U_KS = 5136, U_VS = 5392, U_GA = 5648, U_GB = 5648 + D;
constexpr float EPS = 1e-6f;
constexpr size_t O_YP = 0, O_YS = O_YP + (size_t)MP * D, O_CP = O_YS + (size_t)MS * D, O_CS = O_CP + (size_t)BATCH * 3 * CONV,
                 O_GP = O_CS + (size_t)DB * 3 * CONV, O_GS = O_GP + (size_t)BATCH * H * DK * DV, O_KP = O_GS + (size_t)DB * H * DK * DV,
                 O_KS = O_KP + (size_t)BATCH * WIN * KVH * HD, O_VP = O_KS + (size_t)DB * WIN * KVH * HD,
                 O_VS = O_VP + (size_t)BATCH * WIN * KVH * HD, O_END = O_VS + (size_t)DB * WIN * KVH * HD;
}

#ifdef CPU_EMU
#define HDI inline
template <class K, class... A> void nv_launch(long n, A... a) { for (long g = 0; g < n; ++g) K::run(g, a...); }
#define NV_LAUNCH(K, n, ...) nv_launch<K>((long)(n), __VA_ARGS__)
#else
#define HDI __device__ __forceinline__
template <class K, class... A> __global__ void __launch_bounds__(256) nv_kernel(long n, A... a) {
    for (long g = (long)blockIdx.x * blockDim.x + threadIdx.x; g < n; g += (long)gridDim.x * blockDim.x) K::run(g, a...);
}
#define NV_LAUNCH(K, n, ...) do { long _n = (long)(n); long _b = (_n + 255) / 256; if (_b > 65536 * 4) _b = 65536 * 4; if (_b < 1) _b = 1; \
    nv_kernel<K><<<dim3((unsigned)_b), dim3(256), 0, stream>>>(_n, __VA_ARGS__); } while (0)
#endif

namespace nv {
using namespace cfg;
HDI float silu_f(float x) { return x / (1.0f + expf(-x)); }
HDI float sigmoid_f(float x) { return 1.0f / (1.0f + expf(-x)); }
HDI float softplus_f(float x) { return x > 20.f ? x : log1pf(expf(x)); }

struct Concat {
    static HDI void run(long g, const float* xp, const float* xs, float* X) {
        X[g] = g < (long)MP * D ? xp[g] : xs[g - (long)MP * D];
    }
};
struct Rmsnorm {
    static HDI void run(long r, const float* x, const float* w, float* out, int ncol) {
        const float* xr = x + r * ncol; float s = 0.f;
        for (int c = 0; c < ncol; ++c) s += xr[c] * xr[c];
        const float rs = 1.0f / sqrtf(s / (float)ncol + EPS);
        for (int c = 0; c < ncol; ++c) out[r * ncol + c] = xr[c] * rs * w[c];
    }
};
struct Gemm {
    static HDI void run(long g, const float* A, int lda, const float* B, int ldb, float* C, int ldc, int N, int K) {
        const int nq = N / 4; const long mi = g / nq; const int ni = (int)(g % nq);
        float acc[4][4];
#pragma unroll
        for (int i = 0; i < 4; ++i)
#pragma unroll
            for (int j = 0; j < 4; ++j) acc[i][j] = 0.f;
        const float* a0 = A + (mi * 4) * lda; const float* bp = B + ni * 4;
        for (int k = 0; k < K; ++k) {
            const float b0 = bp[(long)k * ldb], b1 = bp[(long)k * ldb + 1], b2 = bp[(long)k * ldb + 2], b3 = bp[(long)k * ldb + 3];
#pragma unroll
            for (int i = 0; i < 4; ++i) { const float a = a0[(long)i * lda + k]; acc[i][0] += a * b0; acc[i][1] += a * b1; acc[i][2] += a * b2; acc[i][3] += a * b3; }
        }
#pragma unroll
        for (int i = 0; i < 4; ++i)
#pragma unroll
            for (int j = 0; j < 4; ++j) C[(mi * 4 + i) * ldc + ni * 4 + j] = acc[i][j];
    }
};
struct GemmSwiglu {
    static HDI void run(long g, const float* A, const float* B, float* Hh, int K) {
        const int nq = FF / 4; const long mi = g / nq; const int ni = (int)(g % nq);
        float ag[4][4], au[4][4];
#pragma unroll
        for (int i = 0; i < 4; ++i)
#pragma unroll
            for (int j = 0; j < 4; ++j) { ag[i][j] = 0.f; au[i][j] = 0.f; }
        const float* a0 = A + (mi * 4) * K; const float* bp = B + ni * 4;
        for (int k = 0; k < K; ++k) {
            float bg[4], bu[4];
#pragma unroll
            for (int j = 0; j < 4; ++j) { bg[j] = bp[(long)k * 2 * FF + j]; bu[j] = bp[(long)k * 2 * FF + FF + j]; }
#pragma unroll
            for (int i = 0; i < 4; ++i) { const float a = a0[(long)i * K + k];
#pragma unroll
                for (int j = 0; j < 4; ++j) { ag[i][j] += a * bg[j]; au[i][j] += a * bu[j]; } }
        }
#pragma unroll
        for (int i = 0; i < 4; ++i)
#pragma unroll
            for (int j = 0; j < 4; ++j) Hh[(mi * 4 + i) * FF + ni * 4 + j] = silu_f(ag[i][j]) * au[i][j];
    }
};
struct Axpy {
    static HDI void run(long g, const float* a, const float* b, float alpha, float* out) { out[g] = a[g] + alpha * b[g]; }
};
HDI void row_info(long r, int& is_s, int& seq, int& t, int& L, long& base) {
    if (r < MP) { is_s = 0; seq = (int)(r / SEQ); t = (int)(r % SEQ); L = SEQ; base = (long)seq * SEQ; }
    else { const long rr = r - MP; is_s = 1; seq = (int)(rr / DS); t = (int)(rr % DS); L = DS; base = MP + (long)seq * DS; }
}
struct ConvInPlace {
    static HDI void run(long g, float* U1, const float* state_conv, const float* conv_w) {
        const int c = (int)(g % CONV); const int sq = (int)(g / CONV);
        const int is_s = sq >= BATCH; const int seq = is_s ? sq - BATCH : sq; const int L = is_s ? DS : SEQ;
        const long base = is_s ? MP + (long)seq * DS : (long)seq * SEQ;
        const float w0 = conv_w[0 * CONV + c], w1 = conv_w[1 * CONV + c], w2 = conv_w[2 * CONV + c], w3 = conv_w[3 * CONV + c];
        float e0 = is_s ? state_conv[((long)seq * 3 + 0) * CONV + c] : 0.f;
        float e1 = is_s ? state_conv[((long)seq * 3 + 1) * CONV + c] : 0.f;
        float e2 = is_s ? state_conv[((long)seq * 3 + 2) * CONV + c] : 0.f;
        for (int t = 0; t < L; ++t) {
            const float e3 = U1[(base + t) * CONV + c];
            U1[(base + t) * CONV + c] = silu_f(w0 * e0 + w1 * e1 + w2 * e2 + w3 * e3);
            e0 = e1; e1 = e2; e2 = e3;
        }
    }
};
struct L2norm {
    static HDI void run(long g, float* QKV) {
        const long r = g / 16; const int hh = (int)(g % 16);
        float* p = QKV + r * CONV + hh * 128; float s = 0.f;
        for (int j = 0; j < 128; ++j) s += p[j] * p[j];
        const float rs = 1.0f / sqrtf(s + EPS);
        for (int j = 0; j < 128; ++j) p[j] *= rs;
    }
};
constexpr int W2 = 2576, C2_Z = 0, C2_A = 1024, C2_B = 1032, C2_QS = 1040, C2_KS = 2064, C2_VS = 2320;
struct Gdn {
    static HDI void run(long g, const float* U2, const float* QKV, const float* state_gdn, const float* a_log, const float* dt_bias,
                        float* OG, float* out_gp, float* out_gs) {
        const int dv = (int)(g % DV); const int h = (int)((g / DV) % H); const int sq = (int)(g / (DV * H));
        const int is_s = sq >= BATCH; const int seq = is_s ? sq - BATCH : sq; const int L = is_s ? DS : SEQ;
        const long base = is_s ? MP + (long)seq * DS : (long)seq * SEQ;
        float S[DK];
#pragma unroll
        for (int j = 0; j < DK; ++j) S[j] = is_s ? state_gdn[(((long)seq * H + h) * DK + j) * DV + dv] : 0.f;
        const float ea = expf(a_log[h]), dtb = dt_bias[h];
        for (int t = 0; t < L; ++t) {
            const long r = base + t;
            const float a = U2[r * W2 + C2_A + h], b = U2[r * W2 + C2_B + h];
            const float gg = -ea * softplus_f(a + dtb), beta = sigmoid_f(b), alpha = expf(gg);
            const float* q = QKV + r * CONV + h * DK; const float* k = QKV + r * CONV + 1024 + h * DK;
            const float v = QKV[r * CONV + 2048 + h * DV + dv];
            float ks = 0.f;
#pragma unroll
            for (int j = 0; j < DK; ++j) ks += k[j] * S[j];
            const float vn = beta * (v - alpha * ks);
            float o = 0.f;
#pragma unroll
            for (int j = 0; j < DK; ++j) { S[j] = alpha * S[j] + k[j] * vn; o += q[j] * S[j]; }
            OG[r * 1024 + h * DV + dv] = o * 0.08838834764831845f;
        }
        float* so = is_s ? out_gs : out_gp;
#pragma unroll
        for (int j = 0; j < DK; ++j) so[(((long)seq * H + h) * DK + j) * DV + dv] = S[j];
    }
};
struct Rope {
    static HDI void run(long g, float* U2) {
        const int i = (int)(g % 8); const int hh = (int)((g / 8) % 20); const long r = g / 160;
        int is_s, seq, t, L; long base; row_info(r, is_s, seq, t, L, base);
        const float pos = (float)(is_s ? PAST + t : t);
        const float inv = powf(500000.0f, -(float)(2 * i) / 16.0f);
        const float ang = pos * inv; const float cs = cosf(ang), sn = sinf(ang);
        float* p = U2 + r * W2 + (hh < 16 ? C2_QS + hh * 64 : C2_KS + (hh - 16) * 64);
        const float x1 = p[i], x2 = p[i + 8];
        p[i] = x1 * cs - x2 * sn; p[i + 8] = x2 * cs + x1 * sn;
    }
};
struct SwaPrompt {
    static HDI void run(long g, const float* U2, const float* sinks, float* OS) {
        const int qh = (int)(g % QH); const long r = g / QH; const int b = (int)(r / SEQ), t = (int)(r % SEQ); const int kvh = qh / 4;
        float q[HD], o[HD];
#pragma unroll
        for (int d = 0; d < HD; ++d) { q[d] = U2[r * W2 + C2_QS + qh * HD + d]; o[d] = 0.f; }
        float m = sinks[qh], l = 1.0f;
        const int j0 = t - (WIN - 1) < 0 ? 0 : t - (WIN - 1);
        for (int j = j0; j <= t; ++j) {
            const long rk = (long)b * SEQ + j; const float* kp = U2 + rk * W2 + C2_KS + kvh * HD; const float* vp = U2 + rk * W2 + C2_VS + kvh * HD;
            float s = 0.f;
#pragma unroll
            for (int d = 0; d < HD; ++d) s += q[d] * kp[d];
            s *= 0.125f;
            const float mn = fmaxf(m, s), sc = expf(m - mn), p = expf(s - mn);
            l = l * sc + p;
#pragma unroll
            for (int d = 0; d < HD; ++d) o[d] = o[d] * sc + p * vp[d];
            m = mn;
        }
        const float il = 1.0f / l;
#pragma unroll
        for (int d = 0; d < HD; ++d) OS[r * 1024 + qh * HD + d] = o[d] * il;
    }
};
struct SwaSample {
    static HDI void run(long g, const float* U2, const float* ck, const float* cv, const float* sinks, float* OS) {
        const int qh = (int)(g % QH); const long rr = g / QH; const int b = (int)(rr / DS), t = (int)(rr % DS); const int kvh = qh / 4;
        const long r = MP + rr;
        float q[HD], o[HD];
#pragma unroll
        for (int d = 0; d < HD; ++d) { q[d] = U2[r * W2 + C2_QS + qh * HD + d]; o[d] = 0.f; }
        float m = sinks[qh], l = 1.0f;
        for (int j = t + 1; j < WIN + t + 1; ++j) {
            const float *kp, *vp;
            if (j < WIN) { kp = ck + (((long)b * WIN + j) * KVH + kvh) * HD; vp = cv + (((long)b * WIN + j) * KVH + kvh) * HD; }
            else { const long rk = MP + (long)b * DS + (j - WIN); kp = U2 + rk * W2 + C2_KS + kvh * HD; vp = U2 + rk * W2 + C2_VS + kvh * HD; }
            float s = 0.f;
#pragma unroll
            for (int d = 0; d < HD; ++d) s += q[d] * kp[d];
            s *= 0.125f;
            const float mn = fmaxf(m, s), sc = expf(m - mn), p = expf(s - mn);
            l = l * sc + p;
#pragma unroll
            for (int d = 0; d < HD; ++d) o[d] = o[d] * sc + p * vp[d];
            m = mn;
        }
        const float il = 1.0f / l;
#pragma unroll
        for (int d = 0; d < HD; ++d) OS[r * 1024 + qh * HD + d] = o[d] * il;
    }
};
struct Mix {
    static HDI void run(long g, const float* U2, const float* GATES, float* OG, const float* OS, const float* gdn_norm) {
        const int h = (int)(g % H); const long r = g / H;
        float* og = OG + r * 1024 + h * DV; float s = 0.f;
        for (int j = 0; j < DV; ++j) s += og[j] * og[j];
        const float rs = 1.0f / sqrtf(s / (float)DV + EPS);
        for (int j = 0; j < DV; ++j) {
            const int c = h * DV + j;
            const float z = U2[r * W2 + C2_Z + c], ga = GATES[r * 2 * D + c], gb = GATES[r * 2 * D + D + c];
            og[j] = sigmoid_f(ga) * (og[j] * rs * gdn_norm[j] * silu_f(z)) + sigmoid_f(gb) * OS[r * 1024 + c];
        }
    }
};
struct OutConv {
    static HDI void run(long g, const float* U1, float* out_cp, float* out_cs) {
        const int c = (int)(g % CONV); const int i = (int)((g / CONV) % 3); const int sq = (int)(g / (3 * CONV));
        const int is_s = sq >= BATCH; const int seq = is_s ? sq - BATCH : sq; const int L = is_s ? DS : SEQ;
        const long base = is_s ? MP + (long)seq * DS : (long)seq * SEQ;
        const float v = U1[(base + L - 3 + i) * CONV + c];
        (is_s ? out_cs : out_cp)[((long)seq * 3 + i) * CONV + c] = v;
    }
};
struct OutKV {
    static HDI void run(long g, const float* U2, const float* ck, const float* cv, float* out_kp, float* out_ks, float* out_vp, float* out_vs) {
        const int c = (int)(g % 256); const int j = (int)((g / 256) % WIN); const int sq = (int)(g / (256 * WIN));
        if (sq < BATCH) {
            const long r = (long)sq * SEQ + SEQ - WIN + j;
            out_kp[((long)sq * WIN + j) * 256 + c] = U2[r * W2 + C2_KS + c]; out_vp[((long)sq * WIN + j) * 256 + c] = U2[r * W2 + C2_VS + c];
        } else {
            const int b = sq - BATCH; float kv, vv;
            if (j + DS < WIN) { kv = ck[((long)b * WIN + j + DS) * 256 + c]; vv = cv[((long)b * WIN + j + DS) * 256 + c]; }
            else { const long r = MP + (long)b * DS + (j + DS - WIN); kv = U2[r * W2 + C2_KS + c]; vv = U2[r * W2 + C2_VS + c]; }
            out_ks[((long)b * WIN + j) * 256 + c] = kv; out_vs[((long)b * WIN + j) * 256 + c] = vv;
        }
    }
};
}

#ifdef CPU_EMU
typedef int hipStream_t;
#endif

extern "C" void kernel_launch(void* const* d_in, const int* in_sizes, int n_in, void* d_out, int out_size, void* d_ws, size_t ws_size, hipStream_t stream) {
    using namespace cfg; using namespace nv;
    const float* x_prompt = (const float*)d_in[0]; const float* x_sample = (const float*)d_in[1]; const float* state_conv = (const float*)d_in[2];
    const float* state_gdn = (const float*)d_in[3]; const float* cache_k = (const float*)d_in[4]; const float* cache_v = (const float*)d_in[5];
    const float* norm_ffn1 = (const float*)d_in[6]; const float* w_ffn1_in = (const float*)d_in[7]; const float* w_ffn1_out = (const float*)d_in[8];
    const float* norm_mix = (const float*)d_in[9]; const float* w_in = (const float*)d_in[10]; const float* conv_w = (const float*)d_in[11];
    const float* a_log = (const float*)d_in[12]; const float* dt_bias = (const float*)d_in[13]; const float* gdn_norm = (const float*)d_in[14];
    const float* sinks = (const float*)d_in[15]; const float* w_out = (const float*)d_in[16]; const float* norm_ffn2 = (const float*)d_in[17];
    const float* w_ffn2_in = (const float*)d_in[18]; const float* w_ffn2_out = (const float*)d_in[19]; const float* norm_final = (const float*)d_in[20];
    float* out = (float*)d_out;
    float* ws = (float*)d_ws; size_t off = 0;
    auto take = [&](size_t n) { float* p = ws + off; off += (n + 63) / 64 * 64; return p; };
    float* X = take((size_t)M * D);
    float* XN = take((size_t)M * D);
    float* U1 = take((size_t)M * CONV);
    float* HB = take((size_t)M * FF > (size_t)M * W2 ? (size_t)M * FF : (size_t)M * W2);
    float* OG = take((size_t)M * 1024);
    float* OS = take((size_t)M * 1024);
    float* T1 = XN; float* U2 = HB; float* GATES = U1;
    static_assert(2 * D <= CONV, "gates fit in the raw-qkv buffer");
    (void)off; (void)in_sizes; (void)n_in; (void)out_size; (void)ws_size;

    NV_LAUNCH(Concat, (long)M * D, x_prompt, x_sample, X);
    NV_LAUNCH(Rmsnorm, M, (const float*)X, norm_ffn1, XN, D);
    NV_LAUNCH(GemmSwiglu, (long)(M / 4) * (FF / 4), (const float*)XN, w_ffn1_in, HB, D);
    NV_LAUNCH(Gemm, (long)(M / 4) * (D / 4), (const float*)HB, FF, w_ffn1_out, D, T1, D, D, FF);
    NV_LAUNCH(Axpy, (long)M * D, (const float*)X, (const float*)T1, 0.5f, X);
    NV_LAUNCH(Rmsnorm, M, (const float*)X, norm_mix, XN, D);
    NV_LAUNCH(Gemm, (long)(M / 4) * (CONV / 4), (const float*)XN, D, w_in + U_RAW, DIN, U1, CONV, CONV, D);
    NV_LAUNCH(Gemm, (long)(M / 4) * (W2 / 4), (const float*)XN, D, w_in + U_Z, DIN, U2, W2, W2, D);
    NV_LAUNCH(OutConv, (long)(BATCH + DB) * 3 * CONV, (const float*)U1, out + O_CP, out + O_CS);
    NV_LAUNCH(ConvInPlace, (long)(BATCH + DB) * CONV, U1, state_conv, conv_w);
    NV_LAUNCH(L2norm, (long)M * 16, U1);
    NV_LAUNCH(Gdn, (long)(BATCH + DB) * H * DV, (const float*)U2, (const float*)U1, state_gdn, a_log, dt_bias, OG, out + O_GP, out + O_GS);
    NV_LAUNCH(Rope, (long)M * 160, U2);
    NV_LAUNCH(OutKV, (long)(BATCH + DB) * WIN * 256, (const float*)U2, cache_k, cache_v, out + O_KP, out + O_KS, out + O_VP, out + O_VS);
    NV_LAUNCH(SwaPrompt, (long)MP * QH, (const float*)U2, sinks, OS);
    NV_LAUNCH(SwaSample, (long)MS * QH, (const float*)U2, cache_k, cache_v, sinks, OS);
    NV_LAUNCH(Gemm, (long)(M / 4) * (2 * D / 4), (const float*)XN, D, w_in + U_GA, DIN, GATES, 2 * D, 2 * D, D);
    NV_LAUNCH(Mix, (long)M * H, (const float*)U2, (const float*)GATES, OG, (const float*)OS, gdn_norm);
    NV_LAUNCH(Gemm, (long)(M / 4) * (D / 4), (const float*)OG, 1024, w_out, D, T1, D, D, 1024);
    NV_LAUNCH(Axpy, (long)M * D, (const float*)X, (const float*)T1, 1.0f, X);
    NV_LAUNCH(Rmsnorm, M, (const float*)X, norm_ffn2, XN, D);
    NV_LAUNCH(GemmSwiglu, (long)(M / 4) * (FF / 4), (const float*)XN, w_ffn2_in, HB, D);
    NV_LAUNCH(Gemm, (long)(M / 4) * (D / 4), (const float*)HB, FF, w_ffn2_out, D, T1, D, D, FF);
    NV_LAUNCH(Axpy, (long)M * D, (const float*)X, (const float*)T1, 0.5f, X);
    NV_LAUNCH(Rmsnorm, M, (const float*)X, norm_final, out + O_YP, D);
}
```

```cpp
#ifndef CPU_EMU
#include <hip/hip_runtime.h>
#endif
#include <cmath>
#include <cstdint>
#include <cstddef>

#ifndef CFG_D_MODEL
#define CFG_D_MODEL 1024
#define CFG_BATCH 4
#define CFG_SEQ 4096
#define CFG_DEC_BATCH 128
#define CFG_DEC_SEQ 8
#define CFG_D_FF 2816
#endif
namespace cfg {
constexpr int D = CFG_D_MODEL, BATCH = CFG_BATCH, SEQ = CFG_SEQ, DB = CFG_DEC_BATCH, DS = CFG_DEC_SEQ, FF = CFG_D_FF;
constexpr int PAST = 16384;
constexpr int MP = BATCH * SEQ, MS = DB * DS, M = MP + MS;
constexpr int H = 8, DK = 128, DV = 128, CONV = 3072, QH = 16, KVH = 4, HD = 64, WIN = 128;
constexpr int DIN = 3072 + 1024 + 16 + 1024 + 256 + 256 + 2 * D;
constexpr int U_RAW = 0, U_Z = 3072, U_A = 4096, U_B = 4104, U_QS = 4112, U_KS = 5136, U_VS = 5392, U_GA = 5648, U_GB = 5648 + D;
constexpr float EPS = 1e-6f;
constexpr size_t O_YP = 0, O_YS = O_YP + (size_t)MP * D, O_CP = O_YS + (size_t)MS * D, O_CS = O_CP + (size_t)BATCH * 3 * CONV,
                 O_GP = O_CS + (size_t)DB * 3 * CONV, O_GS = O_GP + (size_t)BATCH * H * DK * DV, O_KP = O_GS + (size_t)DB * H * DK * DV,
                 O_KS = O_KP + (size_t)BATCH * WIN * KVH * HD, O_VP = O_KS + (size_t)DB * WIN * KVH * HD,
                 O_VS = O_VP + (size_t)BATCH * WIN * KVH * HD, O_END = O_VS + (size_t)DB * WIN * KVH * HD;
}

#ifdef CPU_EMU
#define HDI inline
template <class K, class... A> void nv_launch(long n, A... a) { for (long g = 0; g < n; ++g) K::run(g, a...); }
#define NV_LAUNCH(K, n, ...) nv_launch<K>((long)(n), __VA_ARGS__)
#else
#define HDI __device__ __forceinline__
template <class K, class... A> __global__ void __launch_bounds__(256) nv_kernel(long n, A... a) {
    for (long g = (long)blockIdx.x * blockDim.x + threadIdx.x; g < n; g += (long)gridDim.x * blockDim.x) K::run(g, a...);
}
#define NV_LAUNCH(K, n, ...) do { long _n = (long)(n); long _b = (_n + 255) / 256; if (_b > 65536 * 4) _b = 65536 * 4; if (_b < 1) _b = 1; \
    nv_kernel<K><<<dim3((unsigned)_b), dim3(256), 0, stream>>>(_n, __VA_ARGS__); } while (0)
#endif

typedef unsigned short bf16_t;
namespace lay {
using namespace cfg;
constexpr size_t MiB = (size_t)1 << 20;
constexpr size_t WS_CTL = 0, WS_W1IN = 1 * MiB, WS_W1OUT = 12 * MiB, WS_WIN = 18 * MiB, WS_WAB = 33 * MiB, WS_WOUT = 34 * MiB, WS_W2IN = 36 * MiB, WS_W2OUT = 47 * MiB;
constexpr size_t WS_SSQ1 = 53 * MiB, WS_SSQ2 = 55 * MiB, WS_SSQ3 = 57 * MiB, WS_AB = 59 * MiB;
constexpr size_t WS_XN1 = 62 * MiB, WS_X2B = WS_XN1, WS_X1B = 96 * MiB, WS_X1 = 130 * MiB, WS_RAW = 198 * MiB, WS_Z = 300 * MiB, WS_QS = 334 * MiB, WS_OS = WS_QS;
constexpr size_t WS_KS = 368 * MiB, WS_VS = 377 * MiB, WS_GA = 386 * MiB, WS_MIXED = WS_GA, WS_GB = 420 * MiB, WS_OG = 454 * MiB, WS_HB = 488 * MiB, WS_PREP = WS_HB, WS_END = 632 * MiB;
constexpr size_t WS_T1 = WS_RAW;
static_assert((size_t)M * D * 2 <= 34 * MiB && (size_t)M * D * 4 <= 68 * MiB && (size_t)M * CONV * 2 <= 102 * MiB && (size_t)M * FF * 2 <= 144 * MiB && (size_t)M * 256 * 2 <= 9 * MiB && (size_t)M * 16 * 4 <= 2 * MiB, "layout");
}
namespace nv {
using namespace cfg;
HDI float bf2f(bf16_t v) { union { unsigned u; float f; } c; c.u = (unsigned)v << 16; return c.f; }
HDI bf16_t f2bf(float f) { union { unsigned u; float f; } c; c.f = f; return (bf16_t)((c.u + 0x7fffu + ((c.u >> 16) & 1u)) >> 16); }
HDI float ld(const float* p) { return *p; }
HDI float ld(const bf16_t* p) { return bf2f(*p); }
HDI void st(float* p, float v) { *p = v; }
HDI void st(bf16_t* p, float v) { *p = f2bf(v); }
HDI float silu_f(float x) { return x / (1.0f + expf(-x)); }
HDI float sigmoid_f(float x) { return 1.0f / (1.0f + expf(-x)); }
HDI float softplus_f(float x) { return x > 20.f ? x : log1pf(expf(x)); }
HDI const float* xrow(const float* xp, const float* xs, long r) { return r < MP ? xp + r * D : xs + (r - MP) * D; }

struct RmsnormIn {
    static HDI void run(long r, const float* xp, const float* xs, const float* w, bf16_t* out) {
        const float* xr = xrow(xp, xs, r); float s = 0.f;
        for (int c = 0; c < D; ++c) s += xr[c] * xr[c];
        const float rs = 1.0f / sqrtf(s / (float)D + EPS);
        for (int c = 0; c < D; ++c) out[r * D + c] = f2bf(xr[c] * rs * w[c]);
    }
};
template <class TO> struct Rmsnorm {
    static HDI void run(long r, const float* x, const float* w, TO* out) {
        const float* xr = x + r * D; float s = 0.f;
        for (int c = 0; c < D; ++c) s += xr[c] * xr[c];
        const float rs = 1.0f / sqrtf(s / (float)D + EPS);
        for (int c = 0; c < D; ++c) st(out + r * D + c, xr[c] * rs * w[c]);
    }
};
template <class TC> struct Gemm {
    static HDI void run(long g, const bf16_t* A, int lda, const float* B, int ldb, TC* C, int ldc, int N, int K) {
        const int nq = N / 4; const long mi = g / nq; const int ni = (int)(g % nq);
        float acc[4][4];
#pragma unroll
        for (int i = 0; i < 4; ++i)
#pragma unroll
            for (int j = 0; j < 4; ++j) acc[i][j] = 0.f;
        const bf16_t* a0 = A + (mi * 4) * lda; const float* bp = B + ni * 4;
        for (int k = 0; k < K; ++k) {
            const float b0 = bp[(long)k * ldb], b1 = bp[(long)k * ldb + 1], b2 = bp[(long)k * ldb + 2], b3 = bp[(long)k * ldb + 3];
#pragma unroll
            for (int i = 0; i < 4; ++i) { const float a = bf2f(a0[(long)i * lda + k]); acc[i][0] += a * b0; acc[i][1] += a * b1; acc[i][2] += a * b2; acc[i][3] += a * b3; }
        }
#pragma unroll
        for (int i = 0; i < 4; ++i)
#pragma unroll
            for (int j = 0; j < 4; ++j) st(C + (mi * 4 + i) * ldc + ni * 4 + j, acc[i][j]);
    }
};
struct GemmSwiglu {
    static HDI void run(long g, const bf16_t* A, const float* B, bf16_t* Hh, int K) {
        const int nq = FF / 4; const long mi = g / nq; const int ni = (int)(g % nq);
        float ag[4][4], au[4][4];
#pragma unroll
        for (int i = 0; i < 4; ++i)
#pragma unroll
            for (int j = 0; j < 4; ++j) { ag[i][j] = 0.f; au[i][j] = 0.f; }
        const bf16_t* a0 = A + (mi * 4) * K; const float* bp = B + ni * 4;
        for (int k = 0; k < K; ++k) {
            float bg[4], bu[4];
#pragma unroll
            for (int j = 0; j < 4; ++j) { bg[j] = bp[(long)k * 2 * FF + j]; bu[j] = bp[(long)k * 2 * FF + FF + j]; }
#pragma unroll
            for (int i = 0; i < 4; ++i) { const float a = bf2f(a0[(long)i * K + k]);
#pragma unroll
                for (int j = 0; j < 4; ++j) { ag[i][j] += a * bg[j]; au[i][j] += a * bu[j]; } }
        }
#pragma unroll
        for (int i = 0; i < 4; ++i)
#pragma unroll
            for (int j = 0; j < 4; ++j) Hh[(mi * 4 + i) * FF + ni * 4 + j] = f2bf(silu_f(ag[i][j]) * au[i][j]);
    }
};
struct AxpyIn {
    static HDI void run(long g, const float* xp, const float* xs, const float* T, float alpha, float* out) { const long r = g / D; const int c = (int)(g % D); out[g] = xrow(xp, xs, r)[c] + alpha * T[g]; }
};
struct Axpy {
    static HDI void run(long g, const float* a, const float* b, float alpha, float* out) { out[g] = a[g] + alpha * b[g]; }
};
HDI void row_info(long r, int& is_s, int& seq, int& t, int& L, long& base) {
    if (r < MP) { is_s = 0; seq = (int)(r / SEQ); t = (int)(r % SEQ); L = SEQ; base = (long)seq * SEQ; }
    else { const long rr = r - MP; is_s = 1; seq = (int)(rr / DS); t = (int)(rr % DS); L = DS; base = MP + (long)seq * DS; }
}
struct ConvInPlace {
    static HDI void run(long g, bf16_t* RAW, const float* state_conv, const float* conv_w) {
        const int c = (int)(g % CONV); const int sq = (int)(g / CONV);
        const int is_s = sq >= BATCH; const int seq = is_s ? sq - BATCH : sq; const int L = is_s ? DS : SEQ;
        const long base = is_s ? MP + (long)seq * DS : (long)seq * SEQ;
        const float w0 = conv_w[0 * CONV + c], w1 = conv_w[1 * CONV + c], w2 = conv_w[2 * CONV + c], w3 = conv_w[3 * CONV + c];
        float e0 = is_s ? state_conv[((long)seq * 3 + 0) * CONV + c] : 0.f;
        float e1 = is_s ? state_conv[((long)seq * 3 + 1) * CONV + c] : 0.f;
        float e2 = is_s ? state_conv[((long)seq * 3 + 2) * CONV + c] : 0.f;
        for (int t = 0; t < L; ++t) {
            const float e3 = bf2f(RAW[(base + t) * CONV + c]);
            RAW[(base + t) * CONV + c] = f2bf(silu_f(w0 * e0 + w1 * e1 + w2 * e2 + w3 * e3));
            e0 = e1; e1 = e2; e2 = e3;
        }
    }
};
struct L2norm {
    static HDI void run(long g, bf16_t* QKV) {
        const long r = g / 16; const int hh = (int)(g % 16);
        bf16_t* p = QKV + r * CONV + hh * 128; float s = 0.f;
        for (int j = 0; j < 128; ++j) { const float v = bf2f(p[j]); s += v * v; }
        const float rs = 1.0f / sqrtf(s + EPS);
        for (int j = 0; j < 128; ++j) p[j] = f2bf(bf2f(p[j]) * rs);
    }
};
struct Gdn {
    static HDI void run(long g, const float* AB, const bf16_t* QKV, const float* state_gdn, const float* a_log, const float* dt_bias,
                        bf16_t* OG, float* out_gp, float* out_gs) {
        const int dv = (int)(g % DV); const int h = (int)((g / DV) % H); const int sq = (int)(g / (DV * H));
        const int is_s = sq >= BATCH; const int seq = is_s ? sq - BATCH : sq; const int L = is_s ? DS : SEQ;
        const long base = is_s ? MP + (long)seq * DS : (long)seq * SEQ;
        float S[DK];
#pragma unroll
        for (int j = 0; j < DK; ++j) S[j] = is_s ? state_gdn[(((long)seq * H + h) * DK + j) * DV + dv] : 0.f;
        const float ea = expf(a_log[h]), dtb = dt_bias[h];
        for (int t = 0; t < L; ++t) {
            const long r = base + t;
            const float a = AB[r * 16 + h], b = AB[r * 16 + 8 + h];
            const float gg = -ea * softplus_f(a + dtb), beta = sigmoid_f(b), alpha = expf(gg);
            const bf16_t* q = QKV + r * CONV + h * DK; const bf16_t* k = QKV + r * CONV + 1024 + h * DK;
            const float v = bf2f(QKV[r * CONV + 2048 + h * DV + dv]);
            float ks = 0.f;
#pragma unroll
            for (int j = 0; j < DK; ++j) ks += bf2f(k[j]) * S[j];
            const float vn = beta * (v - alpha * ks);
            float o = 0.f;
#pragma unroll
            for (int j = 0; j < DK; ++j) { S[j] = alpha * S[j] + bf2f(k[j]) * vn; o += bf2f(q[j]) * S[j]; }
            OG[r * 1024 + h * DV + dv] = f2bf(o * 0.08838834764831845f);
        }
        float* so = is_s ? out_gs : out_gp;
#pragma unroll
        for (int j = 0; j < DK; ++j) so[(((long)seq * H + h) * DK + j) * DV + dv] = S[j];
    }
};
struct Rope {
    static HDI void run(long g, bf16_t* QS, bf16_t* KS) {
        const int i = (int)(g % 8); const int hh = (int)((g / 8) % 20); const long r = g / 160;
        int is_s, seq, t, L; long base; row_info(r, is_s, seq, t, L, base);
        const float pos = (float)(is_s ? PAST + t : t);
        const float inv = powf(500000.0f, -(float)(2 * i) / 16.0f);
        const float ang = pos * inv; const float cs = cosf(ang), sn = sinf(ang);
        bf16_t* p = hh < 16 ? QS + r * 1024 + hh * 64 : KS + r * 256 + (hh - 16) * 64;
        const float x1 = bf2f(p[i]), x2 = bf2f(p[i + 8]);
        p[i] = f2bf(x1 * cs - x2 * sn); p[i + 8] = f2bf(x2 * cs + x1 * sn);
    }
};
struct SwaPrompt {
    static HDI void run(long g, bf16_t* QS, const bf16_t* KS, const bf16_t* VS, const float* sinks) {
        const int qh = (int)(g % QH); const long r = g / QH; const int b = (int)(r / SEQ), t = (int)(r % SEQ); const int kvh = qh / 4;
        float q[HD], o[HD];
#pragma unroll
        for (int d = 0; d < HD; ++d) { q[d] = bf2f(QS[r * 1024 + qh * HD + d]); o[d] = 0.f; }
        float m = sinks[qh], l = 1.0f;
        const int j0 = t - (WIN - 1) < 0 ? 0 : t - (WIN - 1);
        for (int j = j0; j <= t; ++j) {
            const long rk = (long)b * SEQ + j; const bf16_t* kp = KS + rk * 256 + kvh * HD; const bf16_t* vp = VS + rk * 256 + kvh * HD;
            float s = 0.f;
#pragma unroll
            for (int d = 0; d < HD; ++d) s += q[d] * bf2f(kp[d]);
            s *= 0.125f;
            const float mn = fmaxf(m, s), sc = expf(m - mn), p = expf(s - mn);
            l = l * sc + p;
#pragma unroll
            for (int d = 0; d < HD; ++d) o[d] = o[d] * sc + p * bf2f(vp[d]);
            m = mn;
        }
        const float il = 1.0f / l;
#pragma unroll
        for (int d = 0; d < HD; ++d) QS[r * 1024 + qh * HD + d] = f2bf(o[d] * il);
    }
};
struct SwaSample {
    static HDI void run(long g, bf16_t* QS, const bf16_t* KS, const bf16_t* VS, const float* ck, const float* cv, const float* sinks) {
        const int qh = (int)(g % QH); const long rr = g / QH; const int b = (int)(rr / DS), t = (int)(rr % DS); const int kvh = qh / 4;
        const long r = MP + rr;
        float q[HD], o[HD];
#pragma unroll
        for (int d = 0; d < HD; ++d) { q[d] = bf2f(QS[r * 1024 + qh * HD + d]); o[d] = 0.f; }
        float m = sinks[qh], l = 1.0f;
        for (int j = t + 1; j < WIN + t + 1; ++j) {
            float s = 0.f; float vv[HD];
            if (j < WIN) { const float* kp = ck + (((long)b * WIN + j) * KVH + kvh) * HD; const float* vp = cv + (((long)b * WIN + j) * KVH + kvh) * HD;
#pragma unroll
                for (int d = 0; d < HD; ++d) { s += q[d] * kp[d]; vv[d] = vp[d]; } }
            else { const long rk = MP + (long)b * DS + (j - WIN); const bf16_t* kp = KS + rk * 256 + kvh * HD; const bf16_t* vp = VS + rk * 256 + kvh * HD;
#pragma unroll
                for (int d = 0; d < HD; ++d) { s += q[d] * bf2f(kp[d]); vv[d] = bf2f(vp[d]); } }
            s *= 0.125f;
            const float mn = fmaxf(m, s), sc = expf(m - mn), p = expf(s - mn);
            l = l * sc + p;
#pragma unroll
            for (int d = 0; d < HD; ++d) o[d] = o[d] * sc + p * vv[d];
            m = mn;
        }
        const float il = 1.0f / l;
#pragma unroll
        for (int d = 0; d < HD; ++d) QS[r * 1024 + qh * HD + d] = f2bf(o[d] * il);
    }
};
struct Mix {
    static HDI void run(long g, const bf16_t* Z, bf16_t* GA, const bf16_t* GB, const bf16_t* OG, const bf16_t* OS, const float* gdn_norm) {
        const int h = (int)(g % H); const long r = g / H;
        const bf16_t* og = OG + r * 1024 + h * DV; float s = 0.f;
        for (int j = 0; j < DV; ++j) { const float v = bf2f(og[j]); s += v * v; }
        const float rs = 1.0f / sqrtf(s / (float)DV + EPS);
        for (int j = 0; j < DV; ++j) {
            const long c = r * 1024 + h * DV + j;
            const float z = bf2f(Z[c]), ga = bf2f(GA[c]), gb = bf2f(GB[c]);
            GA[c] = f2bf(sigmoid_f(ga) * (bf2f(og[j]) * rs * gdn_norm[j] * silu_f(z)) + sigmoid_f(gb) * bf2f(OS[c]));
        }
    }
};
struct OutConv {
    static HDI void run(long g, const bf16_t* RAW, float* out_cp, float* out_cs) {
        const int c = (int)(g % CONV); const int i = (int)((g / CONV) % 3); const int sq = (int)(g / (3 * CONV));
        const int is_s = sq >= BATCH; const int seq = is_s ? sq - BATCH : sq; const int L = is_s ? DS : SEQ;
        const long base = is_s ? MP + (long)seq * DS : (long)seq * SEQ;
        const float v = bf2f(RAW[(base + L - 3 + i) * CONV + c]);
        (is_s ? out_cs : out_cp)[((long)seq * 3 + i) * CONV + c] = v;
    }
};
struct OutKV {
    static HDI void run(long g, const bf16_t* KS, const bf16_t* VS, const float* ck, const float* cv, float* out_kp, float* out_ks, float* out_vp, float* out_vs) {
        const int c = (int)(g % 256); const int j = (int)((g / 256) % WIN); const int sq = (int)(g / (256 * WIN));
        if (sq < BATCH) {
            const long r = (long)sq * SEQ + SEQ - WIN + j;
            out_kp[((long)sq * WIN + j) * 256 + c] = bf2f(KS[r * 256 + c]); out_vp[((long)sq * WIN + j) * 256 + c] = bf2f(VS[r * 256 + c]);
        } else {
            const int b = sq - BATCH; float kv, vv;
            if (j + DS < WIN) { kv = ck[((long)b * WIN + j + DS) * 256 + c]; vv = cv[((long)b * WIN + j + DS) * 256 + c]; }
            else { const long r = MP + (long)b * DS + (j + DS - WIN); kv = bf2f(KS[r * 256 + c]); vv = bf2f(VS[r * 256 + c]); }
            out_ks[((long)b * WIN + j) * 256 + c] = kv; out_vs[((long)b * WIN + j) * 256 + c] = vv;
        }
    }
};
}
namespace pg8 {
#define PG8_LAS __attribute__((address_space(3)))
typedef short bf16x8 __attribute__((ext_vector_type(8)));
typedef float f32x4 __attribute__((ext_vector_type(4)));
typedef unsigned u32x4 __attribute__((ext_vector_type(4)));
constexpr int BM = 256, BK = 64, HALF = 128, HTB = HALF * BK * 2  , STAGE_BYTES = 8 * HTB, NXCD = 8, WGM = 8;

__host__ __device__ __forceinline__ int lds_byte(int r, int c) { const int st = (r >> 4) * 2 + (c >> 5), rr = r & 15, cc = c & 31, ob = rr * 64 + cc * 2; return st * 1024 + (ob ^ (((ob >> 9) & 1) << 5)); }
__host__ __device__ __forceinline__ void stage_rc(int b, int& R, int& C) { const int st = b / 1024, sb = b % 1024, swz = sb ^ (((sb >> 9) & 1) << 5); R = (st >> 1) * 16 + swz / 64; C = (st & 1) * 32 + (swz % 64) / 2; }
__host__ __device__ __forceinline__ int perm32(int rho) { const int n = rho >> 4, i = rho & 15; return 8 * (i >> 2) + 4 * n + (i & 3); }

struct Unit { int pm, pn; };
struct Gemm { const bf16_t* A; const bf16_t* Bt; int M, N, K; };

struct StaticOrder {
    int nM, nN, nwg, G, c;
    __host__ __device__ void init(int M, int N, int G_, int c_) { nM = M / BM; nN = N / BM; nwg = nM * nN; G = G_; c = c_; }
    __host__ __device__ bool next(int i, Unit& u) const {
        const long L = (long)i * G + c; if (L >= nwg) return false;
        int wgid = (int)L; { const int q = nwg / NXCD, r = nwg % NXCD, xcd = wgid % NXCD, off = wgid / NXCD; wgid = (xcd < r ? xcd * (q + 1) : r * (q + 1) + (xcd - r) * q) + off; }
        const int nig = WGM * nN, gid = wgid / nig, fm = gid * WGM, gsz = (nM - fm) < WGM ? (nM - fm) : WGM;
        u.pm = fm + ((wgid % nig) % gsz); u.pn = (wgid % nig) / gsz; return true;
    }
    __device__ __forceinline__ void a_ready(const Unit&) const {}
    __device__ __forceinline__ void done(const Unit&) const {}
};
typedef unsigned u32x2 __attribute__((ext_vector_type(2)));
__device__ __forceinline__ unsigned cvt_pk_bf16(float lo, float hi) { unsigned r; asm volatile("v_cvt_pk_bf16_f32 %0, %1, %2" : "=v"(r) : "v"(lo), "v"(hi)); return r; }
__device__ __forceinline__ float fast_sigmoid(float x) { return __builtin_amdgcn_rcpf(1.0f + __builtin_amdgcn_exp2f(-1.4426950408889634f * x)); }
__device__ __forceinline__ float fast_silu(float x) { return x * fast_sigmoid(x); }
__device__ __forceinline__ void load_rs(float (&rs)[2][4], const float* ssq, int pm, int wr, int fr, int fq) {
#pragma unroll
    for (int ai = 0; ai < 2; ++ai)
#pragma unroll
        for (int m = 0; m < 4; ++m) {
            const int row = pm * BM + ai * HALF + wr * 64 + m * 16 + fr;
            const f32x4 v = *(const f32x4*)(ssq + (size_t)row * 16 + 4 * fq);
            float s = (v[0] + v[1]) + (v[2] + v[3]);
            s += __shfl_xor(s, 16); s += __shfl_xor(s, 32);
            rs[ai][m] = 1.0f / sqrtf(s * (1.0f / 1024.0f) + 1e-6f);
        }
}
struct EpiSwiglu {
    static constexpr bool PERM = true, AFTER_DRAIN = false;
    bf16_t* Hh; int ldh; const float* ssq;
    __device__ __forceinline__ void operator()(const f32x4 (&acc)[2][2][4][2], const Unit& u, int wr, int wc, int fr, int fq) const {
        float rs[2][4];
        if (ssq) load_rs(rs, ssq, u.pm, wr, fr, fq);
        const int col0 = u.pn * HALF + wc * 32 + 8 * fq;
#pragma unroll
        for (int ai = 0; ai < 2; ++ai)
#pragma unroll
            for (int m = 0; m < 4; ++m) {
                const float r_ = ssq ? rs[ai][m] : 1.0f;
                const int row = u.pm * BM + ai * HALF + wr * 64 + m * 16 + fr;
                float hv[8];
#pragma unroll
                for (int n = 0; n < 2; ++n)
#pragma unroll
                    for (int i = 0; i < 4; ++i) { const float g = acc[ai][0][m][n][i] * r_, up = acc[ai][1][m][n][i] * r_; hv[4 * n + i] = fast_silu(g) * up; }
                u32x4 w; w.x = cvt_pk_bf16(hv[0], hv[1]); w.y = cvt_pk_bf16(hv[2], hv[3]); w.z = cvt_pk_bf16(hv[4], hv[5]); w.w = cvt_pk_bf16(hv[6], hv[7]);
                *(u32x4*)(Hh + (size_t)row * ldh + col0) = w;
            }
    }
};
struct EpiInProj {
    static constexpr bool PERM = true, AFTER_DRAIN = false;
    bf16_t *raw, *z, *qs, *ks, *vs, *ga, *gb; const float* ssq;
    __device__ __forceinline__ void operator()(const f32x4 (&acc)[2][2][4][2], const Unit& u, int wr, int wc, int fr, int fq) const {
        float rs[2][4]; load_rs(rs, ssq, u.pm, wr, fr, fq);
        bf16_t* base; int ldc, colt; const int pn = u.pn;
        if (pn < 12) { base = raw; ldc = 3072; colt = pn * 256; }
        else if (pn < 16) { base = z; ldc = 1024; colt = (pn - 12) * 256; }
        else if (pn < 20) { base = qs; ldc = 1024; colt = (pn - 16) * 256; }
        else if (pn == 20) { base = ks; ldc = 256; colt = 0; }
        else if (pn == 21) { base = vs; ldc = 256; colt = 0; }
        else if (pn < 26) { base = ga; ldc = 1024; colt = (pn - 22) * 256; }
        else { base = gb; ldc = 1024; colt = (pn - 26) * 256; }
        const int col0 = colt + wc * 32 + 8 * fq;
#pragma unroll
        for (int ai = 0; ai < 2; ++ai)
#pragma unroll
            for (int m = 0; m < 4; ++m) {
                const float r_ = rs[ai][m];
                bf16_t* rowp = base + (size_t)(u.pm * BM + ai * HALF + wr * 64 + m * 16 + fr) * ldc + col0;
#pragma unroll
                for (int bj = 0; bj < 2; ++bj) { const f32x4 v0 = acc[ai][bj][m][0] * r_, v1 = acc[ai][bj][m][1] * r_;
                    u32x4 w; w.x = cvt_pk_bf16(v0[0], v0[1]); w.y = cvt_pk_bf16(v0[2], v0[3]); w.z = cvt_pk_bf16(v1[0], v1[1]); w.w = cvt_pk_bf16(v1[2], v1[3]);
                    *(u32x4*)(rowp + bj * HALF) = w; }
            }
    }
};
struct EpiResid {
    static constexpr bool PERM = false, AFTER_DRAIN = false;
    const float* xin_p; const float* xin_s; int split_row; float alpha; float* xout; bf16_t* xb; float* ssq;
    __device__ __forceinline__ void operator()(const f32x4 (&acc)[2][2][4][2], const Unit& u, int wr, int wc, int fr, int fq) const {
        const int col0 = u.pn * BM + wc * 32 + 4 * fq;
#pragma unroll
        for (int ai = 0; ai < 2; ++ai)
#pragma unroll
            for (int m = 0; m < 4; ++m) {
                const int row = u.pm * BM + ai * HALF + wr * 64 + m * 16 + fr;
                const float* xr = (row < split_row ? xin_p + (size_t)row * 1024 : xin_s + (size_t)(row - split_row) * 1024) + col0;
                float* orow = xout + (size_t)row * 1024 + col0;
                float ss = 0.f;
#pragma unroll
                for (int bj = 0; bj < 2; ++bj)
#pragma unroll
                    for (int n = 0; n < 2; ++n) {
                        const f32x4 xi = *(const f32x4*)(xr + bj * HALF + n * 16);
                        const f32x4 o = xi + acc[ai][bj][m][n] * alpha;
                        *(f32x4*)(orow + bj * HALF + n * 16) = o;
                        if (xb) { u32x2 w; w.x = cvt_pk_bf16(o[0], o[1]); w.y = cvt_pk_bf16(o[2], o[3]); *(u32x2*)(xb + (size_t)row * 1024 + col0 + bj * HALF + n * 16) = w; }
                        ss += (o[0] * o[0] + o[1] * o[1]) + (o[2] * o[2] + o[3] * o[3]);
                    }
                ss += __shfl_xor(ss, 16); ss += __shfl_xor(ss, 32);
                if (fq == 0) ssq[(size_t)row * 16 + u.pn * 4 + wc] = ss;
                if (m & 1) asm volatile("" ::: "memory");
            }
    }
};
template <class Epi, class Sched, bool ALIGN_EPI = false, bool SP2 = false>
__device__ __forceinline__ void gemm_phase(PG8_LAS unsigned char* lds, const Gemm g, const Sched& S, const Epi& E) {
    const int tid = threadIdx.x, wid = __builtin_amdgcn_readfirstlane(tid >> 6), lane = tid & 63, wr = wid >> 2, wc = wid & 3, fr = lane & 15, fq = lane >> 4;
    const int K = g.K, nt = K / BK;
    unsigned voffA[2], voffB[2];
#pragma unroll
    for (int i = 0; i < 2; ++i) { int R, C; stage_rc(tid * 16 + i * 8192, R, C); const int Rb = Epi::PERM ? ((R & ~31) + perm32(R & 31)) : R;
        voffA[i] = (unsigned)(R * K + C) * 2u; voffB[i] = (unsigned)(Rb * K + C) * 2u; }
    const size_t kstep = (size_t)(BK * 2);
    const size_t hstep = (size_t)HALF * K * 2;
    const size_t tstep = 2 * hstep;
    const unsigned ldsw = (unsigned)wid * 1024u;
    const int aoff = lds_byte(wr * 64 + fr, fq * 8), boff = lds_byte(wc * 32 + fr, fq * 8);
#define PG8_SA(b, h) (((b) * 2 + (h)) * HTB)
#define PG8_SB(b, h) ((4 + (b) * 2 + (h)) * HTB)
#define PG8_STAGE(bufoff, gbase, voff) do { _Pragma("unroll") for (int _i = 0; _i < 2; ++_i) \
        __builtin_amdgcn_global_load_lds((const unsigned*)((const char*)(gbase) + (voff)[_i]), (PG8_LAS unsigned*)(lds + (bufoff) + ldsw + _i * 8192), 16, 0, 0); } while (0)
#define PG8_LDA(dst, b, h) do { _Pragma("unroll") for (int m = 0; m < 4; ++m) _Pragma("unroll") for (int k = 0; k < 2; ++k) dst[m][k] = *(const PG8_LAS bf16x8*)(lds + PG8_SA(b, h) + aoff + m * 2048 + k * 1024); } while (0)
#define PG8_LDB(dst, b, h) do { _Pragma("unroll") for (int n = 0; n < 2; ++n) _Pragma("unroll") for (int k = 0; k < 2; ++k) dst[n][k] = *(const PG8_LAS bf16x8*)(lds + PG8_SB(b, h) + boff + n * 2048 + k * 1024); } while (0)
#define PG8_MMA(ai, bj, At, Bt) do { __builtin_amdgcn_s_setprio(1); _Pragma("unroll") for (int m = 0; m < 4; ++m) _Pragma("unroll") for (int n = 0; n < 2; ++n) _Pragma("unroll") for (int k = 0; k < 2; ++k) \
        acc[ai][bj][m][n] = __builtin_amdgcn_mfma_f32_16x16x32_bf16(Bt[n][k], At[m][k], acc[ai][bj][m][n], 0, 0, 0); __builtin_amdgcn_s_setprio(0); } while (0)
#define PG8_WAIT_V(n) asm volatile("s_waitcnt vmcnt(" #n ")" ::: "memory")
#define PG8_WAIT_L(n) asm volatile("s_waitcnt lgkmcnt(" #n ")" ::: "memory")
#define PG8_BAR __builtin_amdgcn_s_barrier()
#define PG8_SCHED __builtin_amdgcn_sched_barrier(0)
    Unit cur, nxt; int ui = 0;
    if (!S.next(0, cur)) return;
    f32x4 acc[2][2][4][2];
#pragma unroll
    for (int a = 0; a < 2; ++a)
#pragma unroll
        for (int b = 0; b < 2; ++b)
#pragma unroll
            for (int m = 0; m < 4; ++m)
#pragma unroll
                for (int n = 0; n < 2; ++n) acc[a][b][m][n] = (f32x4){0.f, 0.f, 0.f, 0.f};
    bf16x8 At[4][2], B0[2][2], B1[2][2];
    const char* cA = (const char*)g.A + (size_t)cur.pm * tstep; const char* cB = (const char*)g.Bt + (size_t)cur.pn * tstep;
    S.a_ready(cur);
    if constexpr (SP2) {
        PG8_STAGE(PG8_SB(0, 0), cB, voffB); PG8_STAGE(PG8_SB(0, 1), cB + hstep, voffB); PG8_STAGE(PG8_SA(0, 0), cA, voffA); PG8_STAGE(PG8_SA(0, 1), cA + hstep, voffA);
        if (wr == 1) PG8_BAR;
        PG8_WAIT_V(2); PG8_BAR;
        PG8_STAGE(PG8_SB(1, 0), cB + kstep, voffB); PG8_STAGE(PG8_SA(1, 0), cA + kstep, voffA); PG8_STAGE(PG8_SB(1, 1), cB + hstep + kstep, voffB);
        PG8_WAIT_V(6); PG8_BAR;
    } else {
        PG8_STAGE(PG8_SB(0, 0), cB, voffB); PG8_STAGE(PG8_SA(0, 0), cA, voffA); PG8_STAGE(PG8_SB(0, 1), cB + hstep, voffB); PG8_STAGE(PG8_SA(0, 1), cA + hstep, voffA);
        if (wr == 1) PG8_BAR;
        PG8_WAIT_V(4); PG8_BAR;
        PG8_STAGE(PG8_SB(1, 0), cB + kstep, voffB); PG8_STAGE(PG8_SA(1, 0), cA + kstep, voffA); PG8_STAGE(PG8_SB(1, 1), cB + hstep + kstep, voffB);
        PG8_WAIT_V(6); PG8_BAR;
    }
    for (;;) {
        const bool has_next = S.next(ui + 1, nxt);
        const char* nA = has_next ? (const char*)g.A + (size_t)nxt.pm * tstep : cA; const char* nB = has_next ? (const char*)g.Bt + (size_t)nxt.pn * tstep : cB;
        for (int t = 0; t < nt; t += 2) {
            const bool last = (t == nt - 2);
            const char* a1 = cA + (size_t)(t + 1) * kstep;
            const char* a2 = last ? nA : cA + (size_t)(t + 2) * kstep; const char* b2 = last ? nB : cB + (size_t)(t + 2) * kstep;
            const char* a3 = a2 + kstep; const char* b3 = b2 + kstep;
            if (last && has_next) S.a_ready(nxt);
            if constexpr (SP2) {
            PG8_LDB(B0, 0, 0); PG8_LDB(B1, 0, 1); PG8_SCHED; PG8_LDA(At, 0, 0); PG8_STAGE(PG8_SA(1, 1), a1 + hstep, voffA);
            PG8_WAIT_V(8); PG8_WAIT_L(0); PG8_BAR; PG8_MMA(0, 0, At, B0); PG8_MMA(0, 1, At, B1); PG8_BAR; PG8_SCHED;
            PG8_LDA(At, 0, 1); PG8_STAGE(PG8_SB(0, 0), b2, voffB); PG8_STAGE(PG8_SB(0, 1), b2 + hstep, voffB); PG8_STAGE(PG8_SA(0, 0), a2, voffA);
            PG8_WAIT_V(8); PG8_WAIT_L(0); PG8_BAR; PG8_MMA(1, 0, At, B0); PG8_MMA(1, 1, At, B1); PG8_BAR; PG8_SCHED;
            PG8_LDB(B0, 1, 0); PG8_LDB(B1, 1, 1); PG8_SCHED; PG8_LDA(At, 1, 0); PG8_STAGE(PG8_SA(0, 1), a2 + hstep, voffA);
            PG8_WAIT_V(8); PG8_WAIT_L(0); PG8_BAR; PG8_MMA(0, 0, At, B0); PG8_MMA(0, 1, At, B1); PG8_BAR; PG8_SCHED;
            PG8_LDA(At, 1, 1); PG8_STAGE(PG8_SB(1, 0), b3, voffB); PG8_STAGE(PG8_SB(1, 1), b3 + hstep, voffB); PG8_STAGE(PG8_SA(1, 0), a3, voffA);
            PG8_WAIT_V(8); PG8_WAIT_L(0); PG8_BAR; PG8_MMA(1, 0, At, B0); PG8_MMA(1, 1, At, B1); PG8_BAR; PG8_SCHED;
            } else {
            PG8_LDB(B0, 0, 0); PG8_SCHED; PG8_LDA(At, 0, 0); PG8_STAGE(PG8_SA(1, 1), a1 + hstep, voffA);
            PG8_WAIT_L(8); PG8_BAR; PG8_WAIT_L(0); PG8_MMA(0, 0, At, B0); PG8_BAR; PG8_SCHED;
            PG8_LDB(B1, 0, 1); PG8_STAGE(PG8_SB(0, 0), b2, voffB);
            PG8_BAR; PG8_WAIT_L(0); PG8_MMA(0, 1, At, B1); PG8_BAR;
            PG8_LDA(At, 0, 1); PG8_STAGE(PG8_SA(0, 0), a2, voffA);
            PG8_BAR; PG8_WAIT_L(0); PG8_MMA(1, 0, At, B0); PG8_BAR; PG8_SCHED;
            PG8_STAGE(PG8_SB(0, 1), b2 + hstep, voffB);
            PG8_WAIT_V(6); PG8_BAR; PG8_MMA(1, 1, At, B1); PG8_BAR;
            PG8_LDB(B0, 1, 0); PG8_SCHED; PG8_LDA(At, 1, 0); PG8_STAGE(PG8_SA(0, 1), a2 + hstep, voffA);
            PG8_WAIT_L(8); PG8_BAR; PG8_WAIT_L(0); PG8_MMA(0, 0, At, B0); PG8_BAR; PG8_SCHED;
            PG8_LDB(B1, 1, 1); PG8_STAGE(PG8_SB(1, 0), b3, voffB);
            PG8_BAR; PG8_WAIT_L(0); PG8_MMA(0, 1, At, B1); PG8_BAR;
            PG8_LDA(At, 1, 1); PG8_STAGE(PG8_SA(1, 0), a3, voffA);
            PG8_BAR; PG8_WAIT_L(0); PG8_MMA(1, 0, At, B0); PG8_BAR; PG8_SCHED;
            PG8_STAGE(PG8_SB(1, 1), b3 + hstep, voffB);
            PG8_WAIT_V(6); PG8_BAR; PG8_MMA(1, 1, At, B1); PG8_BAR;
            }
        }
        if constexpr (ALIGN_EPI) { if (wr == 0) PG8_BAR; }
        if constexpr (!Epi::AFTER_DRAIN) { E(acc, cur, wr, wc, fr, fq); S.done(cur); }
        if (!has_next) break;
#pragma unroll
        for (int a = 0; a < 2; ++a)
#pragma unroll
            for (int b = 0; b < 2; ++b)
#pragma unroll
                for (int m = 0; m < 4; ++m)
#pragma unroll
                    for (int n = 0; n < 2; ++n) acc[a][b][m][n] = (f32x4){0.f, 0.f, 0.f, 0.f};
        cur = nxt; cA = nA; cB = nB; ++ui;
        if constexpr (ALIGN_EPI) { if (wr == 1) PG8_BAR; }
    }
    PG8_WAIT_V(0);
    if constexpr (!ALIGN_EPI) { if (wr == 0) PG8_BAR; }
    PG8_BAR;
    if constexpr (Epi::AFTER_DRAIN) { E.fused(acc, cur, wr, wc, fr, fq, lds, wid, lane); S.done(cur); }
#undef PG8_SA
#undef PG8_SB
#undef PG8_STAGE
#undef PG8_LDA
#undef PG8_LDB
#undef PG8_MMA
#undef PG8_WAIT_V
#undef PG8_WAIT_L
#undef PG8_BAR
#undef PG8_SCHED
}
}
#ifndef CPU_EMU
#include <hip/hip_cooperative_groups.h>
#include <cstdio>
namespace mk {
namespace cg = cooperative_groups;
using namespace cfg;
#define LAS __attribute__((address_space(3)))
#define GAS __attribute__((address_space(1)))
typedef float f32x4 __attribute__((ext_vector_type(4)));
typedef unsigned v4u __attribute__((ext_vector_type(4)));
typedef short bf16x8 __attribute__((ext_vector_type(8)));
constexpr int NWAVES = 8, NTHREADS = NWAVES * 64;
constexpr int LDS_BYTES = 147456;
#ifndef MK_EMBED_NB
#define MK_EMBED_NB 1
#endif
enum Phase { P_PRO = 0, P_FFN1A, P_FFN1B, P_INPROJ, P_PREP, P_MIXER, P_MERGE, P_OUTPROJ, P_FFN2A, P_FFN2B, P_FINAL, P_COUNT };

struct MArgs { const float* in[21]; float* out; unsigned char* ws; int ph_lo, ph_hi; };

__device__ __forceinline__ unsigned f2bf_u(float f) { unsigned u = __builtin_bit_cast(unsigned, f); return (u + 0x7fffu + ((u >> 16) & 1u)) >> 16; }
__device__ __forceinline__ unsigned pk2(float lo, float hi) { return f2bf_u(lo) | (f2bf_u(hi) << 16); }
__device__ __forceinline__ float wave_sum(float v) {
#pragma unroll
    for (int o = 1; o < 64; o <<= 1) v += __shfl_xor(v, o);
    return v;
}
__device__ __forceinline__ void transpose_item(const float* W, int ldw, int src_col0, bf16_t* WT, int K, int dst_row0, int nvalid, const float* kscale, LAS float* scr, int k0, int lane) {
#pragma unroll 8
    for (int i = 0; i < 32; ++i) { const int kk = 2 * i + (lane >> 5); float v = W[(size_t)(k0 + kk) * ldw + src_col0 + (lane & 31)]; if (kscale) v *= kscale[k0 + kk]; scr[kk * 33 + (lane & 31)] = v; }
    asm volatile("s_waitcnt lgkmcnt(0)" ::: "memory");
    const int c = lane & 7;
#pragma unroll
    for (int j = 0; j < 4; ++j) { const int n = (lane >> 3) + 8 * j; const LAS float* s = scr + (8 * c) * 33 + n;
        v4u o; o.x = pk2(s[0 * 33], s[1 * 33]); o.y = pk2(s[2 * 33], s[3 * 33]); o.z = pk2(s[4 * 33], s[5 * 33]); o.w = pk2(s[6 * 33], s[7 * 33]);
        if (n < nvalid) *(v4u*)(WT + (size_t)(dst_row0 + n) * K + k0 + 8 * c) = o; }
    asm volatile("s_waitcnt lgkmcnt(0)" ::: "memory");
}
struct Frame {
    LAS unsigned char* lds; int tid, lane, wave, G;
    const float* in[21]; float* out; unsigned char* ws;
};
#define FB(off) ((bf16_t*)(F.ws + lay::off))
#define FF32(off) ((float*)(F.ws + lay::off))
enum { I_XP = 0, I_XS, I_SCONV, I_SGDN, I_CK, I_CV, I_NF1, I_W1IN, I_W1OUT, I_NMIX, I_WIN, I_CONVW, I_ALOG, I_DTB, I_GNORM, I_SINKS, I_WOUT, I_NF2, I_W2IN, I_W2OUT, I_NFIN };

__device__ __forceinline__ void p0_prologue(Frame& F) {
    LAS float* scr = (LAS float*)(F.lds + F.wave * 16384);
    const int gw = blockIdx.x * NWAVES + F.wave, NGW = F.G * NWAVES;
    constexpr int KB1 = D / 64, KB2 = FF / 64;
    constexpr int N_W1IN = KB1 * (2 * FF / 32), N_W1OUT = KB2 * (D / 32), N_WIN = KB1 * (7680 / 32), N_WAB = KB1, N_WOUT = KB1 * (D / 32);
    constexpr int NITEMS = 2 * N_W1IN + 2 * N_W1OUT + N_WIN + N_WAB + N_WOUT;
    for (int it = gw; it < NITEMS; it += NGW) {
        int r = it;
        if (r < 2 * N_W1IN) {
            const int second = r >= N_W1IN; if (second) r -= N_W1IN;
            const int nbs = 2 * FF / 32, kb = r / nbs, nb = r % nbs, pn = nb >> 3, bj = (nb >> 2) & 1, wi = nb & 3;
            transpose_item(F.in[second ? I_W2IN : I_W1IN], 2 * FF, bj * FF + pn * 128 + wi * 32, second ? FB(WS_W2IN) : FB(WS_W1IN), D, nb * 32, 32, second ? F.in[I_NF2] : nullptr, scr, kb * 64, F.lane);
            continue; }
        r -= 2 * N_W1IN;
        if (r < 2 * N_W1OUT) {
            const int second = r >= N_W1OUT; if (second) r -= N_W1OUT;
            const int nbs = D / 32, kb = r / nbs, nb = r % nbs;
            transpose_item(F.in[second ? I_W2OUT : I_W1OUT], D, nb * 32, second ? FB(WS_W2OUT) : FB(WS_W1OUT), FF, nb * 32, 32, nullptr, scr, kb * 64, F.lane);
            continue; }
        r -= 2 * N_W1OUT;
        if (r < N_WIN) {
            const int nbs = 7680 / 32, kb = r / nbs, nb = r % nbs, drow = nb * 32;
            transpose_item(F.in[I_WIN], DIN, drow + (drow >= 4096 ? 16 : 0), FB(WS_WIN), D, drow, 32, F.in[I_NMIX], scr, kb * 64, F.lane);
            continue; }
        r -= N_WIN;
        if (r < N_WAB) { transpose_item(F.in[I_WIN], DIN, 4096, FB(WS_WAB), D, 0, 16, F.in[I_NMIX], scr, r * 64, F.lane); continue; }
        r -= N_WAB;
        { const int nbs = D / 32, kb = r / nbs, nb = r % nbs; transpose_item(F.in[I_WOUT], D, nb * 32, FB(WS_WOUT), D, nb * 32, 32, nullptr, scr, kb * 64, F.lane); }
    }
    const float* nw = F.in[I_NF1];
    f32x4 wv[4];
#pragma unroll
    for (int j = 0; j < 4; ++j) wv[j] = *(const f32x4*)(nw + 4 * F.lane + 256 * j);
    for (int m = gw; m < M; m += NGW) {
        const float* xr = (m < MP ? F.in[I_XP] + (size_t)m * D : F.in[I_XS] + (size_t)(m - MP) * D) + 4 * F.lane;
        f32x4 v[4]; float s = 0.f;
#pragma unroll
        for (int j = 0; j < 4; ++j) { v[j] = *(const f32x4*)(xr + 256 * j); s += (v[j][0] * v[j][0] + v[j][1] * v[j][1]) + (v[j][2] * v[j][2] + v[j][3] * v[j][3]); }
        const float rs = 1.0f / sqrtf(wave_sum(s) * (1.0f / D) + EPS);
        unsigned long long* o8 = (unsigned long long*)(FB(WS_XN1) + (size_t)m * D) + F.lane;
#pragma unroll
        for (int j = 0; j < 4; ++j) { const f32x4 o = v[j] * rs * wv[j]; o8[64 * j] = (unsigned long long)pk2(o[0], o[1]) | ((unsigned long long)pk2(o[2], o[3]) << 32); }
    }
}
__device__ __forceinline__ void ab_tiles(Frame& F) {
    const int gw = blockIdx.x * NWAVES + F.wave, NGW = F.G * NWAVES; const int lane = F.lane, q = lane >> 4, c = lane & 15;
    const bf16_t* x1b = FB(WS_X1B); const bf16_t* wab = FB(WS_WAB); const float* ssq = FF32(WS_SSQ1); float* AB = FF32(WS_AB);
    for (int tile = gw; tile < M / 16; tile += NGW) {
        f32x4 acc = {0.f, 0.f, 0.f, 0.f};
        const bf16_t* ap = x1b + (size_t)(tile * 16 + c) * D + 8 * q; const bf16_t* bp = wab + (size_t)c * D + 8 * q;
#pragma unroll 8
        for (int s = 0; s < D / 32; ++s) { const bf16x8 a = *(const bf16x8*)(ap + 32 * s), b = *(const bf16x8*)(bp + 32 * s); acc = __builtin_amdgcn_mfma_f32_16x16x32_bf16(a, b, acc, 0, 0, 0); }
#pragma unroll
        for (int r = 0; r < 4; ++r) { const int row = tile * 16 + 4 * q + r; const float* sp = ssq + (size_t)row * 16;
            float s = 0.f;
#pragma unroll
            for (int i = 0; i < 4; ++i) { const f32x4 v = *(const f32x4*)(sp + 4 * i); s += (v[0] + v[1]) + (v[2] + v[3]); }
            AB[(size_t)row * 16 + c] = acc[r] * (1.0f / sqrtf(s * (1.0f / D) + EPS)); }
    }
}
__device__ __forceinline__ void final_norm(Frame& F) {
    const int gw = blockIdx.x * NWAVES + F.wave, NGW = F.G * NWAVES; const float* nw = F.in[I_NFIN];
    f32x4 wv[4];
#pragma unroll
    for (int j = 0; j < 4; ++j) wv[j] = *(const f32x4*)(nw + 4 * F.lane + 256 * j);
    for (int m = gw; m < M; m += NGW) {
        float* xr = F.out + O_YP + (size_t)m * D + 4 * F.lane;
        f32x4 v[4]; float s = 0.f;
#pragma unroll
        for (int j = 0; j < 4; ++j) { v[j] = *(const f32x4*)(xr + 256 * j); s += (v[j][0] * v[j][0] + v[j][1] * v[j][1]) + (v[j][2] * v[j][2] + v[j][3] * v[j][3]); }
        const float rs = 1.0f / sqrtf(wave_sum(s) * (1.0f / D) + EPS);
#pragma unroll
        for (int j = 0; j < 4; ++j) *(f32x4*)(xr + 256 * j) = v[j] * rs * wv[j];
    }
}

struct Gdn2 {
    static __device__ __forceinline__ void run(long g, const float* AB, const bf16_t* QKV, const float* state_gdn, const float* a_log, const float* dt_bias,
                        bf16_t* OG, float* out_gp, float* out_gs) {
        using namespace nv;
        const int half = (int)(g & 1); const long col = g >> 1;
        const int dv = (int)(col % DV); const int h = (int)((col / DV) % H); const int sq = (int)(col / (DV * H));
        const int is_s = sq >= BATCH; const int seq = is_s ? sq - BATCH : sq; const int L = is_s ? DS : SEQ;
        const long base = is_s ? MP + (long)seq * DS : (long)seq * SEQ;
        float S[64];
#pragma unroll
        for (int j = 0; j < 64; ++j) S[j] = is_s ? state_gdn[(((long)seq * H + h) * DK + 64 * half + j) * DV + dv] : 0.f;
        const float ea = expf(a_log[h]), dtb = dt_bias[h];
        for (int t = 0; t < L; ++t) {
            const long r = base + t;
            const float a = AB[r * 16 + h], b = AB[r * 16 + 8 + h];
            const float gg = -ea * softplus_f(a + dtb), beta = sigmoid_f(b), alpha = expf(gg);
            const bf16_t* q = QKV + r * CONV + h * DK + 64 * half; const bf16_t* k = QKV + r * CONV + 1024 + h * DK + 64 * half;
            const float v = bf2f(QKV[r * CONV + 2048 + h * DV + dv]);
            float ks = 0.f;
#pragma unroll
            for (int j = 0; j < 64; ++j) ks += bf2f(k[j]) * S[j];
            ks += __shfl_xor(ks, 1);
            const float vn = beta * (v - alpha * ks);
            float o = 0.f;
#pragma unroll
            for (int j = 0; j < 64; ++j) { S[j] = alpha * S[j] + bf2f(k[j]) * vn; o += bf2f(q[j]) * S[j]; }
            o += __shfl_xor(o, 1);
            if (half == 0) OG[r * 1024 + h * DV + dv] = f2bf(o * 0.08838834764831845f);
        }
        float* so = is_s ? out_gs : out_gp;
#pragma unroll
        for (int j = 0; j < 64; ++j) so[(((long)seq * H + h) * DK + 64 * half + j) * DV + dv] = S[j];
    }
};
template <class K, class... A> __device__ __forceinline__ void run_items(long n, A... a) {
    for (long g = (long)blockIdx.x * NTHREADS + threadIdx.x; g < n; g += (long)gridDim.x * NTHREADS) K::run(g, a...);
}

__global__ void __launch_bounds__(NTHREADS, 2) mega_fwd(MArgs args) {
    extern __shared__ __attribute__((aligned(16))) unsigned char lds_raw[];
    cg::grid_group grid = cg::this_grid();
    Frame F;
    F.lds = (LAS unsigned char*)lds_raw; F.tid = threadIdx.x; F.lane = F.tid & 63; F.wave = __builtin_amdgcn_readfirstlane(F.tid >> 6); F.G = gridDim.x;
#pragma unroll
    for (int i = 0; i < 21; ++i) F.in[i] = args.in[i];
    F.out = args.out; F.ws = args.ws;
    const int lo = args.ph_lo, hi = args.ph_hi;
#define IN(k) (lo <= (k) && (k) < hi)
#define SEAM(k) do { if (IN(k) && IN((k) + 1)) grid.sync(); } while (0)
    typedef pg8::StaticOrder SO;
    if (IN(P_PRO)) { p0_prologue(F); } SEAM(P_PRO);
    if (IN(P_FFN1A)) {
        pg8::Gemm g{FB(WS_XN1), FB(WS_W1IN), M, 2 * FF, D}; SO S; S.init(M, 2 * FF, F.G, (int)blockIdx.x);
        pg8::EpiSwiglu E{FB(WS_HB), FF, nullptr};
        pg8::gemm_phase<pg8::EpiSwiglu, SO, true, true>(F.lds, g, S, E);
    } SEAM(P_FFN1A);
    if (IN(P_FFN1B)) {
        pg8::Gemm g{FB(WS_HB), FB(WS_W1OUT), M, D, FF}; SO S; S.init(M, D, F.G, (int)blockIdx.x);
        pg8::EpiResid E{F.in[I_XP], F.in[I_XS], MP, 0.5f, FF32(WS_X1), FB(WS_X1B), FF32(WS_SSQ1)};
        pg8::gemm_phase<pg8::EpiResid, SO, true, true>(F.lds, g, S, E);
    } SEAM(P_FFN1B);
    if (IN(P_INPROJ)) {
        ab_tiles(F);
        pg8::Gemm g{FB(WS_X1B), FB(WS_WIN), M, 7680, D}; SO S; S.init(M, 7680, F.G, (int)blockIdx.x);
        pg8::EpiInProj E{FB(WS_RAW), FB(WS_Z), FB(WS_QS), FB(WS_KS), FB(WS_VS), FB(WS_GA), FB(WS_GB), FF32(WS_SSQ1)};
        pg8::gemm_phase<pg8::EpiInProj, SO, true, true>(F.lds, g, S, E);
    } SEAM(P_INPROJ);
#if MK_EMBED_NB
    if (IN(P_PREP)) {
        run_items<nv::OutConv>((long)(BATCH + DB) * 3 * CONV, (const bf16_t*)FB(WS_RAW), F.out + O_CP, F.out + O_CS);
        run_items<nv::Rope>((long)M * 160, FB(WS_QS), FB(WS_KS));
        grid.sync();
        run_items<nv::ConvInPlace>((long)(BATCH + DB) * CONV, FB(WS_RAW), F.in[I_SCONV], F.in[I_CONVW]);
        run_items<nv::OutKV>((long)(BATCH + DB) * WIN * 256, (const bf16_t*)FB(WS_KS), (const bf16_t*)FB(WS_VS), F.in[I_CK], F.in[I_CV], F.out + O_KP, F.out + O_KS, F.out + O_VP, F.out + O_VS);
        grid.sync();
        run_items<nv::L2norm>((long)M * 16, FB(WS_RAW));
    } SEAM(P_PREP);
    if (IN(P_MIXER)) {
        run_items<Gdn2>((long)(BATCH + DB) * H * DV * 2, (const float*)FF32(WS_AB), (const bf16_t*)FB(WS_RAW), F.in[I_SGDN], F.in[I_ALOG], F.in[I_DTB], FB(WS_OG), F.out + O_GP, F.out + O_GS);
        run_items<nv::SwaPrompt>((long)MP * QH, FB(WS_QS), (const bf16_t*)FB(WS_KS), (const bf16_t*)FB(WS_VS), F.in[I_SINKS]);
        run_items<nv::SwaSample>((long)MS * QH, FB(WS_QS), (const bf16_t*)FB(WS_KS), (const bf16_t*)FB(WS_VS), F.in[I_CK], F.in[I_CV], F.in[I_SINKS]);
    } SEAM(P_MIXER);
    if (IN(P_MERGE)) {
        run_items<nv::Mix>((long)M * H, (const bf16_t*)FB(WS_Z), FB(WS_GA), (const bf16_t*)FB(WS_GB), (const bf16_t*)FB(WS_OG), (const bf16_t*)FB(WS_OS), F.in[I_GNORM]);
    } SEAM(P_MERGE);
#endif
    if (IN(P_OUTPROJ)) {
        pg8::Gemm g{FB(WS_MIXED), FB(WS_WOUT), M, D, D}; SO S; S.init(M, D, F.G, (int)blockIdx.x);
        pg8::EpiResid E{FF32(WS_X1), FF32(WS_X1), M, 1.0f, FF32(WS_X1), FB(WS_X2B), FF32(WS_SSQ2)};
        pg8::gemm_phase<pg8::EpiResid, SO, true, true>(F.lds, g, S, E);
    } SEAM(P_OUTPROJ);
    if (IN(P_FFN2A)) {
        pg8::Gemm g{FB(WS_X2B), FB(WS_W2IN), M, 2 * FF, D}; SO S; S.init(M, 2 * FF, F.G, (int)blockIdx.x);
        pg8::EpiSwiglu E{FB(WS_HB), FF, FF32(WS_SSQ2)};
        pg8::gemm_phase<pg8::EpiSwiglu, SO, true, true>(F.lds, g, S, E);
    } SEAM(P_FFN2A);
    if (IN(P_FFN2B)) {
        pg8::Gemm g{FB(WS_HB), FB(WS_W2OUT), M, D, FF}; SO S; S.init(M, D, F.G, (int)blockIdx.x);
        pg8::EpiResid E{FF32(WS_X1), FF32(WS_X1), M, 0.5f, F.out + O_YP, nullptr, FF32(WS_SSQ3)};
        pg8::gemm_phase<pg8::EpiResid, SO, true, true>(F.lds, g, S, E);
    } SEAM(P_FFN2B);
    if (IN(P_FINAL)) { final_norm(F); }
#undef IN
#undef SEAM
}

static int g_grid = 0;
static bool mega_setup() {
    if (g_grid != 0) return g_grid > 0;
    int dev = 0, cus = 0, per_cu = 0;
    if (hipGetDevice(&dev) != hipSuccess || hipDeviceGetAttribute(&cus, hipDeviceAttributeMultiprocessorCount, dev) != hipSuccess) { g_grid = -1; return false; }
    if (hipFuncSetAttribute((const void*)mega_fwd, hipFuncAttributeMaxDynamicSharedMemorySize, LDS_BYTES) != hipSuccess) { fprintf(stderr, "mega: hipFuncSetAttribute failed\n"); g_grid = -1; return false; }
    if (hipOccupancyMaxActiveBlocksPerMultiprocessor(&per_cu, (const void*)mega_fwd, NTHREADS, LDS_BYTES) != hipSuccess || per_cu < 1) { fprintf(stderr, "mega: occupancy query says %d blocks per CU\n", per_cu); g_grid = -1; return false; }
    g_grid = cus;
    return true;
}
static void mega_launch(void* const* d_in, void* d_out, void* d_ws, int ph_lo, int ph_hi, hipStream_t stream) {
    if (!mega_setup()) return;
    MArgs a{};
    for (int i = 0; i < 21; ++i) a.in[i] = (const float*)d_in[i];
    a.out = (float*)d_out; a.ws = (unsigned char*)d_ws; a.ph_lo = ph_lo; a.ph_hi = ph_hi;
    void* kargs[] = {&a};
    const hipError_t e = hipLaunchCooperativeKernel((const void*)mega_fwd, dim3(g_grid), dim3(NTHREADS), kargs, LDS_BYTES, stream);
    if (e != hipSuccess) fprintf(stderr, "mega: cooperative launch failed: %s (grid %d)\n", hipGetErrorString(e), g_grid);
}
}
#endif
#ifdef CPU_EMU
typedef int hipStream_t;
#endif

struct Ptrs {
    const float *x_prompt, *x_sample, *state_conv, *state_gdn, *cache_k, *cache_v, *norm_ffn1, *w_ffn1_in, *w_ffn1_out, *norm_mix, *w_in, *conv_w,
                *a_log, *dt_bias, *gdn_norm, *sinks, *w_out, *norm_ffn2, *w_ffn2_in, *w_ffn2_out, *norm_final;
    float* out; unsigned char* ws;
};
static Ptrs make_ptrs(void* const* d_in, void* d_out, void* d_ws) {
    Ptrs p;
    p.x_prompt = (const float*)d_in[0]; p.x_sample = (const float*)d_in[1]; p.state_conv = (const float*)d_in[2]; p.state_gdn = (const float*)d_in[3];
    p.cache_k = (const float*)d_in[4]; p.cache_v = (const float*)d_in[5]; p.norm_ffn1 = (const float*)d_in[6]; p.w_ffn1_in = (const float*)d_in[7];
    p.w_ffn1_out = (const float*)d_in[8]; p.norm_mix = (const float*)d_in[9]; p.w_in = (const float*)d_in[10]; p.conv_w = (const float*)d_in[11];
    p.a_log = (const float*)d_in[12]; p.dt_bias = (const float*)d_in[13]; p.gdn_norm = (const float*)d_in[14]; p.sinks = (const float*)d_in[15];
    p.w_out = (const float*)d_in[16]; p.norm_ffn2 = (const float*)d_in[17]; p.w_ffn2_in = (const float*)d_in[18]; p.w_ffn2_out = (const float*)d_in[19];
    p.norm_final = (const float*)d_in[20]; p.out = (float*)d_out; p.ws = (unsigned char*)d_ws; return p;
}
#define WSB(off) ((bf16_t*)(p.ws + lay::off))
#define WSF(off) ((float*)(p.ws + lay::off))

static void nb_ffn1(const Ptrs& p, hipStream_t stream) {
    using namespace cfg; using namespace nv;
    NV_LAUNCH(RmsnormIn, M, p.x_prompt, p.x_sample, p.norm_ffn1, WSB(WS_XN1));
    NV_LAUNCH(GemmSwiglu, (long)(M / 4) * (FF / 4), (const bf16_t*)WSB(WS_XN1), p.w_ffn1_in, WSB(WS_HB), D);
    NV_LAUNCH(Gemm<float>, (long)(M / 4) * (D / 4), (const bf16_t*)WSB(WS_HB), FF, p.w_ffn1_out, D, WSF(WS_T1), D, D, FF);
    NV_LAUNCH(AxpyIn, (long)M * D, p.x_prompt, p.x_sample, (const float*)WSF(WS_T1), 0.5f, WSF(WS_X1));
}
static void nb_inproj(const Ptrs& p, hipStream_t stream) {
    using namespace cfg; using namespace nv;
    NV_LAUNCH(Rmsnorm<bf16_t>, M, (const float*)WSF(WS_X1), p.norm_mix, WSB(WS_X1B));
    const bf16_t* A = WSB(WS_X1B);
    NV_LAUNCH(Gemm<bf16_t>, (long)(M / 4) * (CONV / 4), A, D, p.w_in + U_RAW, DIN, WSB(WS_RAW), CONV, CONV, D);
    NV_LAUNCH(Gemm<bf16_t>, (long)(M / 4) * (1024 / 4), A, D, p.w_in + U_Z, DIN, WSB(WS_Z), 1024, 1024, D);
    NV_LAUNCH(Gemm<float>, (long)(M / 4) * (16 / 4), A, D, p.w_in + U_A, DIN, WSF(WS_AB), 16, 16, D);
    NV_LAUNCH(Gemm<bf16_t>, (long)(M / 4) * (1024 / 4), A, D, p.w_in + U_QS, DIN, WSB(WS_QS), 1024, 1024, D);
    NV_LAUNCH(Gemm<bf16_t>, (long)(M / 4) * (256 / 4), A, D, p.w_in + U_KS, DIN, WSB(WS_KS), 256, 256, D);
    NV_LAUNCH(Gemm<bf16_t>, (long)(M / 4) * (256 / 4), A, D, p.w_in + U_VS, DIN, WSB(WS_VS), 256, 256, D);
    NV_LAUNCH(Gemm<bf16_t>, (long)(M / 4) * (1024 / 4), A, D, p.w_in + U_GA, DIN, WSB(WS_GA), 1024, 1024, D);
    NV_LAUNCH(Gemm<bf16_t>, (long)(M / 4) * (1024 / 4), A, D, p.w_in + U_GB, DIN, WSB(WS_GB), 1024, 1024, D);
}
static void nb_mixer(const Ptrs& p, hipStream_t stream) {
    using namespace cfg; using namespace nv;
    float* out = p.out;
    NV_LAUNCH(OutConv, (long)(BATCH + DB) * 3 * CONV, (const bf16_t*)WSB(WS_RAW), out + O_CP, out + O_CS);
    NV_LAUNCH(ConvInPlace, (long)(BATCH + DB) * CONV, WSB(WS_RAW), p.state_conv, p.conv_w);
    NV_LAUNCH(L2norm, (long)M * 16, WSB(WS_RAW));
    NV_LAUNCH(Gdn, (long)(BATCH + DB) * H * DV, (const float*)WSF(WS_AB), (const bf16_t*)WSB(WS_RAW), p.state_gdn, p.a_log, p.dt_bias, WSB(WS_OG), out + O_GP, out + O_GS);
    NV_LAUNCH(Rope, (long)M * 160, WSB(WS_QS), WSB(WS_KS));
    NV_LAUNCH(OutKV, (long)(BATCH + DB) * WIN * 256, (const bf16_t*)WSB(WS_KS), (const bf16_t*)WSB(WS_VS), p.cache_k, p.cache_v, out + O_KP, out + O_KS, out + O_VP, out + O_VS);
    NV_LAUNCH(SwaPrompt, (long)MP * QH, WSB(WS_QS), (const bf16_t*)WSB(WS_KS), (const bf16_t*)WSB(WS_VS), p.sinks);
    NV_LAUNCH(SwaSample, (long)MS * QH, WSB(WS_QS), (const bf16_t*)WSB(WS_KS), (const bf16_t*)WSB(WS_VS), p.cache_k, p.cache_v, p.sinks);
    NV_LAUNCH(Mix, (long)M * H, (const bf16_t*)WSB(WS_Z), WSB(WS_GA), (const bf16_t*)WSB(WS_GB), (const bf16_t*)WSB(WS_OG), (const bf16_t*)WSB(WS_OS), p.gdn_norm);
}
static void nb_tail(const Ptrs& p, hipStream_t stream) {
    using namespace cfg; using namespace nv;
    NV_LAUNCH(Gemm<float>, (long)(M / 4) * (D / 4), (const bf16_t*)WSB(WS_MIXED), 1024, p.w_out, D, WSF(WS_T1), D, D, 1024);
    NV_LAUNCH(Axpy, (long)M * D, (const float*)WSF(WS_X1), (const float*)WSF(WS_T1), 1.0f, WSF(WS_X1));
    NV_LAUNCH(Rmsnorm<bf16_t>, M, (const float*)WSF(WS_X1), p.norm_ffn2, WSB(WS_X2B));
    NV_LAUNCH(GemmSwiglu, (long)(M / 4) * (FF / 4), (const bf16_t*)WSB(WS_X2B), p.w_ffn2_in, WSB(WS_HB), D);
    NV_LAUNCH(Gemm<float>, (long)(M / 4) * (D / 4), (const bf16_t*)WSB(WS_HB), FF, p.w_ffn2_out, D, WSF(WS_T1), D, D, FF);
    NV_LAUNCH(Axpy, (long)M * D, (const float*)WSF(WS_X1), (const float*)WSF(WS_T1), 0.5f, WSF(WS_X1));
    NV_LAUNCH(Rmsnorm<float>, M, (const float*)WSF(WS_X1), p.norm_final, p.out + O_YP);
}
extern "C" void kernel_launch(void* const* d_in, const int* in_sizes, int n_in, void* d_out, int out_size, void* d_ws, size_t ws_size, hipStream_t stream) {
    (void)in_sizes; (void)n_in; (void)out_size;
    if (ws_size < lay::WS_END) return;
#ifndef CPU_EMU
    mk::mega_launch(d_in, d_out, d_ws, mk::P_PRO, mk::P_COUNT, stream);
#else
    const Ptrs p = make_ptrs(d_in, d_out, d_ws);
    nb_ffn1(p, stream); nb_inproj(p, stream); nb_mixer(p, stream); nb_tail(p, stream);
#endif
}
```

```cpp
#ifndef CPU_EMU
#include <hip/hip_runtime.h>
#endif
#include <cmath>
#include <cstdint>
#include <cstddef>

#ifndef CFG_D_MODEL
#define CFG_D_MODEL 1024
#define CFG_BATCH 4
#define CFG_SEQ 4096
#define CFG_DEC_BATCH 128
#define CFG_DEC_SEQ 8
#define CFG_D_FF 2816
#endif
namespace cfg {
constexpr int D = CFG_D_MODEL, BATCH = CFG_BATCH, SEQ = CFG_SEQ, DB = CFG_DEC_BATCH, DS = CFG_DEC_SEQ, FF = CFG_D_FF;
constexpr int PAST = 16384;
constexpr int MP = BATCH * SEQ, MS = DB * DS, M = MP + MS;
constexpr int H = 8, DK = 128, DV = 128, CONV = 3072, QH = 16, KVH = 4, HD = 64, WIN = 128;
constexpr int DIN = 3072 + 1024 + 16 + 1024 + 256 + 256 + 2 * D;
constexpr int U_RAW = 0, U_Z = 3072, U_A = 4096, U_B = 4104, U_QS = 4112, U_KS = 5136, U_VS = 5392, U_GA = 5648, U_GB = 5648 + D;
constexpr float EPS = 1e-6f;
constexpr size_t O_YP = 0, O_YS = O_YP + (size_t)MP * D, O_CP = O_YS + (size_t)MS * D, O_CS = O_CP + (size_t)BATCH * 3 * CONV,
                 O_GP = O_CS + (size_t)DB * 3 * CONV, O_GS = O_GP + (size_t)BATCH * H * DK * DV, O_KP = O_GS + (size_t)DB * H * DK * DV,
                 O_KS = O_KP + (size_t)BATCH * WIN * KVH * HD, O_VP = O_KS + (size_t)DB * WIN * KVH * HD,
                 O_VS = O_VP + (size_t)BATCH * WIN * KVH * HD, O_END = O_VS + (size_t)DB * WIN * KVH * HD;
}

#ifdef CPU_EMU
#define HDI inline
template <class K, class... A> void nv_launch(long n, A... a) { for (long g = 0; g < n; ++g) K::run(g, a...); }
#define NV_LAUNCH(K, n, ...) nv_launch<K>((long)(n), __VA_ARGS__)
#else
#define HDI __device__ __forceinline__
template <class K, class... A> __global__ void __launch_bounds__(256) nv_kernel(long n, A... a) {
    for (long g = (long)blockIdx.x * blockDim.x + threadIdx.x; g < n; g += (long)gridDim.x * blockDim.x) K::run(g, a...);
}
#define NV_LAUNCH(K, n, ...) do { long _n = (long)(n); long _b = (_n + 255) / 256; if (_b > 65536 * 4) _b = 65536 * 4; if (_b < 1) _b = 1; \
    nv_kernel<K><<<dim3((unsigned)_b), dim3(256), 0, stream>>>(_n, __VA_ARGS__); } while (0)
#endif

typedef unsigned short bf16_t;
namespace lay {
using namespace cfg;
constexpr size_t MiB = (size_t)1 << 20;
constexpr size_t WS_CTL = 0, WS_W1IN = 1 * MiB, WS_W1OUT = 12 * MiB, WS_WIN = 18 * MiB, WS_WAB = 33 * MiB, WS_WOUT = 34 * MiB, WS_W2IN = 36 * MiB, WS_W2OUT = 47 * MiB;
constexpr size_t WS_SSQ1 = 53 * MiB, WS_SSQ2 = 55 * MiB, WS_SSQ3 = 57 * MiB, WS_AB = 59 * MiB;
constexpr size_t WS_XN1 = 62 * MiB, WS_X2B = WS_XN1, WS_X1B = 96 * MiB, WS_X1 = 130 * MiB, WS_RAW = 198 * MiB, WS_Z = 300 * MiB, WS_QS = 334 * MiB, WS_OS = WS_QS;
constexpr size_t WS_KS = 368 * MiB, WS_VS = 377 * MiB, WS_GA = 386 * MiB, WS_MIXED = WS_GA, WS_GB = 420 * MiB, WS_OG = 454 * MiB, WS_HB = 488 * MiB, WS_END = 671 * MiB;
constexpr size_t WS_WK = 488 * MiB, WS_QG = 520 * MiB, WS_KGT = 552 * MiB, WS_QKP = 584 * MiB, WS_UV = 600 * MiB, WS_GL = 664 * MiB, WS_QKVS = 665 * MiB;
constexpr size_t WS_T1 = WS_RAW;
static_assert((size_t)M * D * 2 <= 34 * MiB && (size_t)M * D * 4 <= 68 * MiB && (size_t)M * CONV * 2 <= 102 * MiB && (size_t)M * FF * 2 <= 144 * MiB && (size_t)M * 256 * 2 <= 9 * MiB && (size_t)M * 16 * 4 <= 2 * MiB, "layout");
constexpr size_t WS_VN = 1 * MiB, WS_QN = 62 * MiB, WS_KN = 94 * MiB;
static_assert((size_t)MP * 1024 * 2 <= 32 * MiB, "layout");
}
namespace nv {
using namespace cfg;
HDI float bf2f(bf16_t v) { union { unsigned u; float f; } c; c.u = (unsigned)v << 16; return c.f; }
HDI bf16_t f2bf(float f) { union { unsigned u; float f; } c; c.f = f; return (bf16_t)((c.u + 0x7fffu + ((c.u >> 16) & 1u)) >> 16); }
HDI float ld(const float* p) { return *p; }
HDI float ld(const bf16_t* p) { return bf2f(*p); }
HDI void st(float* p, float v) { *p = v; }
HDI void st(bf16_t* p, float v) { *p = f2bf(v); }
HDI float silu_f(float x) { return x / (1.0f + expf(-x)); }
HDI float sigmoid_f(float x) { return 1.0f / (1.0f + expf(-x)); }
HDI float softplus_f(float x) { return x > 20.f ? x : log1pf(expf(x)); }
HDI const float* xrow(const float* xp, const float* xs, long r) { return r < MP ? xp + r * D : xs + (r - MP) * D; }

struct RmsnormIn {
    static HDI void run(long r, const float* xp, const float* xs, const float* w, bf16_t* out) {
        const float* xr = xrow(xp, xs, r); float s = 0.f;
        for (int c = 0; c < D; ++c) s += xr[c] * xr[c];
        const float rs = 1.0f / sqrtf(s / (float)D + EPS);
        for (int c = 0; c < D; ++c) out[r * D + c] = f2bf(xr[c] * rs * w[c]);
    }
};
template <class TO> struct Rmsnorm {
    static HDI void run(long r, const float* x, const float* w, TO* out) {
        const float* xr = x + r * D; float s = 0.f;
        for (int c = 0; c < D; ++c) s += xr[c] * xr[c];
        const float rs = 1.0f / sqrtf(s / (float)D + EPS);
        for (int c = 0; c < D; ++c) st(out + r * D + c, xr[c] * rs * w[c]);
    }
};
template <class TC> struct Gemm {
    static HDI void run(long g, const bf16_t* A, int lda, const float* B, int ldb, TC* C, int ldc, int N, int K) {
        const int nq = N / 4; const long mi = g / nq; const int ni = (int)(g % nq);
        float acc[4][4];
#pragma unroll
        for (int i = 0; i < 4; ++i)
#pragma unroll
            for (int j = 0; j < 4; ++j) acc[i][j] = 0.f;
        const bf16_t* a0 = A + (mi * 4) * lda; const float* bp = B + ni * 4;
        for (int k = 0; k < K; ++k) {
            const float b0 = bp[(long)k * ldb], b1 = bp[(long)k * ldb + 1], b2 = bp[(long)k * ldb + 2], b3 = bp[(long)k * ldb + 3];
#pragma unroll
            for (int i = 0; i < 4; ++i) { const float a = bf2f(a0[(long)i * lda + k]); acc[i][0] += a * b0; acc[i][1] += a * b1; acc[i][2] += a * b2; acc[i][3] += a * b3; }
        }
#pragma unroll
        for (int i = 0; i < 4; ++i)
#pragma unroll
            for (int j = 0; j < 4; ++j) st(C + (mi * 4 + i) * ldc + ni * 4 + j, acc[i][j]);
    }
};
struct GemmSwiglu {
    static HDI void run(long g, const bf16_t* A, const float* B, bf16_t* Hh, int K) {
        const int nq = FF / 4; const long mi = g / nq; const int ni = (int)(g % nq);
        float ag[4][4], au[4][4];
#pragma unroll
        for (int i = 0; i < 4; ++i)
#pragma unroll
            for (int j = 0; j < 4; ++j) { ag[i][j] = 0.f; au[i][j] = 0.f; }
        const bf16_t* a0 = A + (mi * 4) * K; const float* bp = B + ni * 4;
        for (int k = 0; k < K; ++k) {
            float bg[4], bu[4];
#pragma unroll
            for (int j = 0; j < 4; ++j) { bg[j] = bp[(long)k * 2 * FF + j]; bu[j] = bp[(long)k * 2 * FF + FF + j]; }
#pragma unroll
            for (int i = 0; i < 4; ++i) { const float a = bf2f(a0[(long)i * K + k]);
#pragma unroll
                for (int j = 0; j < 4; ++j) { ag[i][j] += a * bg[j]; au[i][j] += a * bu[j]; } }
        }
#pragma unroll
        for (int i = 0; i < 4; ++i)
#pragma unroll
            for (int j = 0; j < 4; ++j) Hh[(mi * 4 + i) * FF + ni * 4 + j] = f2bf(silu_f(ag[i][j]) * au[i][j]);
    }
};
struct AxpyIn {
    static HDI void run(long g, const float* xp, const float* xs, const float* T, float alpha, float* out) { const long r = g / D; const int c = (int)(g % D); out[g] = xrow(xp, xs, r)[c] + alpha * T[g]; }
};
struct Axpy {
    static HDI void run(long g, const float* a, const float* b, float alpha, float* out) { out[g] = a[g] + alpha * b[g]; }
};
HDI void row_info(long r, int& is_s, int& seq, int& t, int& L, long& base) {
    if (r < MP) { is_s = 0; seq = (int)(r / SEQ); t = (int)(r % SEQ); L = SEQ; base = (long)seq * SEQ; }
    else { const long rr = r - MP; is_s = 1; seq = (int)(rr / DS); t = (int)(rr % DS); L = DS; base = MP + (long)seq * DS; }
}
struct ConvInPlace {
    static HDI void run(long g, bf16_t* RAW, const float* state_conv, const float* conv_w) {
        const int c = (int)(g % CONV); const int sq = (int)(g / CONV);
        const int is_s = sq >= BATCH; const int seq = is_s ? sq - BATCH : sq; const int L = is_s ? DS : SEQ;
        const long base = is_s ? MP + (long)seq * DS : (long)seq * SEQ;
        const float w0 = conv_w[0 * CONV + c], w1 = conv_w[1 * CONV + c], w2 = conv_w[2 * CONV + c], w3 = conv_w[3 * CONV + c];
        float e0 = is_s ? state_conv[((long)seq * 3 + 0) * CONV + c] : 0.f;
        float e1 = is_s ? state_conv[((long)seq * 3 + 1) * CONV + c] : 0.f;
        float e2 = is_s ? state_conv[((long)seq * 3 + 2) * CONV + c] : 0.f;
        for (int t = 0; t < L; ++t) {
            const float e3 = bf2f(RAW[(base + t) * CONV + c]);
            RAW[(base + t) * CONV + c] = f2bf(silu_f(w0 * e0 + w1 * e1 + w2 * e2 + w3 * e3));
            e0 = e1; e1 = e2; e2 = e3;
        }
    }
};
struct L2norm {
    static HDI void run(long g, bf16_t* QKV) {
        const long r = g / 16; const int hh = (int)(g % 16);
        bf16_t* p = QKV + r * CONV + hh * 128; float s = 0.f;
        for (int j = 0; j < 128; ++j) { const float v = bf2f(p[j]); s += v * v; }
        const float rs = 1.0f / sqrtf(s + EPS);
        for (int j = 0; j < 128; ++j) p[j] = f2bf(bf2f(p[j]) * rs);
    }
};
struct Gdn {
    static HDI void run(long g, const float* AB, const bf16_t* QKV, const float* state_gdn, const float* a_log, const float* dt_bias,
                        bf16_t* OG, float* out_gp, float* out_gs) {
        const int dv = (int)(g % DV); const int h = (int)((g / DV) % H); const int sq = (int)(g / (DV * H));
        const int is_s = sq >= BATCH; const int seq = is_s ? sq - BATCH : sq; const int L = is_s ? DS : SEQ;
        const long base = is_s ? MP + (long)seq * DS : (long)seq * SEQ;
        float S[DK];
#pragma unroll
        for (int j = 0; j < DK; ++j) S[j] = is_s ? state_gdn[(((long)seq * H + h) * DK + j) * DV + dv] : 0.f;
        const float ea = expf(a_log[h]), dtb = dt_bias[h];
        for (int t = 0; t < L; ++t) {
            const long r = base + t;
            const float a = AB[r * 16 + h], b = AB[r * 16 + 8 + h];
            const float gg = -ea * softplus_f(a + dtb), beta = sigmoid_f(b), alpha = expf(gg);
            const bf16_t* q = QKV + r * CONV + h * DK; const bf16_t* k = QKV + r * CONV + 1024 + h * DK;
            const float v = bf2f(QKV[r * CONV + 2048 + h * DV + dv]);
            float ks = 0.f;
#pragma unroll
            for (int j = 0; j < DK; ++j) ks += bf2f(k[j]) * S[j];
            const float vn = beta * (v - alpha * ks);
            float o = 0.f;
#pragma unroll
            for (int j = 0; j < DK; ++j) { S[j] = alpha * S[j] + bf2f(k[j]) * vn; o += bf2f(q[j]) * S[j]; }
            OG[r * 1024 + h * DV + dv] = f2bf(o * 0.08838834764831845f);
        }
        float* so = is_s ? out_gs : out_gp;
#pragma unroll
        for (int j = 0; j < DK; ++j) so[(((long)seq * H + h) * DK + j) * DV + dv] = S[j];
    }
};
struct Rope {
    static HDI void run(long g, bf16_t* QS, bf16_t* KS) {
        const int i = (int)(g % 8); const int hh = (int)((g / 8) % 20); const long r = g / 160;
        int is_s, seq, t, L; long base; row_info(r, is_s, seq, t, L, base);
        const float pos = (float)(is_s ? PAST + t : t);
        const float inv = powf(500000.0f, -(float)(2 * i) / 16.0f);
        const float ang = pos * inv; const float cs = cosf(ang), sn = sinf(ang);
        bf16_t* p = hh < 16 ? QS + r * 1024 + hh * 64 : KS + r * 256 + (hh - 16) * 64;
        const float x1 = bf2f(p[i]), x2 = bf2f(p[i + 8]);
        p[i] = f2bf(x1 * cs - x2 * sn); p[i + 8] = f2bf(x2 * cs + x1 * sn);
    }
};
struct SwaPrompt {
    static HDI void run(long g, bf16_t* QS, const bf16_t* KS, const bf16_t* VS, const float* sinks) {
        const int qh = (int)(g % QH); const long r = g / QH; const int b = (int)(r / SEQ), t = (int)(r % SEQ); const int kvh = qh / 4;
        float q[HD], o[HD];
#pragma unroll
        for (int d = 0; d < HD; ++d) { q[d] = bf2f(QS[r * 1024 + qh * HD + d]); o[d] = 0.f; }
        float m = sinks[qh], l = 1.0f;
        const int j0 = t - (WIN - 1) < 0 ? 0 : t - (WIN - 1);
        for (int j = j0; j <= t; ++j) {
            const long rk = (long)b * SEQ + j; const bf16_t* kp = KS + rk * 256 + kvh * HD; const bf16_t* vp = VS + rk * 256 + kvh * HD;
            float s = 0.f;
#pragma unroll
            for (int d = 0; d < HD; ++d) s += q[d] * bf2f(kp[d]);
            s *= 0.125f;
            const float mn = fmaxf(m, s), sc = expf(m - mn), p = expf(s - mn);
            l = l * sc + p;
#pragma unroll
            for (int d = 0; d < HD; ++d) o[d] = o[d] * sc + p * bf2f(vp[d]);
            m = mn;
        }
        const float il = 1.0f / l;
#pragma unroll
        for (int d = 0; d < HD; ++d) QS[r * 1024 + qh * HD + d] = f2bf(o[d] * il);
    }
};
struct SwaSample {
    static HDI void run(long g, bf16_t* QS, const bf16_t* KS, const bf16_t* VS, const float* ck, const float* cv, const float* sinks) {
        const int qh = (int)(g % QH); const long rr = g / QH; const int b = (int)(rr / DS), t = (int)(rr % DS); const int kvh = qh / 4;
        const long r = MP + rr;
        float q[HD], o[HD];
#pragma unroll
        for (int d = 0; d < HD; ++d) { q[d] = bf2f(QS[r * 1024 + qh * HD + d]); o[d] = 0.f; }
        float m = sinks[qh], l = 1.0f;
        for (int j = t + 1; j < WIN + t + 1; ++j) {
            float s = 0.f; float vv[HD];
            if (j < WIN) { const float* kp = ck + (((long)b * WIN + j) * KVH + kvh) * HD; const float* vp = cv + (((long)b * WIN + j) * KVH + kvh) * HD;
#pragma unroll
                for (int d = 0; d < HD; ++d) { s += q[d] * kp[d]; vv[d] = vp[d]; } }
            else { const long rk = MP + (long)b * DS + (j - WIN); const bf16_t* kp = KS + rk * 256 + kvh * HD; const bf16_t* vp = VS + rk * 256 + kvh * HD;
#pragma unroll
                for (int d = 0; d < HD; ++d) { s += q[d] * bf2f(kp[d]); vv[d] = bf2f(vp[d]); } }
            s *= 0.125f;
            const float mn = fmaxf(m, s), sc = expf(m - mn), p = expf(s - mn);
            l = l * sc + p;
#pragma unroll
            for (int d = 0; d < HD; ++d) o[d] = o[d] * sc + p * vv[d];
            m = mn;
        }
        const float il = 1.0f / l;
#pragma unroll
        for (int d = 0; d < HD; ++d) QS[r * 1024 + qh * HD + d] = f2bf(o[d] * il);
    }
};
struct Mix {
    static HDI void run(long g, const bf16_t* Z, bf16_t* GA, const bf16_t* GB, const bf16_t* OG, const bf16_t* OS, const float* gdn_norm) {
        const int h = (int)(g % H); const long r = g / H;
        const bf16_t* og = OG + r * 1024 + h * DV; float s = 0.f;
        for (int j = 0; j < DV; ++j) { const float v = bf2f(og[j]); s += v * v; }
        const float rs = 1.0f / sqrtf(s / (float)DV + EPS);
        for (int j = 0; j < DV; ++j) {
            const long c = r * 1024 + h * DV + j;
            const float z = bf2f(Z[c]), ga = bf2f(GA[c]), gb = bf2f(GB[c]);
            GA[c] = f2bf(sigmoid_f(ga) * (bf2f(og[j]) * rs * gdn_norm[j] * silu_f(z)) + sigmoid_f(gb) * bf2f(OS[c]));
        }
    }
};
struct OutConv {
    static HDI void run(long g, const bf16_t* RAW, float* out_cp, float* out_cs) {
        const int c = (int)(g % CONV); const int i = (int)((g / CONV) % 3); const int sq = (int)(g / (3 * CONV));
        const int is_s = sq >= BATCH; const int seq = is_s ? sq - BATCH : sq; const int L = is_s ? DS : SEQ;
        const long base = is_s ? MP + (long)seq * DS : (long)seq * SEQ;
        const float v = bf2f(RAW[(base + L - 3 + i) * CONV + c]);
        (is_s ? out_cs : out_cp)[((long)seq * 3 + i) * CONV + c] = v;
    }
};
struct OutKV {
    static HDI void run(long g, const bf16_t* KS, const bf16_t* VS, const float* ck, const float* cv, float* out_kp, float* out_ks, float* out_vp, float* out_vs) {
        const int c = (int)(g % 256); const int j = (int)((g / 256) % WIN); const int sq = (int)(g / (256 * WIN));
        if (sq < BATCH) {
            const long r = (long)sq * SEQ + SEQ - WIN + j;
            out_kp[((long)sq * WIN + j) * 256 + c] = bf2f(KS[r * 256 + c]); out_vp[((long)sq * WIN + j) * 256 + c] = bf2f(VS[r * 256 + c]);
        } else {
            const int b = sq - BATCH; float kv, vv;
            if (j + DS < WIN) { kv = ck[((long)b * WIN + j + DS) * 256 + c]; vv = cv[((long)b * WIN + j + DS) * 256 + c]; }
            else { const long r = MP + (long)b * DS + (j + DS - WIN); kv = bf2f(KS[r * 256 + c]); vv = bf2f(VS[r * 256 + c]); }
            out_ks[((long)b * WIN + j) * 256 + c] = kv; out_vs[((long)b * WIN + j) * 256 + c] = vv;
        }
    }
};
}
namespace pg8 {
#define PG8_LAS __attribute__((address_space(3)))
typedef short bf16x8 __attribute__((ext_vector_type(8)));
typedef float f32x4 __attribute__((ext_vector_type(4)));
typedef unsigned u32x4 __attribute__((ext_vector_type(4)));
constexpr int BM = 256, BK = 64, HALF = 128, HTB = HALF * BK * 2  , STAGE_BYTES = 8 * HTB, NXCD = 8, WGM = 8;

__host__ __device__ __forceinline__ int lds_byte(int r, int c) { const int st = (r >> 4) * 2 + (c >> 5), rr = r & 15, cc = c & 31, ob = rr * 64 + cc * 2; return st * 1024 + (ob ^ (((ob >> 9) & 1) << 5)); }
__host__ __device__ __forceinline__ void stage_rc(int b, int& R, int& C) { const int st = b / 1024, sb = b % 1024, swz = sb ^ (((sb >> 9) & 1) << 5); R = (st >> 1) * 16 + swz / 64; C = (st & 1) * 32 + (swz % 64) / 2; }
__host__ __device__ __forceinline__ int perm32(int rho) { const int n = rho >> 4, i = rho & 15; return 8 * (i >> 2) + 4 * n + (i & 3); }

struct Unit { int pm, pn; };
struct Gemm { const bf16_t* A; const bf16_t* Bt; int M, N, K; };

struct StaticOrder {
    int nM, nN, nwg, G, c;
    __host__ __device__ void init(int M, int N, int G_, int c_) { nM = M / BM; nN = N / BM; nwg = nM * nN; G = G_; c = c_; }
    __host__ __device__ bool next(int i, Unit& u) const {
        const long L = (long)i * G + c; if (L >= nwg) return false;
        int wgid = (int)L; { const int q = nwg / NXCD, r = nwg % NXCD, xcd = wgid % NXCD, off = wgid / NXCD; wgid = (xcd < r ? xcd * (q + 1) : r * (q + 1) + (xcd - r) * q) + off; }
        const int nig = WGM * nN, gid = wgid / nig, fm = gid * WGM, gsz = (nM - fm) < WGM ? (nM - fm) : WGM;
        u.pm = fm + ((wgid % nig) % gsz); u.pn = (wgid % nig) / gsz; return true;
    }
    __device__ __forceinline__ void a_ready(const Unit&) const {}
    __device__ __forceinline__ void done(const Unit&) const {}
};
typedef unsigned u32x2 __attribute__((ext_vector_type(2)));
__device__ __forceinline__ unsigned cvt_pk_bf16(float lo, float hi) { unsigned r; asm volatile("v_cvt_pk_bf16_f32 %0, %1, %2" : "=v"(r) : "v"(lo), "v"(hi)); return r; }
__device__ __forceinline__ float fast_sigmoid(float x) { return __builtin_amdgcn_rcpf(1.0f + __builtin_amdgcn_exp2f(-1.4426950408889634f * x)); }
__device__ __forceinline__ float fast_silu(float x) { return x * fast_sigmoid(x); }
__device__ __forceinline__ void load_rs(float (&rs)[2][4], const float* ssq, int pm, int wr, int fr, int fq) {
#pragma unroll
    for (int ai = 0; ai < 2; ++ai)
#pragma unroll
        for (int m = 0; m < 4; ++m) {
            const int row = pm * BM + ai * HALF + wr * 64 + m * 16 + fr;
            const f32x4 v = *(const f32x4*)(ssq + (size_t)row * 16 + 4 * fq);
            float s = (v[0] + v[1]) + (v[2] + v[3]);
            s += __shfl_xor(s, 16); s += __shfl_xor(s, 32);
            rs[ai][m] = 1.0f / sqrtf(s * (1.0f / 1024.0f) + 1e-6f);
        }
}
struct EpiSwiglu {
    static constexpr bool PERM = true, AFTER_DRAIN = false;
    bf16_t* Hh; int ldh; const float* ssq;
    __device__ __forceinline__ void operator()(const f32x4 (&acc)[2][2][4][2], const Unit& u, int wr, int wc, int fr, int fq) const {
        float rs[2][4];
        if (ssq) load_rs(rs, ssq, u.pm, wr, fr, fq);
        const int col0 = u.pn * HALF + wc * 32 + 8 * fq;
#pragma unroll
        for (int ai = 0; ai < 2; ++ai)
#pragma unroll
            for (int m = 0; m < 4; ++m) {
                const float r_ = ssq ? rs[ai][m] : 1.0f;
                const int row = u.pm * BM + ai * HALF + wr * 64 + m * 16 + fr;
                float hv[8];
#pragma unroll
                for (int n = 0; n < 2; ++n)
#pragma unroll
                    for (int i = 0; i < 4; ++i) { const float g = acc[ai][0][m][n][i] * r_, up = acc[ai][1][m][n][i] * r_; hv[4 * n + i] = fast_silu(g) * up; }
                u32x4 w; w.x = cvt_pk_bf16(hv[0], hv[1]); w.y = cvt_pk_bf16(hv[2], hv[3]); w.z = cvt_pk_bf16(hv[4], hv[5]); w.w = cvt_pk_bf16(hv[6], hv[7]);
                *(u32x4*)(Hh + (size_t)row * ldh + col0) = w;
            }
    }
};
struct EpiInProj {
    static constexpr bool PERM = true, AFTER_DRAIN = false;
    bf16_t *raw, *z, *qs, *ks, *vs, *ga, *gb; const float* ssq;
    __device__ __forceinline__ void operator()(const f32x4 (&acc)[2][2][4][2], const Unit& u, int wr, int wc, int fr, int fq) const {
        float rs[2][4]; load_rs(rs, ssq, u.pm, wr, fr, fq);
        bf16_t* base; int ldc, colt; const int pn = u.pn;
        if (pn < 12) { base = raw; ldc = 3072; colt = pn * 256; }
        else if (pn < 16) { base = z; ldc = 1024; colt = (pn - 12) * 256; }
        else if (pn < 20) { base = qs; ldc = 1024; colt = (pn - 16) * 256; }
        else if (pn == 20) { base = ks; ldc = 256; colt = 0; }
        else if (pn == 21) { base = vs; ldc = 256; colt = 0; }
        else if (pn < 26) { base = ga; ldc = 1024; colt = (pn - 22) * 256; }
        else { base = gb; ldc = 1024; colt = (pn - 26) * 256; }
        const int col0 = colt + wc * 32 + 8 * fq;
#pragma unroll
        for (int ai = 0; ai < 2; ++ai)
#pragma unroll
            for (int m = 0; m < 4; ++m) {
                const float r_ = rs[ai][m];
                bf16_t* rowp = base + (size_t)(u.pm * BM + ai * HALF + wr * 64 + m * 16 + fr) * ldc + col0;
#pragma unroll
                for (int bj = 0; bj < 2; ++bj) { const f32x4 v0 = acc[ai][bj][m][0] * r_, v1 = acc[ai][bj][m][1] * r_;
                    u32x4 w; w.x = cvt_pk_bf16(v0[0], v0[1]); w.y = cvt_pk_bf16(v0[2], v0[3]); w.z = cvt_pk_bf16(v1[0], v1[1]); w.w = cvt_pk_bf16(v1[2], v1[3]);
                    *(u32x4*)(rowp + bj * HALF) = w; }
            }
    }
};
struct EpiResid {
    static constexpr bool PERM = false, AFTER_DRAIN = false;
    const float* xin_p; const float* xin_s; int split_row; float alpha; float* xout; bf16_t* xb; float* ssq;
    __device__ __forceinline__ void operator()(const f32x4 (&acc)[2][2][4][2], const Unit& u, int wr, int wc, int fr, int fq) const {
        const int col0 = u.pn * BM + wc * 32 + 4 * fq;
#pragma unroll
        for (int ai = 0; ai < 2; ++ai)
#pragma unroll
            for (int m = 0; m < 4; ++m) {
                const int row = u.pm * BM + ai * HALF + wr * 64 + m * 16 + fr;
                const float* xr = (row < split_row ? xin_p + (size_t)row * 1024 : xin_s + (size_t)(row - split_row) * 1024) + col0;
                float* orow = xout + (size_t)row * 1024 + col0;
                float ss = 0.f;
#pragma unroll
                for (int bj = 0; bj < 2; ++bj)
#pragma unroll
                    for (int n = 0; n < 2; ++n) {
                        const f32x4 xi = *(const f32x4*)(xr + bj * HALF + n * 16);
                        const f32x4 o = xi + acc[ai][bj][m][n] * alpha;
                        *(f32x4*)(orow + bj * HALF + n * 16) = o;
                        if (xb) { u32x2 w; w.x = cvt_pk_bf16(o[0], o[1]); w.y = cvt_pk_bf16(o[2], o[3]); *(u32x2*)(xb + (size_t)row * 1024 + col0 + bj * HALF + n * 16) = w; }
                        ss += (o[0] * o[0] + o[1] * o[1]) + (o[2] * o[2] + o[3] * o[3]);
                    }
                ss += __shfl_xor(ss, 16); ss += __shfl_xor(ss, 32);
                if (fq == 0) ssq[(size_t)row * 16 + u.pn * 4 + wc] = ss;
                if (m & 1) asm volatile("" ::: "memory");
            }
    }
};
template <class Epi, class Sched, bool ALIGN_EPI = false, bool SP2 = false>
__device__ __forceinline__ void gemm_phase(PG8_LAS unsigned char* lds, const Gemm g, const Sched& S, const Epi& E) {
    const int tid = threadIdx.x, wid = __builtin_amdgcn_readfirstlane(tid >> 6), lane = tid & 63, wr = wid >> 2, wc = wid & 3, fr = lane & 15, fq = lane >> 4;
    const int K = g.K, nt = K / BK;
    unsigned voffA[2], voffB[2];
#pragma unroll
    for (int i = 0; i < 2; ++i) { int R, C; stage_rc(tid * 16 + i * 8192, R, C); const int Rb = Epi::PERM ? ((R & ~31) + perm32(R & 31)) : R;
        voffA[i] = (unsigned)(R * K + C) * 2u; voffB[i] = (unsigned)(Rb * K + C) * 2u; }
    const size_t kstep = (size_t)(BK * 2);
    const size_t hstep = (size_t)HALF * K * 2;
    const size_t tstep = 2 * hstep;
    const unsigned ldsw = (unsigned)wid * 1024u;
    const int aoff = lds_byte(wr * 64 + fr, fq * 8), boff = lds_byte(wc * 32 + fr, fq * 8);
#define PG8_SA(b, h) (((b) * 2 + (h)) * HTB)
#define PG8_SB(b, h) ((4 + (b) * 2 + (h)) * HTB)
#define PG8_STAGE(bufoff, gbase, voff) do { _Pragma("unroll") for (int _i = 0; _i < 2; ++_i) \
        __builtin_amdgcn_global_load_lds((const unsigned*)((const char*)(gbase) + (voff)[_i]), (PG8_LAS unsigned*)(lds + (bufoff) + ldsw + _i * 8192), 16, 0, 0); } while (0)
#define PG8_LDA(dst, b, h) do { _Pragma("unroll") for (int m = 0; m < 4; ++m) _Pragma("unroll") for (int k = 0; k < 2; ++k) dst[m][k] = *(const PG8_LAS bf16x8*)(lds + PG8_SA(b, h) + aoff + m * 2048 + k * 1024); } while (0)
#define PG8_LDB(dst, b, h) do { _Pragma("unroll") for (int n = 0; n < 2; ++n) _Pragma("unroll") for (int k = 0; k < 2; ++k) dst[n][k] = *(const PG8_LAS bf16x8*)(lds + PG8_SB(b, h) + boff + n * 2048 + k * 1024); } while (0)
#define PG8_MMA(ai, bj, At, Bt) do { __builtin_amdgcn_s_setprio(1); _Pragma("unroll") for (int m = 0; m < 4; ++m) _Pragma("unroll") for (int n = 0; n < 2; ++n) _Pragma("unroll") for (int k = 0; k < 2; ++k) \
        acc[ai][bj][m][n] = __builtin_amdgcn_mfma_f32_16x16x32_bf16(Bt[n][k], At[m][k], acc[ai][bj][m][n], 0, 0, 0); __builtin_amdgcn_s_setprio(0); } while (0)
#define PG8_WAIT_V(n) asm volatile("s_waitcnt vmcnt(" #n ")" ::: "memory")
#define PG8_WAIT_L(n) asm volatile("s_waitcnt lgkmcnt(" #n ")" ::: "memory")
#define PG8_BAR __builtin_amdgcn_s_barrier()
#define PG8_SCHED __builtin_amdgcn_sched_barrier(0)
    Unit cur, nxt; int ui = 0;
    if (!S.next(0, cur)) return;
    f32x4 acc[2][2][4][2];
#pragma unroll
    for (int a = 0; a < 2; ++a)
#pragma unroll
        for (int b = 0; b < 2; ++b)
#pragma unroll
            for (int m = 0; m < 4; ++m)
#pragma unroll
                for (int n = 0; n < 2; ++n) acc[a][b][m][n] = (f32x4){0.f, 0.f, 0.f, 0.f};
    bf16x8 At[4][2], B0[2][2], B1[2][2];
    const char* cA = (const char*)g.A + (size_t)cur.pm * tstep; const char* cB = (const char*)g.Bt + (size_t)cur.pn * tstep;
    S.a_ready(cur);
    if constexpr (SP2) {
        PG8_STAGE(PG8_SB(0, 0), cB, voffB); PG8_STAGE(PG8_SB(0, 1), cB + hstep, voffB); PG8_STAGE(PG8_SA(0, 0), cA, voffA); PG8_STAGE(PG8_SA(0, 1), cA + hstep, voffA);
        if (wr == 1) PG8_BAR;
        PG8_WAIT_V(2); PG8_BAR;
        PG8_STAGE(PG8_SB(1, 0), cB + kstep, voffB); PG8_STAGE(PG8_SA(1, 0), cA + kstep, voffA); PG8_STAGE(PG8_SB(1, 1), cB + hstep + kstep, voffB);
        PG8_WAIT_V(6); PG8_BAR;
    } else {
        PG8_STAGE(PG8_SB(0, 0), cB, voffB); PG8_STAGE(PG8_SA(0, 0), cA, voffA); PG8_STAGE(PG8_SB(0, 1), cB + hstep, voffB); PG8_STAGE(PG8_SA(0, 1), cA + hstep, voffA);
        if (wr == 1) PG8_BAR;
        PG8_WAIT_V(4); PG8_BAR;
        PG8_STAGE(PG8_SB(1, 0), cB + kstep, voffB); PG8_STAGE(PG8_SA(1, 0), cA + kstep, voffA); PG8_STAGE(PG8_SB(1, 1), cB + hstep + kstep, voffB);
        PG8_WAIT_V(6); PG8_BAR;
    }
    for (;;) {
        const bool has_next = S.next(ui + 1, nxt);
        const char* nA = has_next ? (const char*)g.A + (size_t)nxt.pm * tstep : cA; const char* nB = has_next ? (const char*)g.Bt + (size_t)nxt.pn * tstep : cB;
        for (int t = 0; t < nt; t += 2) {
            const bool last = (t == nt - 2);
            const char* a1 = cA + (size_t)(t + 1) * kstep;
            const char* a2 = last ? nA : cA + (size_t)(t + 2) * kstep; const char* b2 = last ? nB : cB + (size_t)(t + 2) * kstep;
            const char* a3 = a2 + kstep; const char* b3 = b2 + kstep;
            if (last && has_next) S.a_ready(nxt);
            if constexpr (SP2) {
            PG8_LDB(B0, 0, 0); PG8_LDB(B1, 0, 1); PG8_SCHED; PG8_LDA(At, 0, 0); PG8_STAGE(PG8_SA(1, 1), a1 + hstep, voffA);
            PG8_WAIT_V(8); PG8_WAIT_L(0); PG8_BAR; PG8_MMA(0, 0, At, B0); PG8_MMA(0, 1, At, B1); PG8_BAR; PG8_SCHED;
            PG8_LDA(At, 0, 1); PG8_STAGE(PG8_SB(0, 0), b2, voffB); PG8_STAGE(PG8_SB(0, 1), b2 + hstep, voffB); PG8_STAGE(PG8_SA(0, 0), a2, voffA);
            PG8_WAIT_V(8); PG8_WAIT_L(0); PG8_BAR; PG8_MMA(1, 0, At, B0); PG8_MMA(1, 1, At, B1); PG8_BAR; PG8_SCHED;
            PG8_LDB(B0, 1, 0); PG8_LDB(B1, 1, 1); PG8_SCHED; PG8_LDA(At, 1, 0); PG8_STAGE(PG8_SA(0, 1), a2 + hstep, voffA);
            PG8_WAIT_V(8); PG8_WAIT_L(0); PG8_BAR; PG8_MMA(0, 0, At, B0); PG8_MMA(0, 1, At, B1); PG8_BAR; PG8_SCHED;
            PG8_LDA(At, 1, 1); PG8_STAGE(PG8_SB(1, 0), b3, voffB); PG8_STAGE(PG8_SB(1, 1), b3 + hstep, voffB); PG8_STAGE(PG8_SA(1, 0), a3, voffA);
            PG8_WAIT_V(8); PG8_WAIT_L(0); PG8_BAR; PG8_MMA(1, 0, At, B0); PG8_MMA(1, 1, At, B1); PG8_BAR; PG8_SCHED;
            } else {
            PG8_LDB(B0, 0, 0); PG8_SCHED; PG8_LDA(At, 0, 0); PG8_STAGE(PG8_SA(1, 1), a1 + hstep, voffA);
            PG8_WAIT_L(8); PG8_BAR; PG8_WAIT_L(0); PG8_MMA(0, 0, At, B0); PG8_BAR; PG8_SCHED;
            PG8_LDB(B1, 0, 1); PG8_STAGE(PG8_SB(0, 0), b2, voffB);
            PG8_BAR; PG8_WAIT_L(0); PG8_MMA(0, 1, At, B1); PG8_BAR;
            PG8_LDA(At, 0, 1); PG8_STAGE(PG8_SA(0, 0), a2, voffA);
            PG8_BAR; PG8_WAIT_L(0); PG8_MMA(1, 0, At, B0); PG8_BAR; PG8_SCHED;
            PG8_STAGE(PG8_SB(0, 1), b2 + hstep, voffB);
            PG8_WAIT_V(6); PG8_BAR; PG8_MMA(1, 1, At, B1); PG8_BAR;
            PG8_LDB(B0, 1, 0); PG8_SCHED; PG8_LDA(At, 1, 0); PG8_STAGE(PG8_SA(0, 1), a2 + hstep, voffA);
            PG8_WAIT_L(8); PG8_BAR; PG8_WAIT_L(0); PG8_MMA(0, 0, At, B0); PG8_BAR; PG8_SCHED;
            PG8_LDB(B1, 1, 1); PG8_STAGE(PG8_SB(1, 0), b3, voffB);
            PG8_BAR; PG8_WAIT_L(0); PG8_MMA(0, 1, At, B1); PG8_BAR;
            PG8_LDA(At, 1, 1); PG8_STAGE(PG8_SA(1, 0), a3, voffA);
            PG8_BAR; PG8_WAIT_L(0); PG8_MMA(1, 0, At, B0); PG8_BAR; PG8_SCHED;
            PG8_STAGE(PG8_SB(1, 1), b3 + hstep, voffB);
            PG8_WAIT_V(6); PG8_BAR; PG8_MMA(1, 1, At, B1); PG8_BAR;
            }
        }
        if constexpr (ALIGN_EPI) { if (wr == 0) PG8_BAR; }
        if constexpr (!Epi::AFTER_DRAIN) { E(acc, cur, wr, wc, fr, fq); S.done(cur); }
        if (!has_next) break;
#pragma unroll
        for (int a = 0; a < 2; ++a)
#pragma unroll
            for (int b = 0; b < 2; ++b)
#pragma unroll
                for (int m = 0; m < 4; ++m)
#pragma unroll
                    for (int n = 0; n < 2; ++n) acc[a][b][m][n] = (f32x4){0.f, 0.f, 0.f, 0.f};
        cur = nxt; cA = nA; cB = nB; ++ui;
        if constexpr (ALIGN_EPI) { if (wr == 1) PG8_BAR; }
    }
    PG8_WAIT_V(0);
    if constexpr (!ALIGN_EPI) { if (wr == 0) PG8_BAR; }
    PG8_BAR;
    if constexpr (Epi::AFTER_DRAIN) { E.fused(acc, cur, wr, wc, fr, fq, lds, wid, lane); S.done(cur); }
#undef PG8_SA
#undef PG8_SB
#undef PG8_STAGE
#undef PG8_LDA
#undef PG8_LDB
#undef PG8_MMA
#undef PG8_WAIT_V
#undef PG8_WAIT_L
#undef PG8_BAR
#undef PG8_SCHED
}
}
#ifndef CPU_EMU
#include <hip/hip_cooperative_groups.h>
#include <cstdio>
namespace mk {
namespace cg = cooperative_groups;
using namespace cfg;
#define LAS __attribute__((address_space(3)))
#define GAS __attribute__((address_space(1)))
typedef float f32x4 __attribute__((ext_vector_type(4)));
typedef unsigned v4u __attribute__((ext_vector_type(4)));
typedef short bf16x8 __attribute__((ext_vector_type(8)));
constexpr int NWAVES = 8, NTHREADS = NWAVES * 64;
constexpr int LDS_BYTES = 163840;
#ifndef MK_EMBED_NB
#define MK_EMBED_NB 1
#endif
enum Phase { P_PRO = 0, P_FFN1A, P_FFN1B, P_INPROJ, P_PREP, P_MIXER, P_MERGE, P_OUTPROJ, P_FFN2A, P_FFN2B, P_FINAL, P_COUNT };

struct MArgs { const float* in[21]; float* out; unsigned char* ws; int ph_lo, ph_hi; };

__device__ __forceinline__ unsigned f2bf_u(float f) { unsigned u = __builtin_bit_cast(unsigned, f); return (u + 0x7fffu + ((u >> 16) & 1u)) >> 16; }
__device__ __forceinline__ unsigned pk2(float lo, float hi) { return f2bf_u(lo) | (f2bf_u(hi) << 16); }
__device__ __forceinline__ float wave_sum(float v) {
#pragma unroll
    for (int o = 1; o < 64; o <<= 1) v += __shfl_xor(v, o);
    return v;
}
__device__ __forceinline__ void transpose_item(const float* W, int ldw, int src_col0, bf16_t* WT, int K, int dst_row0, int nvalid, const float* kscale, LAS float* scr, int k0, int lane) {
#pragma unroll 8
    for (int i = 0; i < 32; ++i) { const int kk = 2 * i + (lane >> 5); float v = W[(size_t)(k0 + kk) * ldw + src_col0 + (lane & 31)]; if (kscale) v *= kscale[k0 + kk]; scr[kk * 33 + (lane & 31)] = v; }
    asm volatile("s_waitcnt lgkmcnt(0)" ::: "memory");
    const int c = lane & 7;
#pragma unroll
    for (int j = 0; j < 4; ++j) { const int n = (lane >> 3) + 8 * j; const LAS float* s = scr + (8 * c) * 33 + n;
        v4u o; o.x = pk2(s[0 * 33], s[1 * 33]); o.y = pk2(s[2 * 33], s[3 * 33]); o.z = pk2(s[4 * 33], s[5 * 33]); o.w = pk2(s[6 * 33], s[7 * 33]);
        if (n < nvalid) *(v4u*)(WT + (size_t)(dst_row0 + n) * K + k0 + 8 * c) = o; }
    asm volatile("s_waitcnt lgkmcnt(0)" ::: "memory");
}
struct Frame {
    LAS unsigned char* lds; int tid, lane, wave, G;
    const float* const* in; float* out; unsigned char* ws;
};
#define FB(off) ((bf16_t*)(F.ws + lay::off))
#define FF32(off) ((float*)(F.ws + lay::off))
enum { I_XP = 0, I_XS, I_SCONV, I_SGDN, I_CK, I_CV, I_NF1, I_W1IN, I_W1OUT, I_NMIX, I_WIN, I_CONVW, I_ALOG, I_DTB, I_GNORM, I_SINKS, I_WOUT, I_NF2, I_W2IN, I_W2OUT, I_NFIN };

__device__ __forceinline__ void p0_prologue(Frame& F) {
    LAS float* scr = (LAS float*)(F.lds + F.wave * 16384);
    const int gw = blockIdx.x * NWAVES + F.wave, NGW = F.G * NWAVES;
    constexpr int KB1 = D / 64, KB2 = FF / 64;
    constexpr int N_W1IN = KB1 * (2 * FF / 32), N_W1OUT = KB2 * (D / 32), N_WIN = KB1 * (7680 / 32), N_WAB = KB1, N_WOUT = KB1 * (D / 32);
    constexpr int NITEMS = 2 * N_W1IN + 2 * N_W1OUT + N_WIN + N_WAB + N_WOUT;
    for (int it = gw; it < NITEMS; it += NGW) {
        int r = it;
        if (r < 2 * N_W1IN) {
            const int second = r >= N_W1IN; if (second) r -= N_W1IN;
            const int nbs = 2 * FF / 32, kb = r / nbs, nb = r % nbs, pn = nb >> 3, bj = (nb >> 2) & 1, wi = nb & 3;
            transpose_item(F.in[second ? I_W2IN : I_W1IN], 2 * FF, bj * FF + pn * 128 + wi * 32, second ? FB(WS_W2IN) : FB(WS_W1IN), D, nb * 32, 32, second ? F.in[I_NF2] : nullptr, scr, kb * 64, F.lane);
            continue; }
        r -= 2 * N_W1IN;
        if (r < 2 * N_W1OUT) {
            const int second = r >= N_W1OUT; if (second) r -= N_W1OUT;
            const int nbs = D / 32, kb = r / nbs, nb = r % nbs;
            transpose_item(F.in[second ? I_W2OUT : I_W1OUT], D, nb * 32, second ? FB(WS_W2OUT) : FB(WS_W1OUT), FF, nb * 32, 32, nullptr, scr, kb * 64, F.lane);
            continue; }
        r -= 2 * N_W1OUT;
        if (r < N_WIN) {
            const int nbs = 7680 / 32, kb = r / nbs, nb = r % nbs, drow = nb * 32;
            transpose_item(F.in[I_WIN], DIN, drow + (drow >= 4096 ? 16 : 0), FB(WS_WIN), D, drow, 32, F.in[I_NMIX], scr, kb * 64, F.lane);
            continue; }
        r -= N_WIN;
        if (r < N_WAB) { transpose_item(F.in[I_WIN], DIN, 4096, FB(WS_WAB), D, 0, 16, F.in[I_NMIX], scr, r * 64, F.lane); continue; }
        r -= N_WAB;
        { const int nbs = D / 32, kb = r / nbs, nb = r % nbs; transpose_item(F.in[I_WOUT], D, nb * 32, FB(WS_WOUT), D, nb * 32, 32, nullptr, scr, kb * 64, F.lane); }
    }
    const float* nw = F.in[I_NF1];
    f32x4 wv[4];
#pragma unroll
    for (int j = 0; j < 4; ++j) wv[j] = *(const f32x4*)(nw + 4 * F.lane + 256 * j);
    for (int m = gw; m < M; m += NGW) {
        const float* xr = (m < MP ? F.in[I_XP] + (size_t)m * D : F.in[I_XS] + (size_t)(m - MP) * D) + 4 * F.lane;
        f32x4 v[4]; float s = 0.f;
#pragma unroll
        for (int j = 0; j < 4; ++j) { v[j] = *(const f32x4*)(xr + 256 * j); s += (v[j][0] * v[j][0] + v[j][1] * v[j][1]) + (v[j][2] * v[j][2] + v[j][3] * v[j][3]); }
        const float rs = 1.0f / sqrtf(wave_sum(s) * (1.0f / D) + EPS);
        unsigned long long* o8 = (unsigned long long*)(FB(WS_XN1) + (size_t)m * D) + F.lane;
#pragma unroll
        for (int j = 0; j < 4; ++j) { const f32x4 o = v[j] * rs * wv[j]; o8[64 * j] = (unsigned long long)pk2(o[0], o[1]) | ((unsigned long long)pk2(o[2], o[3]) << 32); }
    }
}
__device__ __forceinline__ void ab_tiles(Frame& F) {
    const int gw = blockIdx.x * NWAVES + F.wave, NGW = F.G * NWAVES; const int lane = F.lane, q = lane >> 4, c = lane & 15;
    const bf16_t* x1b = FB(WS_X1B); const bf16_t* wab = FB(WS_WAB); const float* ssq = FF32(WS_SSQ1); float* AB = FF32(WS_AB);
    for (int tile = gw; tile < M / 16; tile += NGW) {
        f32x4 acc = {0.f, 0.f, 0.f, 0.f};
        const bf16_t* ap = x1b + (size_t)(tile * 16 + c) * D + 8 * q; const bf16_t* bp = wab + (size_t)c * D + 8 * q;
#pragma unroll 8
        for (int s = 0; s < D / 32; ++s) { const bf16x8 a = *(const bf16x8*)(ap + 32 * s), b = *(const bf16x8*)(bp + 32 * s); acc = __builtin_amdgcn_mfma_f32_16x16x32_bf16(a, b, acc, 0, 0, 0); }
#pragma unroll
        for (int r = 0; r < 4; ++r) { const int row = tile * 16 + 4 * q + r; const float* sp = ssq + (size_t)row * 16;
            float s = 0.f;
#pragma unroll
            for (int i = 0; i < 4; ++i) { const f32x4 v = *(const f32x4*)(sp + 4 * i); s += (v[0] + v[1]) + (v[2] + v[3]); }
            AB[(size_t)row * 16 + c] = acc[r] * (1.0f / sqrtf(s * (1.0f / D) + EPS)); }
    }
}
__device__ __forceinline__ void final_norm(Frame& F) {
    const int gw = blockIdx.x * NWAVES + F.wave, NGW = F.G * NWAVES; const float* nw = F.in[I_NFIN];
    f32x4 wv[4];
#pragma unroll
    for (int j = 0; j < 4; ++j) wv[j] = *(const f32x4*)(nw + 4 * F.lane + 256 * j);
    for (int m = gw; m < M; m += NGW) {
        float* xr = F.out + O_YP + (size_t)m * D + 4 * F.lane;
        f32x4 v[4]; float s = 0.f;
#pragma unroll
        for (int j = 0; j < 4; ++j) { v[j] = *(const f32x4*)(xr + 256 * j); s += (v[j][0] * v[j][0] + v[j][1] * v[j][1]) + (v[j][2] * v[j][2] + v[j][3] * v[j][3]); }
        const float rs = 1.0f / sqrtf(wave_sum(s) * (1.0f / D) + EPS);
#pragma unroll
        for (int j = 0; j < 4; ++j) *(f32x4*)(xr + 256 * j) = v[j] * rs * wv[j];
    }
}

struct Gdn2 {
    static __device__ __forceinline__ void run(long g, const float* AB, const bf16_t* QKV, const float* state_gdn, const float* a_log, const float* dt_bias,
                        bf16_t* OG, float* out_gp, float* out_gs) {
        using namespace nv;
        const int half = (int)(g & 1); const long col = g >> 1;
        const int dv = (int)(col % DV); const int h = (int)((col / DV) % H); const int sq = (int)(col / (DV * H));
        const int is_s = sq >= BATCH; const int seq = is_s ? sq - BATCH : sq; const int L = is_s ? DS : SEQ;
        const long base = is_s ? MP + (long)seq * DS : (long)seq * SEQ;
        float S[64];
#pragma unroll
        for (int j = 0; j < 64; ++j) S[j] = is_s ? state_gdn[(((long)seq * H + h) * DK + 64 * half + j) * DV + dv] : 0.f;
        const float ea = expf(a_log[h]), dtb = dt_bias[h];
        for (int t = 0; t < L; ++t) {
            const long r = base + t;
            const float a = AB[r * 16 + h], b = AB[r * 16 + 8 + h];
            const float gg = -ea * softplus_f(a + dtb), beta = sigmoid_f(b), alpha = expf(gg);
            const bf16_t* q = QKV + r * CONV + h * DK + 64 * half; const bf16_t* k = QKV + r * CONV + 1024 + h * DK + 64 * half;
            const float v = bf2f(QKV[r * CONV + 2048 + h * DV + dv]);
            float ks = 0.f;
#pragma unroll
            for (int j = 0; j < 64; ++j) ks += bf2f(k[j]) * S[j];
            ks += __shfl_xor(ks, 1);
            const float vn = beta * (v - alpha * ks);
            float o = 0.f;
#pragma unroll
            for (int j = 0; j < 64; ++j) { S[j] = alpha * S[j] + bf2f(k[j]) * vn; o += bf2f(q[j]) * S[j]; }
            o += __shfl_xor(o, 1);
            if (half == 0) OG[r * 1024 + h * DV + dv] = f2bf(o * 0.08838834764831845f);
        }
        float* so = is_s ? out_gs : out_gp;
#pragma unroll
        for (int j = 0; j < 64; ++j) so[(((long)seq * H + h) * DK + 64 * half + j) * DV + dv] = S[j];
    }
};
namespace att {
typedef float f32x16 __attribute__((ext_vector_type(16)));
typedef unsigned u32x2 __attribute__((ext_vector_type(2)));
constexpr int KPB = 144;
constexpr int VPE = 196;
constexpr int NSLOT = 192;
constexpr int K_OFF = 0, V_OFF = NSLOT * KPB, BUF_BYTES = V_OFF + 64 * VPE * 2;
constexpr float LOG2E = 1.4426950408889634f;
__device__ __forceinline__ int crow(int r, int h) { return (r & 3) + 8 * (r >> 2) + 4 * h; }
__device__ __forceinline__ unsigned cvtpk(float lo, float hi) { unsigned r; asm volatile("v_cvt_pk_bf16_f32 %0, %1, %2" : "=v"(r) : "v"(lo), "v"(hi)); return r; }

__device__ __forceinline__ void attn_wave(const LAS unsigned char* Kl, const LAS unsigned char* Vl, const bf16x8 (&qf)[4], int kt0, int kpos0, int qpos, float sink, f32x16 (&o)[2], int lane) {
    const int r32 = lane & 31, h = lane >> 5;
    f32x16 S[5];
#pragma unroll
    for (int j = 0; j < 5; ++j) {
#pragma unroll
        for (int e = 0; e < 16; ++e) S[j][e] = 0.f;
        const LAS unsigned char* kp = Kl + (32 * (kt0 + j) + r32) * KPB + 16 * h;
#pragma unroll
        for (int s = 0; s < 4; ++s) { const bf16x8 a = *(const LAS bf16x8*)(kp + 32 * s); S[j] = __builtin_amdgcn_mfma_f32_32x32x16_bf16(a, qf[s], S[j], 0, 0, 0); }
    }
    const float sink2 = sink * LOG2E; float m = sink2;
    const int rel0 = qpos - kpos0 - 32 * kt0;
#pragma unroll
    for (int j = 0; j < 5; ++j)
#pragma unroll
        for (int e = 0; e < 16; ++e) { const int x = 32 * j + crow(e, h); const int rel = rel0 - x; const bool ok = (rel >= 0) && (rel <= 127) && (kpos0 + 32 * kt0 + x >= 0);
            const float v = ok ? S[j][e] * LOG2E : -INFINITY; S[j][e] = v; m = fmaxf(m, v); }
    m = fmaxf(m, __shfl_xor(m, 32));
    float l = 0.f;
#pragma unroll
    for (int j = 0; j < 5; ++j)
#pragma unroll
        for (int e = 0; e < 16; ++e) { const float p = __builtin_amdgcn_exp2f(S[j][e] - m); S[j][e] = p; l += p; }
    l += __shfl_xor(l, 32); l += __builtin_amdgcn_exp2f(sink2 - m);
    const float il = 1.0f / l;
#pragma unroll
    for (int mt = 0; mt < 2; ++mt) {
#pragma unroll
        for (int e = 0; e < 16; ++e) o[mt][e] = 0.f;
        const LAS unsigned char* vp = Vl + ((32 * mt + r32) * VPE + 32 * kt0 + 4 * h) * 2;
#pragma unroll
        for (int j = 0; j < 5; ++j)
#pragma unroll
            for (int s = 0; s < 2; ++s) {
                const u32x2 lo = *(const LAS u32x2*)(vp + (32 * j + 16 * s) * 2), hi = *(const LAS u32x2*)(vp + (32 * j + 16 * s + 8) * 2);
                v4u av; av.x = lo.x; av.y = lo.y; av.z = hi.x; av.w = hi.y;
                v4u pv; pv.x = cvtpk(S[j][8 * s + 0], S[j][8 * s + 1]); pv.y = cvtpk(S[j][8 * s + 2], S[j][8 * s + 3]); pv.z = cvtpk(S[j][8 * s + 4], S[j][8 * s + 5]); pv.w = cvtpk(S[j][8 * s + 6], S[j][8 * s + 7]);
                o[mt] = __builtin_amdgcn_mfma_f32_32x32x16_bf16(__builtin_bit_cast(bf16x8, av), __builtin_bit_cast(bf16x8, pv), o[mt], 0, 0, 0);
            }
#pragma unroll
        for (int e = 0; e < 16; ++e) o[mt][e] *= il;
    }
}
__device__ __forceinline__ void load_q(bf16x8 (&qf)[4], const bf16_t* qrow, int h) {
#pragma unroll
    for (int s = 0; s < 4; ++s) { const v4u w = *(const v4u*)(qrow + 16 * s + 8 * h); v4u o;
#pragma unroll
        for (int i = 0; i < 4; ++i) { const float a = __builtin_bit_cast(float, w[i] << 16) * 0.125f, b = __builtin_bit_cast(float, w[i] & 0xffff0000u) * 0.125f;
            o[i] = (__builtin_bit_cast(unsigned, a) >> 16) | (__builtin_bit_cast(unsigned, b) & 0xffff0000u); }
        qf[s] = __builtin_bit_cast(bf16x8, o); }
}
__device__ __forceinline__ void store_o(const f32x16 (&o)[2], bf16_t* orow, int h) {
#pragma unroll
    for (int mt = 0; mt < 2; ++mt)
#pragma unroll
        for (int g4 = 0; g4 < 4; ++g4) { u32x2 w; w.x = cvtpk(o[mt][4 * g4 + 0], o[mt][4 * g4 + 1]); w.y = cvtpk(o[mt][4 * g4 + 2], o[mt][4 * g4 + 3]);
            *(u32x2*)(orow + 32 * mt + 8 * g4 + 4 * h) = w; }
}
__device__ __forceinline__ void put_kv(LAS unsigned char* Kl, LAS unsigned char* Vl, int i, int part, v4u kv, v4u vv) {
    *(LAS v4u*)(Kl + i * KPB + part * 16) = kv;
#pragma unroll
    for (int e = 0; e < 8; ++e) { const unsigned short val = (unsigned short)((vv[e >> 1] >> (16 * (e & 1))) & 0xffffu); *(LAS unsigned short*)(Vl + ((part * 8 + e) * VPE + i) * 2) = val; }
}
__device__ __forceinline__ void attn_phase(Frame& F, int wg, int nwg) {
    LAS unsigned char* Kl = F.lds + K_OFF; LAS unsigned char* Vl = F.lds + V_OFF;
    bf16_t* QS = FB(WS_QS); const bf16_t* KS = FB(WS_KS); const bf16_t* VS = FB(WS_VS);
    const int lane = F.lane, r32 = lane & 31, h = lane >> 5, w = F.wave;
    constexpr int NPU = BATCH * KVH * (SEQ / 64), NSU = DB * KVH;
    for (int u = wg; u < NPU + NSU; u += nwg) {
        if (u < NPU) {
            const int b = u / (KVH * (SEQ / 64)), kvh = (u / (SEQ / 64)) % KVH, q0 = (u % (SEQ / 64)) * 64;
            for (int c = F.tid; c < NSLOT * 8; c += NTHREADS) { const int i = c >> 3, part = c & 7, kpos = q0 - 128 + i;
                v4u kv = {0u, 0u, 0u, 0u}, vv = {0u, 0u, 0u, 0u};
                if (kpos >= 0) { const size_t off = ((size_t)b * SEQ + kpos) * 256 + kvh * 64 + part * 8; kv = *(const v4u*)(KS + off); vv = *(const v4u*)(VS + off); }
                put_kv(Kl, Vl, i, part, kv, vv); }
            const int head = kvh * 4 + (w >> 1), hf = w & 1; const size_t row = (size_t)b * SEQ + q0 + 32 * hf + r32;
            bf16x8 qf[4]; load_q(qf, QS + row * 1024 + head * 64, h);
            __syncthreads();
            f32x16 o[2]; attn_wave(Kl, Vl, qf, hf, q0 - 128, q0 + 32 * hf + r32, F.in[I_SINKS][head], o, lane);
            store_o(o, QS + row * 1024 + head * 64, h);
            __syncthreads();
        } else {
            const int su = u - NPU, b = su / KVH, kvh = su % KVH;
            const float* ck = F.in[I_CK]; const float* cv = F.in[I_CV];
            for (int c = F.tid; c < 160 * 8; c += NTHREADS) { const int i = c >> 3, part = c & 7;
                v4u kv = {0u, 0u, 0u, 0u}, vv = {0u, 0u, 0u, 0u};
                if (i < WIN) { const size_t off = (((size_t)b * WIN + i) * KVH + kvh) * HD + part * 8;
                    const f32x4 k0 = *(const f32x4*)(ck + off), k1 = *(const f32x4*)(ck + off + 4), v0 = *(const f32x4*)(cv + off), v1 = *(const f32x4*)(cv + off + 4);
                    kv.x = pk2(k0[0], k0[1]); kv.y = pk2(k0[2], k0[3]); kv.z = pk2(k1[0], k1[1]); kv.w = pk2(k1[2], k1[3]);
                    vv.x = pk2(v0[0], v0[1]); vv.y = pk2(v0[2], v0[3]); vv.z = pk2(v1[0], v1[1]); vv.w = pk2(v1[2], v1[3]); }
                else if (i < WIN + DS) { const size_t off = ((size_t)MP + (size_t)b * DS + (i - WIN)) * 256 + kvh * 64 + part * 8; kv = *(const v4u*)(KS + off); vv = *(const v4u*)(VS + off); }
                put_kv(Kl, Vl, i, part, kv, vv); }
            const int head = kvh * 4 + (r32 >> 3), t = r32 & 7; const size_t row = (size_t)MP + (size_t)b * DS + t;
            bf16x8 qf[4];
            if (w == 0) load_q(qf, QS + row * 1024 + head * 64, h);
            __syncthreads();
            if (w == 0) { f32x16 o[2]; attn_wave(Kl, Vl, qf, 0, PAST - WIN, PAST + t, F.in[I_SINKS][head], o, lane); store_o(o, QS + row * 1024 + head * 64, h); }
            __syncthreads();
        }
    }
}
}
namespace gdn {
typedef unsigned u32x2 __attribute__((ext_vector_type(2)));
constexpr int NCH = SEQ / 64, NU = BATCH * H * NCH;
constexpr size_t WKB = 16384, QKPB = 8192, UVB = 32768;
constexpr int TEAM_LDS = 81920, PK = 272;
constexpr int KB_OFF = 0, QB_OFF = 17408, VB_OFF = 34816, A_OFF = 52224, QKP_OFF = 68608, SM_OFF = 76800;
__device__ __forceinline__ int permpos(int j) { return (j & ~31) + 8 * ((j >> 2) & 3) + 4 * ((j >> 4) & 1) + (j & 3); }
__device__ __forceinline__ float bfl(unsigned w) { return __builtin_bit_cast(float, w << 16); }
__device__ __forceinline__ float bfh(unsigned w) { return __builtin_bit_cast(float, w & 0xffff0000u); }
__device__ __forceinline__ unsigned cvtpk(float lo, float hi) { unsigned r; asm volatile("v_cvt_pk_bf16_f32 %0, %1, %2" : "=v"(r) : "v"(lo), "v"(hi)); return r; }
__device__ __forceinline__ float silu_a(float x) { return x * __builtin_amdgcn_rcpf(1.0f + __builtin_amdgcn_exp2f(-1.4426950408889634f * x)); }

__device__ __forceinline__ void prep_phase(Frame& F) {
    const int team = F.tid >> 8, lt0 = F.tid & 255, tw = lt0 >> 6, lane = F.lane;
    LAS unsigned char* L = F.lds + team * TEAM_LDS;
    LAS float* sm = (LAS float*)(L + SM_OFF);
    LAS float* Am = (LAS float*)(L + A_OFF);
    const int tg = blockIdx.x * 2 + team, ntg = F.G * 2;
    const int rounds = (NU + ntg - 1) / ntg;
#pragma unroll 1
    for (int rd = 0; rd < rounds; ++rd) {
        int lt = lt0; asm volatile("" : "+v"(lt));
        unsigned char* wsb = F.ws; asm volatile("" : "+s"(wsb));
        const float* AB = (const float*)(wsb + lay::WS_AB);
        unsigned char* wkb = wsb + lay::WS_WK; unsigned char* qgb = wsb + lay::WS_QG; unsigned char* kgtb = wsb + lay::WS_KGT; unsigned char* qkpb = wsb + lay::WS_QKP;
        float* uvb = (float*)(wsb + lay::WS_UV); float* glb = (float*)(wsb + lay::WS_GL);
        const int uid = tg + rd * ntg; const bool act = uid < NU;
        const int n = uid % NCH, h = (uid / NCH) % H, b = uid / (NCH * H);
        const size_t r0 = (size_t)b * SEQ + (size_t)n * 64;
        if (act && tw == 0) {
            const float a = AB[(r0 + lane) * 16 + h], bb = AB[(r0 + lane) * 16 + 8 + h];
            const float xg = a + F.in[I_DTB][h]; const float sp = xg > 20.f ? xg : log1pf(expf(xg));
            float v = -expf(F.in[I_ALOG][h]) * sp;
#pragma unroll
            for (int d = 1; d < 64; d <<= 1) { const float t2 = __shfl_up(v, d); if (lane >= d) v += t2; }
            const float gl = __shfl(v, 63);
            sm[lane] = v; sm[64 + lane] = 1.0f / (1.0f + expf(-bb)); sm[128 + lane] = expf(v); sm[192 + lane] = expf(gl - v);
            if (lane == 0) glb[uid] = expf(gl);
        }
        { v4u z = {0u, 0u, 0u, 0u}; *(LAS v4u*)(L + QKP_OFF + lt * 32) = z; *(LAS v4u*)(L + QKP_OFF + lt * 32 + 16) = z; }
        if (act) {
#pragma unroll
            for (int k = 0; k < 12; ++k) { const int id = lt + 256 * k, mat = id >> 10, i = (id >> 4) & 63, part = id & 15;
                const bf16_t* src = (const bf16_t*)(wsb + (mat == 0 ? lay::WS_QN : mat == 1 ? lay::WS_KN : lay::WS_VN));
                const v4u w = *(const v4u*)(src + (r0 + i) * 1024 + h * 128 + part * 8);
                *(LAS v4u*)(L + (mat == 0 ? QB_OFF : mat == 1 ? KB_OFF : VB_OFF) + i * PK + part * 16) = w; }
        }
        __syncthreads();
        if (act) {
            const int c = lane & 15, q = lane >> 4;
#pragma unroll 1
            for (int job = tw; job < 20; job += 4) {
                const int mat = job / 10, tau = job % 10, ti = tau >= 6 ? 3 : tau >= 3 ? 2 : tau >= 1 ? 1 : 0, tj = tau - ti * (ti + 1) / 2;
                const LAS unsigned char* ap = L + (mat == 0 ? KB_OFF : QB_OFF) + (16 * ti + c) * PK + 16 * q; const LAS unsigned char* bp = L + KB_OFF + (16 * tj + c) * PK + 16 * q;
                f32x4 acc = {0.f, 0.f, 0.f, 0.f};
#pragma unroll
                for (int s = 0; s < 4; ++s) acc = __builtin_amdgcn_mfma_f32_16x16x32_bf16(*(const LAS bf16x8*)(ap + 64 * s), *(const LAS bf16x8*)(bp + 64 * s), acc, 0, 0, 0);
                const int j = 16 * tj + c; const float gcj = sm[j];
#pragma unroll
                for (int r = 0; r < 4; ++r) { const int i = 16 * ti + 4 * q + r; const float dec = expf(sm[i] - gcj);
                    if (mat == 0) Am[i * 64 + j] = (i > j) ? acc[r] * sm[64 + i] * dec : 0.f;
                    else *(LAS unsigned short*)(L + QKP_OFF + i * 128 + permpos(j) * 2) = (unsigned short)f2bf_u((i >= j) ? acc[r] * dec : 0.f); }
            }
        }
        __syncthreads();
        float x[64];
        if (act) {
            if (lt < 128) {
#pragma unroll
                for (int i = 0; i < 64; ++i) x[i] = bfl((unsigned)*(const LAS unsigned short*)(L + VB_OFF + i * PK + lt * 2)) * sm[64 + i];
            } else {
#pragma unroll
                for (int i = 0; i < 64; ++i) x[i] = bfl((unsigned)*(const LAS unsigned short*)(L + KB_OFF + i * PK + (lt - 128) * 2)) * sm[64 + i] * sm[128 + i];
            }
#pragma clang loop unroll(full)
            for (int i = 1; i < 64; ++i) {
                float acc = x[i];
#pragma clang loop unroll(full)
                for (int j4 = 0; j4 < 16; ++j4) if (4 * j4 < i) { const f32x4 a = *(const LAS f32x4*)(Am + i * 64 + 4 * j4);
                    acc -= a[0] * x[4 * j4]; if (4 * j4 + 1 < i) acc -= a[1] * x[4 * j4 + 1]; if (4 * j4 + 2 < i) acc -= a[2] * x[4 * j4 + 2]; if (4 * j4 + 3 < i) acc -= a[3] * x[4 * j4 + 3]; }
                x[i] = acc;
            }
        }
        __syncthreads();
        const int lo_ = lt;
        if (act) {
            if (lt < 128) {
                float* up = uvb + (size_t)uid * (UVB / 4) + (size_t)((lo_ >> 4) * 4) * 256 + (lo_ & 15) * 4;
#pragma unroll
                for (int mt = 0; mt < 4; ++mt)
#pragma unroll
                    for (int q = 0; q < 4; ++q) { f32x4 o = {x[16 * mt + 4 * q], x[16 * mt + 4 * q + 1], x[16 * mt + 4 * q + 2], x[16 * mt + 4 * q + 3]}; *(f32x4*)(up + mt * 256 + q * 64) = o; }
            } else {
#pragma unroll
                for (int i = 0; i < 64; ++i) *(LAS unsigned short*)(L + VB_OFF + i * PK + (lo_ - 128) * 2) = (unsigned short)f2bf_u(x[i]);
            }
        }
        __syncthreads();
        if (act) {
#pragma unroll
            for (int k = 0; k < 4; ++k) { const int id = lo_ + 256 * k, i = id >> 4, s = (id >> 2) & 3, q = id & 3;
                { const LAS unsigned char* p = L + VB_OFF + i * PK + (32 * s + 4 * q) * 2; const u32x2 lo = *(const LAS u32x2*)p, hi = *(const LAS u32x2*)(p + 32);
                  v4u o; o.x = lo.x; o.y = lo.y; o.z = hi.x; o.w = hi.y; *(v4u*)(wkb + (size_t)uid * WKB + (size_t)id * 16) = o; }
                { const LAS unsigned char* p = L + QB_OFF + i * PK + (32 * s + 4 * q) * 2; const u32x2 lo = *(const LAS u32x2*)p, hi = *(const LAS u32x2*)(p + 32); const float e = sm[128 + i];
                  v4u o; o.x = cvtpk(bfl(lo.x) * e, bfh(lo.x) * e); o.y = cvtpk(bfl(lo.y) * e, bfh(lo.y) * e); o.z = cvtpk(bfl(hi.x) * e, bfh(hi.x) * e); o.w = cvtpk(bfl(hi.y) * e, bfh(hi.y) * e);
                  *(v4u*)(qgb + (size_t)uid * WKB + (size_t)id * 16) = o; }
            }
#pragma unroll
            for (int k = 0; k < 4; ++k) { const int id = lo_ + 256 * k, dk = id >> 3, s = (id >> 2) & 1, q = id & 3; float v[8];
#pragma unroll
                for (int j = 0; j < 8; ++j) { const int tok = 32 * s + 16 * (j >> 2) + 4 * q + (j & 3); v[j] = bfl((unsigned)*(const LAS unsigned short*)(L + KB_OFF + tok * PK + dk * 2)) * sm[192 + tok]; }
                v4u o; o.x = cvtpk(v[0], v[1]); o.y = cvtpk(v[2], v[3]); o.z = cvtpk(v[4], v[5]); o.w = cvtpk(v[6], v[7]);
                *(v4u*)(kgtb + (size_t)uid * WKB + (size_t)id * 16) = o; }
#pragma unroll
            for (int k = 0; k < 2; ++k) { const int id = lo_ + 256 * k; *(v4u*)(qkpb + (size_t)uid * QKPB + (size_t)id * 16) = *(const LAS v4u*)(L + QKP_OFF + id * 16); }
        }
        __syncthreads();
    }
}

constexpr int SC_WK = 0, SC_QG = 17408, SC_KGT = 34816, SC_QKP = 34816 + 18432, SC_BUF = SC_QKP + 9216;
__device__ __forceinline__ void scan_phase(Frame& F, int bh) {
    const int lane = F.lane, w = F.wave, c = lane & 15, q = lane >> 4, tid = F.tid;
    const int b = bh / H, h = bh % H;
    const unsigned char* wkb = F.ws + lay::WS_WK; const unsigned char* qgb = F.ws + lay::WS_QG; const unsigned char* kgtb = F.ws + lay::WS_KGT; const unsigned char* qkpb = F.ws + lay::WS_QKP;
    const float* uvb = (const float*)(F.ws + lay::WS_UV); const float* glb = (const float*)(F.ws + lay::WS_GL);
    bf16_t* OG = FB(WS_OG);
    f32x4 Sacc[8]; bf16x8 Sb[4];
#pragma unroll
    for (int i = 0; i < 8; ++i) Sacc[i] = (f32x4){0.f, 0.f, 0.f, 0.f};
#pragma unroll
    for (int i = 0; i < 4; ++i) Sb[i] = (bf16x8){0, 0, 0, 0, 0, 0, 0, 0};
    v4u st[7]; f32x4 un[4]; float gln;
#define SC_LOAD(uid) do { _Pragma("unroll") for (int k = 0; k < 7; ++k) { const int g = tid + 512 * k; const unsigned char* src = g < 1024 ? wkb + (size_t)(uid) * WKB + (size_t)g * 16 : g < 2048 ? qgb + (size_t)(uid) * WKB + (size_t)(g - 1024) * 16 \
        : g < 3072 ? kgtb + (size_t)(uid) * WKB + (size_t)(g - 2048) * 16 : qkpb + (size_t)(uid) * QKPB + (size_t)(g - 3072) * 16; st[k] = *(const v4u*)src; } \
        _Pragma("unroll") for (int mt = 0; mt < 4; ++mt) un[mt] = *(const f32x4*)(uvb + (size_t)(uid) * (UVB / 4) + (size_t)((w * 4 + mt) * 64 + lane) * 4); gln = glb[(uid)]; } while (0)
#define SC_WRITE(buf) do { _Pragma("unroll") for (int k = 0; k < 7; ++k) { const int g = tid + 512 * k; int off; \
        if (g < 1024) off = SC_WK + (g >> 4) * PK + (g & 15) * 16; else if (g < 2048) off = SC_QG + ((g - 1024) >> 4) * PK + (g & 15) * 16; \
        else if (g < 3072) off = SC_KGT + ((g - 2048) >> 3) * 144 + (g & 7) * 16; else off = SC_QKP + ((g - 3072) >> 3) * 144 + (g & 7) * 16; \
        *(LAS v4u*)(F.lds + (buf) * SC_BUF + off) = st[k]; } } while (0)
    const int uid0 = bh * NCH;
    SC_LOAD(uid0); SC_WRITE(0);
    __syncthreads();
    for (int n = 0; n < NCH; ++n) {
        f32x4 u[4];
#pragma unroll
        for (int mt = 0; mt < 4; ++mt) u[mt] = un[mt];
        const float gl = gln;
        if (n + 1 < NCH) SC_LOAD(uid0 + n + 1);
        const LAS unsigned char* B = F.lds + (n & 1) * SC_BUF;
        f32x4 vn[4];
#pragma unroll
        for (int mt = 0; mt < 4; ++mt) { f32x4 r = {0.f, 0.f, 0.f, 0.f}; const LAS unsigned char* ap = B + SC_WK + (16 * mt + c) * PK + 16 * q;
#pragma unroll
            for (int s = 0; s < 4; ++s) r = __builtin_amdgcn_mfma_f32_16x16x32_bf16(*(const LAS bf16x8*)(ap + 64 * s), Sb[s], r, 0, 0, 0);
            vn[mt] = u[mt] - r; }
        bf16x8 Vb[2];
#pragma unroll
        for (int s = 0; s < 2; ++s) { v4u p; p.x = cvtpk(vn[2 * s][0], vn[2 * s][1]); p.y = cvtpk(vn[2 * s][2], vn[2 * s][3]); p.z = cvtpk(vn[2 * s + 1][0], vn[2 * s + 1][1]); p.w = cvtpk(vn[2 * s + 1][2], vn[2 * s + 1][3]); Vb[s] = __builtin_bit_cast(bf16x8, p); }
#pragma unroll
        for (int mt = 0; mt < 4; ++mt) { f32x4 o = {0.f, 0.f, 0.f, 0.f}; const LAS unsigned char* ap = B + SC_QG + (16 * mt + c) * PK + 16 * q; const LAS unsigned char* kp = B + SC_QKP + (16 * mt + c) * 144 + 16 * q;
#pragma unroll
            for (int s = 0; s < 4; ++s) o = __builtin_amdgcn_mfma_f32_16x16x32_bf16(*(const LAS bf16x8*)(ap + 64 * s), Sb[s], o, 0, 0, 0);
#pragma unroll
            for (int s = 0; s < 2; ++s) o = __builtin_amdgcn_mfma_f32_16x16x32_bf16(*(const LAS bf16x8*)(kp + 64 * s), Vb[s], o, 0, 0, 0);
            bf16_t* op = OG + ((size_t)b * SEQ + (size_t)n * 64 + 16 * mt + 4 * q) * 1024 + h * 128 + 16 * w + c;
#pragma unroll
            for (int r = 0; r < 4; ++r) op[(size_t)r * 1024] = (bf16_t)f2bf_u(o[r]); }
#pragma unroll
        for (int dt = 0; dt < 8; ++dt) { f32x4 a = Sacc[dt] * gl; const LAS unsigned char* ap = B + SC_KGT + (16 * dt + c) * 144 + 16 * q;
#pragma unroll
            for (int s = 0; s < 2; ++s) a = __builtin_amdgcn_mfma_f32_16x16x32_bf16(*(const LAS bf16x8*)(ap + 64 * s), Vb[s], a, 0, 0, 0);
            Sacc[dt] = a; }
#pragma unroll
        for (int s = 0; s < 4; ++s) { v4u p; p.x = cvtpk(Sacc[2 * s][0], Sacc[2 * s][1]); p.y = cvtpk(Sacc[2 * s][2], Sacc[2 * s][3]); p.z = cvtpk(Sacc[2 * s + 1][0], Sacc[2 * s + 1][1]); p.w = cvtpk(Sacc[2 * s + 1][2], Sacc[2 * s + 1][3]); Sb[s] = __builtin_bit_cast(bf16x8, p); }
        if (n + 1 < NCH) SC_WRITE((n + 1) & 1);
        __syncthreads();
    }
#undef SC_LOAD
#undef SC_WRITE
    float* so = F.out + O_GP + ((size_t)(b * H + h) * DK) * DV + 16 * w + c;
#pragma unroll
    for (int dt = 0; dt < 8; ++dt)
#pragma unroll
        for (int r = 0; r < 4; ++r) so[(size_t)(16 * dt + 4 * q + r) * DV] = Sacc[dt][r];
}

__device__ __forceinline__ void sample_qkv(Frame& F) {
    const int gw = blockIdx.x * NWAVES + F.wave, NGW = F.G * NWAVES, lane = F.lane;
    const bf16_t* RAW = FB(WS_RAW); bf16_t* QKVS = FB(WS_QKVS); const float* sc = F.in[I_SCONV]; const float* conv_w = F.in[I_CONVW];
    for (int task = gw; task < DB * 24; task += NGW) {
        const int b = task / 24, hm = task % 24, col = hm * 128 + 2 * lane;
        float w0[4], w1[4], e0[3], e1[3];
#pragma unroll
        for (int j = 0; j < 4; ++j) { w0[j] = conv_w[j * CONV + col]; w1[j] = conv_w[j * CONV + col + 1]; }
#pragma unroll
        for (int j = 0; j < 3; ++j) { e0[j] = sc[((size_t)b * 3 + j) * CONV + col]; e1[j] = sc[((size_t)b * 3 + j) * CONV + col + 1]; }
        for (int t = 0; t < DS; ++t) {
            const unsigned rw = *(const unsigned*)(RAW + ((size_t)MP + (size_t)b * DS + t) * CONV + col);
            const float c0 = bfl(rw), c1 = bfh(rw);
            float v0 = silu_a(w0[0] * e0[0] + w0[1] * e0[1] + w0[2] * e0[2] + w0[3] * c0), v1 = silu_a(w1[0] * e1[0] + w1[1] * e1[1] + w1[2] * e1[2] + w1[3] * c1);
            e0[0] = e0[1]; e0[1] = e0[2]; e0[2] = c0; e1[0] = e1[1]; e1[1] = e1[2]; e1[2] = c1;
            if (hm < 16) { const float rs = 1.0f / sqrtf(wave_sum(v0 * v0 + v1 * v1) + EPS); v0 *= rs; v1 *= rs; }
            *(unsigned*)(QKVS + ((size_t)b * DS + t) * CONV + col) = cvtpk(v0, v1);
        }
    }
}
__device__ __forceinline__ void qkvn_pass(Frame& F) {
    const int gw = blockIdx.x * NWAVES + F.wave, NGW = F.G * NWAVES, lane = F.lane;
    const bf16_t* RAW = FB(WS_RAW); const float* conv_w = F.in[I_CONVW];
    for (int task = gw; task < BATCH * 24 * NCH; task += NGW) {
        const int st = task % NCH, hm = (task / NCH) % 24, b = task / (NCH * 24), col = hm * 128 + 2 * lane, mat = hm >> 3;
        bf16_t* dst = (mat == 0 ? FB(WS_QN) : mat == 1 ? FB(WS_KN) : FB(WS_VN)) + (hm & 7) * 128 + 2 * lane;
        float w0[4], w1[4], e0[3], e1[3];
#pragma unroll
        for (int j = 0; j < 4; ++j) { w0[j] = conv_w[j * CONV + col]; w1[j] = conv_w[j * CONV + col + 1]; }
        const size_t rb = (size_t)b * SEQ; const int t0 = st * 64;
#pragma unroll
        for (int j = 0; j < 3; ++j) { const int t = t0 - 3 + j; unsigned rw = 0u; if (t >= 0) rw = *(const unsigned*)(RAW + (rb + t) * CONV + col); e0[j] = bfl(rw); e1[j] = bfh(rw); }
#pragma unroll 4
        for (int t = t0; t < t0 + 64; ++t) {
            const unsigned rw = *(const unsigned*)(RAW + (rb + t) * CONV + col);
            const float c0 = bfl(rw), c1 = bfh(rw);
            float v0 = silu_a(w0[0] * e0[0] + w0[1] * e0[1] + w0[2] * e0[2] + w0[3] * c0), v1 = silu_a(w1[0] * e1[0] + w1[1] * e1[1] + w1[2] * e1[2] + w1[3] * c1);
            e0[0] = e0[1]; e0[1] = e0[2]; e0[2] = c0; e1[0] = e1[1]; e1[1] = e1[2]; e1[2] = c1;
            if (mat < 2) { float rs = 1.0f / sqrtf(wave_sum(v0 * v0 + v1 * v1) + EPS); if (mat == 0) rs *= 0.08838834764831845f; v0 *= rs; v1 *= rs; }
            *(unsigned*)(dst + (rb + t) * 1024) = cvtpk(v0, v1);
        }
    }
}
}
template <class K, class... A> __device__ __forceinline__ void run_items(long n, A... a) {
    for (long g = (long)blockIdx.x * NTHREADS + threadIdx.x; g < n; g += (long)gridDim.x * NTHREADS) K::run(g, a...);
}

template <class K, class... A> __device__ __forceinline__ void run_items_sub(long lo, long hi, int wg, int nwg, A... a) {
    for (long g = lo + (long)wg * NTHREADS + threadIdx.x; g < hi; g += (long)nwg * NTHREADS) K::run(g, a...);
}

__global__ void __launch_bounds__(NTHREADS, 2) mega_fwd(MArgs args) {
    extern __shared__ __attribute__((aligned(16))) unsigned char lds_raw[];
    Frame F;
    F.lds = (LAS unsigned char*)lds_raw; F.tid = threadIdx.x; F.lane = F.tid & 63; F.wave = __builtin_amdgcn_readfirstlane(F.tid >> 6); F.G = gridDim.x;
    F.in = args.in; F.out = args.out; F.ws = args.ws;
    const int lo = args.ph_lo, hi = args.ph_hi;
#define IN(k) (lo <= (k) && (k) < hi)
#define SEAM(k) do { if (IN(k) && IN((k) + 1)) cg::this_grid().sync(); } while (0)
    typedef pg8::StaticOrder SO;
    if (IN(P_PRO)) { p0_prologue(F); } SEAM(P_PRO);
    if (IN(P_FFN1A)) {
        pg8::Gemm g{FB(WS_XN1), FB(WS_W1IN), M, 2 * FF, D}; SO S; S.init(M, 2 * FF, F.G, (int)blockIdx.x);
        pg8::EpiSwiglu E{FB(WS_HB), FF, nullptr};
        pg8::gemm_phase<pg8::EpiSwiglu, SO, true, true>(F.lds, g, S, E);
    } SEAM(P_FFN1A);
    if (IN(P_FFN1B)) {
        pg8::Gemm g{FB(WS_HB), FB(WS_W1OUT), M, D, FF}; SO S; S.init(M, D, F.G, (int)blockIdx.x);
        pg8::EpiResid E{F.in[I_XP], F.in[I_XS], MP, 0.5f, FF32(WS_X1), FB(WS_X1B), FF32(WS_SSQ1)};
        pg8::gemm_phase<pg8::EpiResid, SO, true, true>(F.lds, g, S, E);
    } SEAM(P_FFN1B);
    if (IN(P_INPROJ)) {
        ab_tiles(F);
        pg8::Gemm g{FB(WS_X1B), FB(WS_WIN), M, 7680, D}; SO S; S.init(M, 7680, F.G, (int)blockIdx.x);
        pg8::EpiInProj E{FB(WS_RAW), FB(WS_Z), FB(WS_QS), FB(WS_KS), FB(WS_VS), FB(WS_GA), FB(WS_GB), FF32(WS_SSQ1)};
        pg8::gemm_phase<pg8::EpiInProj, SO, true, true>(F.lds, g, S, E);
    } SEAM(P_INPROJ);
#if MK_EMBED_NB
    if (IN(P_PREP)) {
        run_items<nv::OutConv>((long)(BATCH + DB) * 3 * CONV, (const bf16_t*)FB(WS_RAW), F.out + O_CP, F.out + O_CS);
        run_items<nv::Rope>((long)M * 160, FB(WS_QS), FB(WS_KS));
        gdn::sample_qkv(F);
        gdn::qkvn_pass(F);
        cg::this_grid().sync();
        gdn::prep_phase(F);
    } SEAM(P_PREP);
    if (IN(P_MIXER)) {
        constexpr int NSCAN = BATCH * H;
        if ((int)blockIdx.x < NSCAN) gdn::scan_phase(F, (int)blockIdx.x);
        else {
            const int wg = (int)blockIdx.x - NSCAN, nwg = F.G - NSCAN;
            run_items_sub<nv::OutKV>(0, (long)(BATCH + DB) * WIN * 256, wg, nwg, (const bf16_t*)FB(WS_KS), (const bf16_t*)FB(WS_VS), F.in[I_CK], F.in[I_CV], F.out + O_KP, F.out + O_KS, F.out + O_VP, F.out + O_VS);
            run_items_sub<Gdn2>((long)BATCH * H * DV * 2, (long)(BATCH + DB) * H * DV * 2, wg, nwg, (const float*)FF32(WS_AB), (const bf16_t*)(FB(WS_QKVS) - (size_t)MP * CONV), F.in[I_SGDN], F.in[I_ALOG], F.in[I_DTB], FB(WS_OG), F.out + O_GP, F.out + O_GS);
            att::attn_phase(F, wg, nwg);
        }
    } SEAM(P_MIXER);
    if (IN(P_MERGE)) {
        run_items<nv::Mix>((long)M * H, (const bf16_t*)FB(WS_Z), FB(WS_GA), (const bf16_t*)FB(WS_GB), (const bf16_t*)FB(WS_OG), (const bf16_t*)FB(WS_OS), F.in[I_GNORM]);
    } SEAM(P_MERGE);
#endif
    if (IN(P_OUTPROJ)) {
        pg8::Gemm g{FB(WS_MIXED), FB(WS_WOUT), M, D, D}; SO S; S.init(M, D, F.G, (int)blockIdx.x);
        pg8::EpiResid E{FF32(WS_X1), FF32(WS_X1), M, 1.0f, FF32(WS_X1), FB(WS_X2B), FF32(WS_SSQ2)};
        pg8::gemm_phase<pg8::EpiResid, SO, true, true>(F.lds, g, S, E);
    } SEAM(P_OUTPROJ);
    if (IN(P_FFN2A)) {
        pg8::Gemm g{FB(WS_X2B), FB(WS_W2IN), M, 2 * FF, D}; SO S; S.init(M, 2 * FF, F.G, (int)blockIdx.x);
        pg8::EpiSwiglu E{FB(WS_HB), FF, FF32(WS_SSQ2)};
        pg8::gemm_phase<pg8::EpiSwiglu, SO, true, true>(F.lds, g, S, E);
    } SEAM(P_FFN2A);
    if (IN(P_FFN2B)) {
        pg8::Gemm g{FB(WS_HB), FB(WS_W2OUT), M, D, FF}; SO S; S.init(M, D, F.G, (int)blockIdx.x);
        pg8::EpiResid E{FF32(WS_X1), FF32(WS_X1), M, 0.5f, F.out + O_YP, nullptr, FF32(WS_SSQ3)};
        pg8::gemm_phase<pg8::EpiResid, SO, true, true>(F.lds, g, S, E);
    } SEAM(P_FFN2B);
    if (IN(P_FINAL)) { final_norm(F); }
#undef IN
#undef SEAM
}

static int g_grid = 0;
static bool mega_setup() {
    if (g_grid != 0) return g_grid > 0;
    int dev = 0, cus = 0, per_cu = 0;
    if (hipGetDevice(&dev) != hipSuccess || hipDeviceGetAttribute(&cus, hipDeviceAttributeMultiprocessorCount, dev) != hipSuccess) { g_grid = -1; return false; }
    if (hipFuncSetAttribute((const void*)mega_fwd, hipFuncAttributeMaxDynamicSharedMemorySize, LDS_BYTES) != hipSuccess) { fprintf(stderr, "mega: hipFuncSetAttribute failed\n"); g_grid = -1; return false; }
    if (hipOccupancyMaxActiveBlocksPerMultiprocessor(&per_cu, (const void*)mega_fwd, NTHREADS, LDS_BYTES) != hipSuccess || per_cu < 1) { fprintf(stderr, "mega: occupancy query says %d blocks per CU\n", per_cu); g_grid = -1; return false; }
    g_grid = cus;
    return true;
}
static void mega_launch(void* const* d_in, void* d_out, void* d_ws, int ph_lo, int ph_hi, hipStream_t stream) {
    if (!mega_setup()) return;
    MArgs a{};
    for (int i = 0; i < 21; ++i) a.in[i] = (const float*)d_in[i];
    a.out = (float*)d_out; a.ws = (unsigned char*)d_ws; a.ph_lo = ph_lo; a.ph_hi = ph_hi;
    void* kargs[] = {&a};
    const hipError_t e = hipLaunchCooperativeKernel((const void*)mega_fwd, dim3(g_grid), dim3(NTHREADS), kargs, LDS_BYTES, stream);
    if (e != hipSuccess) fprintf(stderr, "mega: cooperative launch failed: %s (grid %d)\n", hipGetErrorString(e), g_grid);
}
}
#endif
#ifdef CPU_EMU
typedef int hipStream_t;
#endif

struct Ptrs {
    const float *x_prompt, *x_sample, *state_conv, *state_gdn, *cache_k, *cache_v, *norm_ffn1, *w_ffn1_in, *w_ffn1_out, *norm_mix, *w_in, *conv_w,
                *a_log, *dt_bias, *gdn_norm, *sinks, *w_out, *norm_ffn2, *w_ffn2_in, *w_ffn2_out, *norm_final;
    float* out; unsigned char* ws;
};
static Ptrs make_ptrs(void* const* d_in, void* d_out, void* d_ws) {
    Ptrs p;
    p.x_prompt = (const float*)d_in[0]; p.x_sample = (const float*)d_in[1]; p.state_conv = (const float*)d_in[2]; p.state_gdn = (const float*)d_in[3];
    p.cache_k = (const float*)d_in[4]; p.cache_v = (const float*)d_in[5]; p.norm_ffn1 = (const float*)d_in[6]; p.w_ffn1_in = (const float*)d_in[7];
    p.w_ffn1_out = (const float*)d_in[8]; p.norm_mix = (const float*)d_in[9]; p.w_in = (const float*)d_in[10]; p.conv_w = (const float*)d_in[11];
    p.a_log = (const float*)d_in[12]; p.dt_bias = (const float*)d_in[13]; p.gdn_norm = (const float*)d_in[14]; p.sinks = (const float*)d_in[15];
    p.w_out = (const float*)d_in[16]; p.norm_ffn2 = (const float*)d_in[17]; p.w_ffn2_in = (const float*)d_in[18]; p.w_ffn2_out = (const float*)d_in[19];
    p.norm_final = (const float*)d_in[20]; p.out = (float*)d_out; p.ws = (unsigned char*)d_ws; return p;
}
#define WSB(off) ((bf16_t*)(p.ws + lay::off))
#define WSF(off) ((float*)(p.ws + lay::off))

static void nb_ffn1(const Ptrs& p, hipStream_t stream) {
    using namespace cfg; using namespace nv;
    NV_LAUNCH(RmsnormIn, M, p.x_prompt, p.x_sample, p.norm_ffn1, WSB(WS_XN1));
    NV_LAUNCH(GemmSwiglu, (long)(M / 4) * (FF / 4), (const bf16_t*)WSB(WS_XN1), p.w_ffn1_in, WSB(WS_HB), D);
    NV_LAUNCH(Gemm<float>, (long)(M / 4) * (D / 4), (const bf16_t*)WSB(WS_HB), FF, p.w_ffn1_out, D, WSF(WS_T1), D, D, FF);
    NV_LAUNCH(AxpyIn, (long)M * D, p.x_prompt, p.x_sample, (const float*)WSF(WS_T1), 0.5f, WSF(WS_X1));
}
static void nb_inproj(const Ptrs& p, hipStream_t stream) {
    using namespace cfg; using namespace nv;
    NV_LAUNCH(Rmsnorm<bf16_t>, M, (const float*)WSF(WS_X1), p.norm_mix, WSB(WS_X1B));
    const bf16_t* A = WSB(WS_X1B);
    NV_LAUNCH(Gemm<bf16_t>, (long)(M / 4) * (CONV / 4), A, D, p.w_in + U_RAW, DIN, WSB(WS_RAW), CONV, CONV, D);
    NV_LAUNCH(Gemm<bf16_t>, (long)(M / 4) * (1024 / 4), A, D, p.w_in + U_Z, DIN, WSB(WS_Z), 1024, 1024, D);
    NV_LAUNCH(Gemm<float>, (long)(M / 4) * (16 / 4), A, D, p.w_in + U_A, DIN, WSF(WS_AB), 16, 16, D);
    NV_LAUNCH(Gemm<bf16_t>, (long)(M / 4) * (1024 / 4), A, D, p.w_in + U_QS, DIN, WSB(WS_QS), 1024, 1024, D);
    NV_LAUNCH(Gemm<bf16_t>, (long)(M / 4) * (256 / 4), A, D, p.w_in + U_KS, DIN, WSB(WS_KS), 256, 256, D);
    NV_LAUNCH(Gemm<bf16_t>, (long)(M / 4) * (256 / 4), A, D, p.w_in + U_VS, DIN, WSB(WS_VS), 256, 256, D);
    NV_LAUNCH(Gemm<bf16_t>, (long)(M / 4) * (1024 / 4), A, D, p.w_in + U_GA, DIN, WSB(WS_GA), 1024, 1024, D);
    NV_LAUNCH(Gemm<bf16_t>, (long)(M / 4) * (1024 / 4), A, D, p.w_in + U_GB, DIN, WSB(WS_GB), 1024, 1024, D);
}
static void nb_mixer(const Ptrs& p, hipStream_t stream) {
    using namespace cfg; using namespace nv;
    float* out = p.out;
    NV_LAUNCH(OutConv, (long)(BATCH + DB) * 3 * CONV, (const bf16_t*)WSB(WS_RAW), out + O_CP, out + O_CS);
    NV_LAUNCH(ConvInPlace, (long)(BATCH + DB) * CONV, WSB(WS_RAW), p.state_conv, p.conv_w);
    NV_LAUNCH(L2norm, (long)M * 16, WSB(WS_RAW));
    NV_LAUNCH(Gdn, (long)(BATCH + DB) * H * DV, (const float*)WSF(WS_AB), (const bf16_t*)WSB(WS_RAW), p.state_gdn, p.a_log, p.dt_bias, WSB(WS_OG), out + O_GP, out + O_GS);
    NV_LAUNCH(Rope, (long)M * 160, WSB(WS_QS), WSB(WS_KS));
    NV_LAUNCH(OutKV, (long)(BATCH + DB) * WIN * 256, (const bf16_t*)WSB(WS_KS), (const bf16_t*)WSB(WS_VS), p.cache_k, p.cache_v, out + O_KP, out + O_KS, out + O_VP, out + O_VS);
    NV_LAUNCH(SwaPrompt, (long)MP * QH, WSB(WS_QS), (const bf16_t*)WSB(WS_KS), (const bf16_t*)WSB(WS_VS), p.sinks);
    NV_LAUNCH(SwaSample, (long)MS * QH, WSB(WS_QS), (const bf16_t*)WSB(WS_KS), (const bf16_t*)WSB(WS_VS), p.cache_k, p.cache_v, p.sinks);
    NV_LAUNCH(Mix, (long)M * H, (const bf16_t*)WSB(WS_Z), WSB(WS_GA), (const bf16_t*)WSB(WS_GB), (const bf16_t*)WSB(WS_OG), (const bf16_t*)WSB(WS_OS), p.gdn_norm);
}
static void nb_tail(const Ptrs& p, hipStream_t stream) {
    using namespace cfg; using namespace nv;
    NV_LAUNCH(Gemm<float>, (long)(M / 4) * (D / 4), (const bf16_t*)WSB(WS_MIXED), 1024, p.w_out, D, WSF(WS_T1), D, D, 1024);
    NV_LAUNCH(Axpy, (long)M * D, (const float*)WSF(WS_X1), (const float*)WSF(WS_T1), 1.0f, WSF(WS_X1));
    NV_LAUNCH(Rmsnorm<bf16_t>, M, (const float*)WSF(WS_X1), p.norm_ffn2, WSB(WS_X2B));
    NV_LAUNCH(GemmSwiglu, (long)(M / 4) * (FF / 4), (const bf16_t*)WSB(WS_X2B), p.w_ffn2_in, WSB(WS_HB), D);
    NV_LAUNCH(Gemm<float>, (long)(M / 4) * (D / 4), (const bf16_t*)WSB(WS_HB), FF, p.w_ffn2_out, D, WSF(WS_T1), D, D, FF);
    NV_LAUNCH(Axpy, (long)M * D, (const float*)WSF(WS_X1), (const float*)WSF(WS_T1), 0.5f, WSF(WS_X1));
    NV_LAUNCH(Rmsnorm<float>, M, (const float*)WSF(WS_X1), p.norm_final, p.out + O_YP);
}
extern "C" void kernel_launch(void* const* d_in, const int* in_sizes, int n_in, void* d_out, int out_size, void* d_ws, size_t ws_size, hipStream_t stream) {
    (void)in_sizes; (void)n_in; (void)out_size;
    if (ws_size < lay::WS_END) return;
#ifndef CPU_EMU
    mk::mega_launch(d_in, d_out, d_ws, mk::P_PRO, mk::P_COUNT, stream);
#else
    const Ptrs p = make_ptrs(d_in, d_out, d_ws);
    nb_ffn1(p, stream); nb_inproj(p, stream); nb_mixer(p, stream); nb_tail(p, stream);
#endif
}
```

```cpp
#ifndef CPU_EMU
#include <hip/hip_runtime.h>
#endif
#include <cmath>
#include <cstdint>
#include <cstddef>

#ifndef CFG_D_MODEL
#define CFG_D_MODEL 1024
#define CFG_BATCH 4
#define CFG_SEQ 4096
#define CFG_DEC_BATCH 128
#define CFG_DEC_SEQ 8
#define CFG_D_FF 2816
#endif
namespace cfg {
constexpr int D = CFG_D_MODEL, BATCH = CFG_BATCH, SEQ = CFG_SEQ, DB = CFG_DEC_BATCH, DS = CFG_DEC_SEQ, FF = CFG_D_FF;
constexpr int PAST = 16384;
constexpr int MP = BATCH * SEQ, MS = DB * DS, M = MP + MS;
constexpr int H = 8, DK = 128, DV = 128, CONV = 3072, QH = 16, KVH = 4, HD = 64, WIN = 128;
constexpr int DIN = 3072 + 1024 + 16 + 1024 + 256 + 256 + 2 * D;
constexpr int U_RAW = 0, U_Z = 3072, U_A = 4096, U_B = 4104, U_QS = 4112, U_KS = 5136, U_VS = 5392, U_GA = 5648, U_GB = 5648 + D;
constexpr float EPS = 1e-6f;
constexpr size_t O_YP = 0, O_YS = O_YP + (size_t)MP * D, O_CP = O_YS + (size_t)MS * D, O_CS = O_CP + (size_t)BATCH * 3 * CONV,
                 O_GP = O_CS + (size_t)DB * 3 * CONV, O_GS = O_GP + (size_t)BATCH * H * DK * DV, O_KP = O_GS + (size_t)DB * H * DK * DV,
                 O_KS = O_KP + (size_t)BATCH * WIN * KVH * HD, O_VP = O_KS + (size_t)DB * WIN * KVH * HD,
                 O_VS = O_VP + (size_t)BATCH * WIN * KVH * HD, O_END = O_VS + (size_t)DB * WIN * KVH * HD;
}

#ifdef CPU_EMU
#define HDI inline
template <class K, class... A> void nv_launch(long n, A... a) { for (long g = 0; g < n; ++g) K::run(g, a...); }
#define NV_LAUNCH(K, n, ...) nv_launch<K>((long)(n), __VA_ARGS__)
#else
#define HDI __device__ __forceinline__
template <class K, class... A> __global__ void __launch_bounds__(256) nv_kernel(long n, A... a) {
    for (long g = (long)blockIdx.x * blockDim.x + threadIdx.x; g < n; g += (long)gridDim.x * blockDim.x) K::run(g, a...);
}
#define NV_LAUNCH(K, n, ...) do { long _n = (long)(n); long _b = (_n + 255) / 256; if (_b > 65536 * 4) _b = 65536 * 4; if (_b < 1) _b = 1; \
    nv_kernel<K><<<dim3((unsigned)_b), dim3(256), 0, stream>>>(_n, __VA_ARGS__); } while (0)
#endif

typedef unsigned short bf16_t;
namespace lay {
using namespace cfg;
constexpr size_t MiB = (size_t)1 << 20;
constexpr size_t WS_CTL = 0, WS_W1IN = 1 * MiB, WS_W1OUT = 12 * MiB, WS_WIN = 18 * MiB, WS_WAB = 33 * MiB, WS_WOUT = 34 * MiB, WS_W2IN = 36 * MiB, WS_W2OUT = 47 * MiB;
constexpr size_t WS_SSQ1 = 53 * MiB, WS_SSQ2 = 55 * MiB, WS_SSQ3 = 57 * MiB, WS_AB = 59 * MiB;
constexpr size_t WS_XN1 = 62 * MiB, WS_X2B = WS_XN1, WS_X1B = 96 * MiB, WS_X1 = 130 * MiB, WS_RAW = 198 * MiB, WS_Z = 300 * MiB, WS_QS = 334 * MiB, WS_OS = WS_QS;
constexpr size_t WS_KS = 368 * MiB, WS_VS = 377 * MiB, WS_GA = 386 * MiB, WS_MIXED = WS_GA, WS_GB = 420 * MiB, WS_OG = 454 * MiB, WS_HB = 488 * MiB, WS_END = 671 * MiB;
constexpr size_t WS_WK = 488 * MiB, WS_QG = 520 * MiB, WS_KGT = 552 * MiB, WS_QKP = 584 * MiB, WS_UV = 600 * MiB, WS_GL = 664 * MiB, WS_QKVS = 665 * MiB;
constexpr size_t WS_T1 = WS_RAW;
static_assert((size_t)M * D * 2 <= 34 * MiB && (size_t)M * D * 4 <= 68 * MiB && (size_t)M * CONV * 2 <= 102 * MiB && (size_t)M * FF * 2 <= 144 * MiB && (size_t)M * 256 * 2 <= 9 * MiB && (size_t)M * 16 * 4 <= 2 * MiB, "layout");
constexpr size_t WS_VN = 1 * MiB, WS_QN = 62 * MiB, WS_KN = 94 * MiB;
static_assert((size_t)MP * 1024 * 2 <= 32 * MiB, "layout");
}
namespace nv {
using namespace cfg;
HDI float bf2f(bf16_t v) { union { unsigned u; float f; } c; c.u = (unsigned)v << 16; return c.f; }
HDI bf16_t f2bf(float f) { union { unsigned u; float f; } c; c.f = f; return (bf16_t)((c.u + 0x7fffu + ((c.u >> 16) & 1u)) >> 16); }
HDI float ld(const float* p) { return *p; }
HDI float ld(const bf16_t* p) { return bf2f(*p); }
HDI void st(float* p, float v) { *p = v; }
HDI void st(bf16_t* p, float v) { *p = f2bf(v); }
HDI float silu_f(float x) { return x / (1.0f + expf(-x)); }
HDI float sigmoid_f(float x) { return 1.0f / (1.0f + expf(-x)); }
HDI float softplus_f(float x) { return x > 20.f ? x : log1pf(expf(x)); }
HDI const float* xrow(const float* xp, const float* xs, long r) { return r < MP ? xp + r * D : xs + (r - MP) * D; }

struct RmsnormIn {
    static HDI void run(long r, const float* xp, const float* xs, const float* w, bf16_t* out) {
        const float* xr = xrow(xp, xs, r); float s = 0.f;
        for (int c = 0; c < D; ++c) s += xr[c] * xr[c];
        const float rs = 1.0f / sqrtf(s / (float)D + EPS);
        for (int c = 0; c < D; ++c) out[r * D + c] = f2bf(xr[c] * rs * w[c]);
    }
};
template <class TO> struct Rmsnorm {
    static HDI void run(long r, const float* x, const float* w, TO* out) {
        const float* xr = x + r * D; float s = 0.f;
        for (int c = 0; c < D; ++c) s += xr[c] * xr[c];
        const float rs = 1.0f / sqrtf(s / (float)D + EPS);
        for (int c = 0; c < D; ++c) st(out + r * D + c, xr[c] * rs * w[c]);
    }
};
template <class TC> struct Gemm {
    static HDI void run(long g, const bf16_t* A, int lda, const float* B, int ldb, TC* C, int ldc, int N, int K) {
        const int nq = N / 4; const long mi = g / nq; const int ni = (int)(g % nq);
        float acc[4][4];
#pragma unroll
        for (int i = 0; i < 4; ++i)
#pragma unroll
            for (int j = 0; j < 4; ++j) acc[i][j] = 0.f;
        const bf16_t* a0 = A + (mi * 4) * lda; const float* bp = B + ni * 4;
        for (int k = 0; k < K; ++k) {
            const float b0 = bp[(long)k * ldb], b1 = bp[(long)k * ldb + 1], b2 = bp[(long)k * ldb + 2], b3 = bp[(long)k * ldb + 3];
#pragma unroll
            for (int i = 0; i < 4; ++i) { const float a = bf2f(a0[(long)i * lda + k]); acc[i][0] += a * b0; acc[i][1] += a * b1; acc[i][2] += a * b2; acc[i][3] += a * b3; }
        }
#pragma unroll
        for (int i = 0; i < 4; ++i)
#pragma unroll
            for (int j = 0; j < 4; ++j) st(C + (mi * 4 + i) * ldc + ni * 4 + j, acc[i][j]);
    }
};
struct GemmSwiglu {
    static HDI void run(long g, const bf16_t* A, const float* B, bf16_t* Hh, int K) {
        const int nq = FF / 4; const long mi = g / nq; const int ni = (int)(g % nq);
        float ag[4][4], au[4][4];
#pragma unroll
        for (int i = 0; i < 4; ++i)
#pragma unroll
            for (int j = 0; j < 4; ++j) { ag[i][j] = 0.f; au[i][j] = 0.f; }
        const bf16_t* a0 = A + (mi * 4) * K; const float* bp = B + ni * 4;
        for (int k = 0; k < K; ++k) {
            float bg[4], bu[4];
#pragma unroll
            for (int j = 0; j < 4; ++j) { bg[j] = bp[(long)k * 2 * FF + j]; bu[j] = bp[(long)k * 2 * FF + FF + j]; }
#pragma unroll
            for (int i = 0; i < 4; ++i) { const float a = bf2f(a0[(long)i * K + k]);
#pragma unroll
                for (int j = 0; j < 4; ++j) { ag[i][j] += a * bg[j]; au[i][j] += a * bu[j]; } }
        }
#pragma unroll
        for (int i = 0; i < 4; ++i)
#pragma unroll
            for (int j = 0; j < 4; ++j) Hh[(mi * 4 + i) * FF + ni * 4 + j] = f2bf(silu_f(ag[i][j]) * au[i][j]);
    }
};
struct AxpyIn {
    static HDI void run(long g, const float* xp, const float* xs, const float* T, float alpha, float* out) { const long r = g / D; const int c = (int)(g % D); out[g] = xrow(xp, xs, r)[c] + alpha * T[g]; }
};
struct Axpy {
    static HDI void run(long g, const float* a, const float* b, float alpha, float* out) { out[g] = a[g] + alpha * b[g]; }
};
HDI void row_info(long r, int& is_s, int& seq, int& t, int& L, long& base) {
    if (r < MP) { is_s = 0; seq = (int)(r / SEQ); t = (int)(r % SEQ); L = SEQ; base = (long)seq * SEQ; }
    else { const long rr = r - MP; is_s = 1; seq = (int)(rr / DS); t = (int)(rr % DS); L = DS; base = MP + (long)seq * DS; }
}
struct ConvInPlace {
    static HDI void run(long g, bf16_t* RAW, const float* state_conv, const float* conv_w) {
        const int c = (int)(g % CONV); const int sq = (int)(g / CONV);
        const int is_s = sq >= BATCH; const int seq = is_s ? sq - BATCH : sq; const int L = is_s ? DS : SEQ;
        const long base = is_s ? MP + (long)seq * DS : (long)seq * SEQ;
        const float w0 = conv_w[0 * CONV + c], w1 = conv_w[1 * CONV + c], w2 = conv_w[2 * CONV + c], w3 = conv_w[3 * CONV + c];
        float e0 = is_s ? state_conv[((long)seq * 3 + 0) * CONV + c] : 0.f;
        float e1 = is_s ? state_conv[((long)seq * 3 + 1) * CONV + c] : 0.f;
        float e2 = is_s ? state_conv[((long)seq * 3 + 2) * CONV + c] : 0.f;
        for (int t = 0; t < L; ++t) {
            const float e3 = bf2f(RAW[(base + t) * CONV + c]);
            RAW[(base + t) * CONV + c] = f2bf(silu_f(w0 * e0 + w1 * e1 + w2 * e2 + w3 * e3));
            e0 = e1; e1 = e2; e2 = e3;
        }
    }
};
struct L2norm {
    static HDI void run(long g, bf16_t* QKV) {
        const long r = g / 16; const int hh = (int)(g % 16);
        bf16_t* p = QKV + r * CONV + hh * 128; float s = 0.f;
        for (int j = 0; j < 128; ++j) { const float v = bf2f(p[j]); s += v * v; }
        const float rs = 1.0f / sqrtf(s + EPS);
        for (int j = 0; j < 128; ++j) p[j] = f2bf(bf2f(p[j]) * rs);
    }
};
struct Gdn {
    static HDI void run(long g, const float* AB, const bf16_t* QKV, const float* state_gdn, const float* a_log, const float* dt_bias,
                        bf16_t* OG, float* out_gp, float* out_gs) {
        const int dv = (int)(g % DV); const int h = (int)((g / DV) % H); const int sq = (int)(g / (DV * H));
        const int is_s = sq >= BATCH; const int seq = is_s ? sq - BATCH : sq; const int L = is_s ? DS : SEQ;
        const long base = is_s ? MP + (long)seq * DS : (long)seq * SEQ;
        float S[DK];
#pragma unroll
        for (int j = 0; j < DK; ++j) S[j] = is_s ? state_gdn[(((long)seq * H + h) * DK + j) * DV + dv] : 0.f;
        const float ea = expf(a_log[h]), dtb = dt_bias[h];
        for (int t = 0; t < L; ++t) {
            const long r = base + t;
            const float a = AB[r * 16 + h], b = AB[r * 16 + 8 + h];
            const float gg = -ea * softplus_f(a + dtb), beta = sigmoid_f(b), alpha = expf(gg);
            const bf16_t* q = QKV + r * CONV + h * DK; const bf16_t* k = QKV + r * CONV + 1024 + h * DK;
            const float v = bf2f(QKV[r * CONV + 2048 + h * DV + dv]);
            float ks = 0.f;
#pragma unroll
            for (int j = 0; j < DK; ++j) ks += bf2f(k[j]) * S[j];
            const float vn = beta * (v - alpha * ks);
            float o = 0.f;
#pragma unroll
            for (int j = 0; j < DK; ++j) { S[j] = alpha * S[j] + bf2f(k[j]) * vn; o += bf2f(q[j]) * S[j]; }
            OG[r * 1024 + h * DV + dv] = f2bf(o * 0.08838834764831845f);
        }
        float* so = is_s ? out_gs : out_gp;
#pragma unroll
        for (int j = 0; j < DK; ++j) so[(((long)seq * H + h) * DK + j) * DV + dv] = S[j];
    }
};
struct Rope {
    static HDI void run(long g, bf16_t* QS, bf16_t* KS) {
        const int i = (int)(g % 8); const int hh = (int)((g / 8) % 20); const long r = g / 160;
        int is_s, seq, t, L; long base; row_info(r, is_s, seq, t, L, base);
        const float pos = (float)(is_s ? PAST + t : t);
        const float inv = powf(500000.0f, -(float)(2 * i) / 16.0f);
        const float ang = pos * inv; const float cs = cosf(ang), sn = sinf(ang);
        bf16_t* p = hh < 16 ? QS + r * 1024 + hh * 64 : KS + r * 256 + (hh - 16) * 64;
        const float x1 = bf2f(p[i]), x2 = bf2f(p[i + 8]);
        p[i] = f2bf(x1 * cs - x2 * sn); p[i + 8] = f2bf(x2 * cs + x1 * sn);
    }
};
struct SwaPrompt {
    static HDI void run(long g, bf16_t* QS, const bf16_t* KS, const bf16_t* VS, const float* sinks) {
        const int qh = (int)(g % QH); const long r = g / QH; const int b = (int)(r / SEQ), t = (int)(r % SEQ); const int kvh = qh / 4;
        float q[HD], o[HD];
#pragma unroll
        for (int d = 0; d < HD; ++d) { q[d] = bf2f(QS[r * 1024 + qh * HD + d]); o[d] = 0.f; }
        float m = sinks[qh], l = 1.0f;
        const int j0 = t - (WIN - 1) < 0 ? 0 : t - (WIN - 1);
        for (int j = j0; j <= t; ++j) {
            const long rk = (long)b * SEQ + j; const bf16_t* kp = KS + rk * 256 + kvh * HD; const bf16_t* vp = VS + rk * 256 + kvh * HD;
            float s = 0.f;
#pragma unroll
            for (int d = 0; d < HD; ++d) s += q[d] * bf2f(kp[d]);
            s *= 0.125f;
            const float mn = fmaxf(m, s), sc = expf(m - mn), p = expf(s - mn);
            l = l * sc + p;
#pragma unroll
            for (int d = 0; d < HD; ++d) o[d] = o[d] * sc + p * bf2f(vp[d]);
            m = mn;
        }
        const float il = 1.0f / l;
#pragma unroll
        for (int d = 0; d < HD; ++d) QS[r * 1024 + qh * HD + d] = f2bf(o[d] * il);
    }
};
struct SwaSample {
    static HDI void run(long g, bf16_t* QS, const bf16_t* KS, const bf16_t* VS, const float* ck, const float* cv, const float* sinks) {
        const int qh = (int)(g % QH); const long rr = g / QH; const int b = (int)(rr / DS), t = (int)(rr % DS); const int kvh = qh / 4;
        const long r = MP + rr;
        float q[HD], o[HD];
#pragma unroll
        for (int d = 0; d < HD; ++d) { q[d] = bf2f(QS[r * 1024 + qh * HD + d]); o[d] = 0.f; }
        float m = sinks[qh], l = 1.0f;
        for (int j = t + 1; j < WIN + t + 1; ++j) {
            float s = 0.f; float vv[HD];
            if (j < WIN) { const float* kp = ck + (((long)b * WIN + j) * KVH + kvh) * HD; const float* vp = cv + (((long)b * WIN + j) * KVH + kvh) * HD;
#pragma unroll
                for (int d = 0; d < HD; ++d) { s += q[d] * kp[d]; vv[d] = vp[d]; } }
            else { const long rk = MP + (long)b * DS + (j - WIN); const bf16_t* kp = KS + rk * 256 + kvh * HD; const bf16_t* vp = VS + rk * 256 + kvh * HD;
#pragma unroll
                for (int d = 0; d < HD; ++d) { s += q[d] * bf2f(kp[d]); vv[d] = bf2f(vp[d]); } }
            s *= 0.125f;
            const float mn = fmaxf(m, s), sc = expf(m - mn), p = expf(s - mn);
            l = l * sc + p;
#pragma unroll
            for (int d = 0; d < HD; ++d) o[d] = o[d] * sc + p * vv[d];
            m = mn;
        }
        const float il = 1.0f / l;
#pragma unroll
        for (int d = 0; d < HD; ++d) QS[r * 1024 + qh * HD + d] = f2bf(o[d] * il);
    }
};
struct Mix {
    static HDI void run(long g, const bf16_t* Z, bf16_t* GA, const bf16_t* GB, const bf16_t* OG, const bf16_t* OS, const float* gdn_norm) {
        const int h = (int)(g % H); const long r = g / H;
        const bf16_t* og = OG + r * 1024 + h * DV; float s = 0.f;
        for (int j = 0; j < DV; ++j) { const float v = bf2f(og[j]); s += v * v; }
        const float rs = 1.0f / sqrtf(s / (float)DV + EPS);
        for (int j = 0; j < DV; ++j) {
            const long c = r * 1024 + h * DV + j;
            const float z = bf2f(Z[c]), ga = bf2f(GA[c]), gb = bf2f(GB[c]);
            GA[c] = f2bf(sigmoid_f(ga) * (bf2f(og[j]) * rs * gdn_norm[j] * silu_f(z)) + sigmoid_f(gb) * bf2f(OS[c]));
        }
    }
};
struct OutConv {
    static HDI void run(long g, const bf16_t* RAW, float* out_cp, float* out_cs) {
        const int c = (int)(g % CONV); const int i = (int)((g / CONV) % 3); const int sq = (int)(g / (3 * CONV));
        const int is_s = sq >= BATCH; const int seq = is_s ? sq - BATCH : sq; const int L = is_s ? DS : SEQ;
        const long base = is_s ? MP + (long)seq * DS : (long)seq * SEQ;
        const float v = bf2f(RAW[(base + L - 3 + i) * CONV + c]);
        (is_s ? out_cs : out_cp)[((long)seq * 3 + i) * CONV + c] = v;
    }
};
struct OutKV {
    static HDI void run(long g, const bf16_t* KS, const bf16_t* VS, const float* ck, const float* cv, float* out_kp, float* out_ks, float* out_vp, float* out_vs) {
        const int c = (int)(g % 256); const int j = (int)((g / 256) % WIN); const int sq = (int)(g / (256 * WIN));
        if (sq < BATCH) {
            const long r = (long)sq * SEQ + SEQ - WIN + j;
            out_kp[((long)sq * WIN + j) * 256 + c] = bf2f(KS[r * 256 + c]); out_vp[((long)sq * WIN + j) * 256 + c] = bf2f(VS[r * 256 + c]);
        } else {
            const int b = sq - BATCH; float kv, vv;
            if (j + DS < WIN) { kv = ck[((long)b * WIN + j + DS) * 256 + c]; vv = cv[((long)b * WIN + j + DS) * 256 + c]; }
            else { const long r = MP + (long)b * DS + (j + DS - WIN); kv = bf2f(KS[r * 256 + c]); vv = bf2f(VS[r * 256 + c]); }
            out_ks[((long)b * WIN + j) * 256 + c] = kv; out_vs[((long)b * WIN + j) * 256 + c] = vv;
        }
    }
};
}
namespace pg8 {
#define PG8_LAS __attribute__((address_space(3)))
typedef short bf16x8 __attribute__((ext_vector_type(8)));
typedef float f32x4 __attribute__((ext_vector_type(4)));
typedef unsigned u32x4 __attribute__((ext_vector_type(4)));
constexpr int BM = 256, BK = 64, HALF = 128, HTB = HALF * BK * 2  , STAGE_BYTES = 8 * HTB, NXCD = 8, WGM = 8;

__host__ __device__ __forceinline__ int lds_byte(int r, int c) { const int st = (r >> 4) * 2 + (c >> 5), rr = r & 15, cc = c & 31, ob = rr * 64 + cc * 2; return st * 1024 + (ob ^ (((ob >> 9) & 1) << 5)); }
__host__ __device__ __forceinline__ void stage_rc(int b, int& R, int& C) { const int st = b / 1024, sb = b % 1024, swz = sb ^ (((sb >> 9) & 1) << 5); R = (st >> 1) * 16 + swz / 64; C = (st & 1) * 32 + (swz % 64) / 2; }
__host__ __device__ __forceinline__ int perm32(int rho) { const int n = rho >> 4, i = rho & 15; return 8 * (i >> 2) + 4 * n + (i & 3); }

struct Unit { int pm, pn; };
struct Gemm { const bf16_t* A; const bf16_t* Bt; int M, N, K; };

struct StaticOrder {
    int nM, nN, nwg, G, c;
    __host__ __device__ void init(int M, int N, int G_, int c_) { nM = M / BM; nN = N / BM; nwg = nM * nN; G = G_; c = c_; }
    __host__ __device__ bool next(int i, Unit& u) const {
        const long L = (long)i * G + c; if (L >= nwg) return false;
        int wgid = (int)L; { const int q = nwg / NXCD, r = nwg % NXCD, xcd = wgid % NXCD, off = wgid / NXCD; wgid = (xcd < r ? xcd * (q + 1) : r * (q + 1) + (xcd - r) * q) + off; }
        const int nig = WGM * nN, gid = wgid / nig, fm = gid * WGM, gsz = (nM - fm) < WGM ? (nM - fm) : WGM;
        u.pm = fm + ((wgid % nig) % gsz); u.pn = (wgid % nig) / gsz; return true;
    }
    __device__ __forceinline__ void a_ready(const Unit&) const {}
    __device__ __forceinline__ void done(const Unit&) const {}
};
typedef unsigned u32x2 __attribute__((ext_vector_type(2)));
__device__ __forceinline__ unsigned cvt_pk_bf16(float lo, float hi) { unsigned r; asm volatile("v_cvt_pk_bf16_f32 %0, %1, %2" : "=v"(r) : "v"(lo), "v"(hi)); return r; }
__device__ __forceinline__ float fast_sigmoid(float x) { return __builtin_amdgcn_rcpf(1.0f + __builtin_amdgcn_exp2f(-1.4426950408889634f * x)); }
__device__ __forceinline__ float fast_silu(float x) { return x * fast_sigmoid(x); }
__device__ __forceinline__ void load_rs(float (&rs)[2][4], const float* ssq, int pm, int wr, int fr, int fq) {
#pragma unroll
    for (int ai = 0; ai < 2; ++ai)
#pragma unroll
        for (int m = 0; m < 4; ++m) {
            const int row = pm * BM + ai * HALF + wr * 64 + m * 16 + fr;
            const f32x4 v = *(const f32x4*)(ssq + (size_t)row * 16 + 4 * fq);
            float s = (v[0] + v[1]) + (v[2] + v[3]);
            s += __shfl_xor(s, 16); s += __shfl_xor(s, 32);
            rs[ai][m] = 1.0f / sqrtf(s * (1.0f / 1024.0f) + 1e-6f);
        }
}
struct EpiSwiglu {
    static constexpr bool PERM = true, AFTER_DRAIN = false;
    bf16_t* Hh; int ldh; const float* ssq;
    __device__ __forceinline__ void operator()(const f32x4 (&acc)[2][2][4][2], const Unit& u, int wr, int wc, int fr, int fq) const {
        float rs[2][4];
        if (ssq) load_rs(rs, ssq, u.pm, wr, fr, fq);
        const int col0 = u.pn * HALF + wc * 32 + 8 * fq;
#pragma unroll
        for (int ai = 0; ai < 2; ++ai)
#pragma unroll
            for (int m = 0; m < 4; ++m) {
                const float r_ = ssq ? rs[ai][m] : 1.0f;
                const int row = u.pm * BM + ai * HALF + wr * 64 + m * 16 + fr;
                float hv[8];
#pragma unroll
                for (int n = 0; n < 2; ++n)
#pragma unroll
                    for (int i = 0; i < 4; ++i) { const float g = acc[ai][0][m][n][i] * r_, up = acc[ai][1][m][n][i] * r_; hv[4 * n + i] = fast_silu(g) * up; }
                u32x4 w; w.x = cvt_pk_bf16(hv[0], hv[1]); w.y = cvt_pk_bf16(hv[2], hv[3]); w.z = cvt_pk_bf16(hv[4], hv[5]); w.w = cvt_pk_bf16(hv[6], hv[7]);
                *(u32x4*)(Hh + (size_t)row * ldh + col0) = w;
            }
    }
};
struct EpiInProj {
    static constexpr bool PERM = true, AFTER_DRAIN = false;
    bf16_t *raw, *z, *qs, *ks, *vs, *ga, *gb; const float* ssq;
    __device__ __forceinline__ void operator()(const f32x4 (&acc)[2][2][4][2], const Unit& u, int wr, int wc, int fr, int fq) const {
        float rs[2][4]; load_rs(rs, ssq, u.pm, wr, fr, fq);
        bf16_t* base; int ldc, colt; const int pn = u.pn;
        if (pn < 12) { base = raw; ldc = 3072; colt = pn * 256; }
        else if (pn < 16) { base = z; ldc = 1024; colt = (pn - 12) * 256; }
        else if (pn < 20) { base = qs; ldc = 1024; colt = (pn - 16) * 256; }
        else if (pn == 20) { base = ks; ldc = 256; colt = 0; }
        else if (pn == 21) { base = vs; ldc = 256; colt = 0; }
        else if (pn < 26) { base = ga; ldc = 1024; colt = (pn - 22) * 256; }
        else { base = gb; ldc = 1024; colt = (pn - 26) * 256; }
        const int col0 = colt + wc * 32 + 8 * fq;
#pragma unroll
        for (int ai = 0; ai < 2; ++ai)
#pragma unroll
            for (int m = 0; m < 4; ++m) {
                const float r_ = rs[ai][m];
                bf16_t* rowp = base + (size_t)(u.pm * BM + ai * HALF + wr * 64 + m * 16 + fr) * ldc + col0;
#pragma unroll
                for (int bj = 0; bj < 2; ++bj) { const f32x4 v0 = acc[ai][bj][m][0] * r_, v1 = acc[ai][bj][m][1] * r_;
                    u32x4 w; w.x = cvt_pk_bf16(v0[0], v0[1]); w.y = cvt_pk_bf16(v0[2], v0[3]); w.z = cvt_pk_bf16(v1[0], v1[1]); w.w = cvt_pk_bf16(v1[2], v1[3]);
                    *(u32x4*)(rowp + bj * HALF) = w; }
            }
    }
};
struct EpiResid {
    static constexpr bool PERM = false, AFTER_DRAIN = false;
    const float* xin_p; const float* xin_s; int split_row; float alpha; float* xout; bf16_t* xb; float* ssq;
    __device__ __forceinline__ void operator()(const f32x4 (&acc)[2][2][4][2], const Unit& u, int wr, int wc, int fr, int fq) const {
        const int col0 = u.pn * BM + wc * 32 + 4 * fq;
#pragma unroll
        for (int ai = 0; ai < 2; ++ai)
#pragma unroll
            for (int m = 0; m < 4; ++m) {
                const int row = u.pm * BM + ai * HALF + wr * 64 + m * 16 + fr;
                const float* xr = (row < split_row ? xin_p + (size_t)row * 1024 : xin_s + (size_t)(row - split_row) * 1024) + col0;
                float* orow = xout + (size_t)row * 1024 + col0;
                float ss = 0.f;
#pragma unroll
                for (int bj = 0; bj < 2; ++bj)
#pragma unroll
                    for (int n = 0; n < 2; ++n) {
                        const f32x4 xi = *(const f32x4*)(xr + bj * HALF + n * 16);
                        const f32x4 o = xi + acc[ai][bj][m][n] * alpha;
                        *(f32x4*)(orow + bj * HALF + n * 16) = o;
                        if (xb) { u32x2 w; w.x = cvt_pk_bf16(o[0], o[1]); w.y = cvt_pk_bf16(o[2], o[3]); *(u32x2*)(xb + (size_t)row * 1024 + col0 + bj * HALF + n * 16) = w; }
                        ss += (o[0] * o[0] + o[1] * o[1]) + (o[2] * o[2] + o[3] * o[3]);
                    }
                ss += __shfl_xor(ss, 16); ss += __shfl_xor(ss, 32);
                if (fq == 0) ssq[(size_t)row * 16 + u.pn * 4 + wc] = ss;
                if (m & 1) asm volatile("" ::: "memory");
            }
    }
};
template <class Epi, class Sched, bool ALIGN_EPI = false, bool SP2 = false>
__device__ __forceinline__ void gemm_phase(PG8_LAS unsigned char* lds, const Gemm g, const Sched& S, const Epi& E) {
    const int tid = threadIdx.x, wid = __builtin_amdgcn_readfirstlane(tid >> 6), lane = tid & 63, wr = wid >> 2, wc = wid & 3, fr = lane & 15, fq = lane >> 4;
    const int K = g.K, nt = K / BK;
    unsigned voffA[2], voffB[2];
#pragma unroll
    for (int i = 0; i < 2; ++i) { int R, C; stage_rc(tid * 16 + i * 8192, R, C); const int Rb = Epi::PERM ? ((R & ~31) + perm32(R & 31)) : R;
        voffA[i] = (unsigned)(R * K + C) * 2u; voffB[i] = (unsigned)(Rb * K + C) * 2u; }
    const size_t kstep = (size_t)(BK * 2);
    const size_t hstep = (size_t)HALF * K * 2;
    const size_t tstep = 2 * hstep;
    const unsigned ldsw = (unsigned)wid * 1024u;
    const int aoff = lds_byte(wr * 64 + fr, fq * 8), boff = lds_byte(wc * 32 + fr, fq * 8);
#define PG8_SA(b, h) (((b) * 2 + (h)) * HTB)
#define PG8_SB(b, h) ((4 + (b) * 2 + (h)) * HTB)
#define PG8_STAGE(bufoff, gbase, voff) do { _Pragma("unroll") for (int _i = 0; _i < 2; ++_i) \
        __builtin_amdgcn_global_load_lds((const unsigned*)((const char*)(gbase) + (voff)[_i]), (PG8_LAS unsigned*)(lds + (bufoff) + ldsw + _i * 8192), 16, 0, 0); } while (0)
#define PG8_LDA(dst, b, h) do { _Pragma("unroll") for (int m = 0; m < 4; ++m) _Pragma("unroll") for (int k = 0; k < 2; ++k) dst[m][k] = *(const PG8_LAS bf16x8*)(lds + PG8_SA(b, h) + aoff + m * 2048 + k * 1024); } while (0)
#define PG8_LDB(dst, b, h) do { _Pragma("unroll") for (int n = 0; n < 2; ++n) _Pragma("unroll") for (int k = 0; k < 2; ++k) dst[n][k] = *(const PG8_LAS bf16x8*)(lds + PG8_SB(b, h) + boff + n * 2048 + k * 1024); } while (0)
#define PG8_MMA(ai, bj, At, Bt) do { __builtin_amdgcn_s_setprio(1); _Pragma("unroll") for (int m = 0; m < 4; ++m) _Pragma("unroll") for (int n = 0; n < 2; ++n) _Pragma("unroll") for (int k = 0; k < 2; ++k) \
        acc[ai][bj][m][n] = __builtin_amdgcn_mfma_f32_16x16x32_bf16(Bt[n][k], At[m][k], acc[ai][bj][m][n], 0, 0, 0); __builtin_amdgcn_s_setprio(0); } while (0)
#define PG8_WAIT_V(n) asm volatile("s_waitcnt vmcnt(" #n ")" ::: "memory")
#define PG8_WAIT_L(n) asm volatile("s_waitcnt lgkmcnt(" #n ")" ::: "memory")
#define PG8_BAR __builtin_amdgcn_s_barrier()
#define PG8_SCHED __builtin_amdgcn_sched_barrier(0)
    Unit cur, nxt; int ui = 0;
    if (!S.next(0, cur)) return;
    f32x4 acc[2][2][4][2];
#pragma unroll
    for (int a = 0; a < 2; ++a)
#pragma unroll
        for (int b = 0; b < 2; ++b)
#pragma unroll
            for (int m = 0; m < 4; ++m)
#pragma unroll
                for (int n = 0; n < 2; ++n) acc[a][b][m][n] = (f32x4){0.f, 0.f, 0.f, 0.f};
    bf16x8 At[4][2], B0[2][2], B1[2][2];
    const char* cA = (const char*)g.A + (size_t)cur.pm * tstep; const char* cB = (const char*)g.Bt + (size_t)cur.pn * tstep;
    S.a_ready(cur);
    if constexpr (SP2) {
        PG8_STAGE(PG8_SB(0, 0), cB, voffB); PG8_STAGE(PG8_SB(0, 1), cB + hstep, voffB); PG8_STAGE(PG8_SA(0, 0), cA, voffA); PG8_STAGE(PG8_SA(0, 1), cA + hstep, voffA);
        if (wr == 1) PG8_BAR;
        PG8_WAIT_V(2); PG8_BAR;
        PG8_STAGE(PG8_SB(1, 0), cB + kstep, voffB); PG8_STAGE(PG8_SA(1, 0), cA + kstep, voffA); PG8_STAGE(PG8_SB(1, 1), cB + hstep + kstep, voffB);
        PG8_WAIT_V(6); PG8_BAR;
    } else {
        PG8_STAGE(PG8_SB(0, 0), cB, voffB); PG8_STAGE(PG8_SA(0, 0), cA, voffA); PG8_STAGE(PG8_SB(0, 1), cB + hstep, voffB); PG8_STAGE(PG8_SA(0, 1), cA + hstep, voffA);
        if (wr == 1) PG8_BAR;
        PG8_WAIT_V(4); PG8_BAR;
        PG8_STAGE(PG8_SB(1, 0), cB + kstep, voffB); PG8_STAGE(PG8_SA(1, 0), cA + kstep, voffA); PG8_STAGE(PG8_SB(1, 1), cB + hstep + kstep, voffB);
        PG8_WAIT_V(6); PG8_BAR;
    }
    for (;;) {
        const bool has_next = S.next(ui + 1, nxt);
        const char* nA = has_next ? (const char*)g.A + (size_t)nxt.pm * tstep : cA; const char* nB = has_next ? (const char*)g.Bt + (size_t)nxt.pn * tstep : cB;
        for (int t = 0; t < nt; t += 2) {
            const bool last = (t == nt - 2);
            const char* a1 = cA + (size_t)(t + 1) * kstep;
            const char* a2 = last ? nA : cA + (size_t)(t + 2) * kstep; const char* b2 = last ? nB : cB + (size_t)(t + 2) * kstep;
            const char* a3 = a2 + kstep; const char* b3 = b2 + kstep;
            if (last && has_next) S.a_ready(nxt);
            if constexpr (SP2) {
            PG8_LDB(B0, 0, 0); PG8_LDB(B1, 0, 1); PG8_SCHED; PG8_LDA(At, 0, 0); PG8_STAGE(PG8_SA(1, 1), a1 + hstep, voffA);
            PG8_WAIT_V(8); PG8_WAIT_L(0); PG8_BAR; PG8_MMA(0, 0, At, B0); PG8_MMA(0, 1, At, B1); PG8_BAR; PG8_SCHED;
            PG8_LDA(At, 0, 1); PG8_STAGE(PG8_SB(0, 0), b2, voffB); PG8_STAGE(PG8_SB(0, 1), b2 + hstep, voffB); PG8_STAGE(PG8_SA(0, 0), a2, voffA);
            PG8_WAIT_V(8); PG8_WAIT_L(0); PG8_BAR; PG8_MMA(1, 0, At, B0); PG8_MMA(1, 1, At, B1); PG8_BAR; PG8_SCHED;
            PG8_LDB(B0, 1, 0); PG8_LDB(B1, 1, 1); PG8_SCHED; PG8_LDA(At, 1, 0); PG8_STAGE(PG8_SA(0, 1), a2 + hstep, voffA);
            PG8_WAIT_V(8); PG8_WAIT_L(0); PG8_BAR; PG8_MMA(0, 0, At, B0); PG8_MMA(0, 1, At, B1); PG8_BAR; PG8_SCHED;
            PG8_LDA(At, 1, 1); PG8_STAGE(PG8_SB(1, 0), b3, voffB); PG8_STAGE(PG8_SB(1, 1), b3 + hstep, voffB); PG8_STAGE(PG8_SA(1, 0), a3, voffA);
            PG8_WAIT_V(8); PG8_WAIT_L(0); PG8_BAR; PG8_MMA(1, 0, At, B0); PG8_MMA(1, 1, At, B1); PG8_BAR; PG8_SCHED;
            } else {
            PG8_LDB(B0, 0, 0); PG8_SCHED; PG8_LDA(At, 0, 0); PG8_STAGE(PG8_SA(1, 1), a1 + hstep, voffA);
            PG8_WAIT_L(8); PG8_BAR; PG8_WAIT_L(0); PG8_MMA(0, 0, At, B0); PG8_BAR; PG8_SCHED;
            PG8_LDB(B1, 0, 1); PG8_STAGE(PG8_SB(0, 0), b2, voffB);
            PG8_BAR; PG8_WAIT_L(0); PG8_MMA(0, 1, At, B1); PG8_BAR;
            PG8_LDA(At, 0, 1); PG8_STAGE(PG8_SA(0, 0), a2, voffA);
            PG8_BAR; PG8_WAIT_L(0); PG8_MMA(1, 0, At, B0); PG8_BAR; PG8_SCHED;
            PG8_STAGE(PG8_SB(0, 1), b2 + hstep, voffB);
            PG8_WAIT_V(6); PG8_BAR; PG8_MMA(1, 1, At, B1); PG8_BAR;
            PG8_LDB(B0, 1, 0); PG8_SCHED; PG8_LDA(At, 1, 0); PG8_STAGE(PG8_SA(0, 1), a2 + hstep, voffA);
            PG8_WAIT_L(8); PG8_BAR; PG8_WAIT_L(0); PG8_MMA(0, 0, At, B0); PG8_BAR; PG8_SCHED;
            PG8_LDB(B1, 1, 1); PG8_STAGE(PG8_SB(1, 0), b3, voffB);
            PG8_BAR; PG8_WAIT_L(0); PG8_MMA(0, 1, At, B1); PG8_BAR;
            PG8_LDA(At, 1, 1); PG8_STAGE(PG8_SA(1, 0), a3, voffA);
            PG8_BAR; PG8_WAIT_L(0); PG8_MMA(1, 0, At, B0); PG8_BAR; PG8_SCHED;
            PG8_STAGE(PG8_SB(1, 1), b3 + hstep, voffB);
            PG8_WAIT_V(6); PG8_BAR; PG8_MMA(1, 1, At, B1); PG8_BAR;
            }
        }
        if constexpr (ALIGN_EPI) { if (wr == 0) PG8_BAR; }
        if constexpr (!Epi::AFTER_DRAIN) { E(acc, cur, wr, wc, fr, fq); S.done(cur); }
        if (!has_next) break;
#pragma unroll
        for (int a = 0; a < 2; ++a)
#pragma unroll
            for (int b = 0; b < 2; ++b)
#pragma unroll
                for (int m = 0; m < 4; ++m)
#pragma unroll
                    for (int n = 0; n < 2; ++n) acc[a][b][m][n] = (f32x4){0.f, 0.f, 0.f, 0.f};
        cur = nxt; cA = nA; cB = nB; ++ui;
        if constexpr (ALIGN_EPI) { if (wr == 1) PG8_BAR; }
    }
    PG8_WAIT_V(0);
    if constexpr (!ALIGN_EPI) { if (wr == 0) PG8_BAR; }
    PG8_BAR;
    if constexpr (Epi::AFTER_DRAIN) { E.fused(acc, cur, wr, wc, fr, fq, lds, wid, lane); S.done(cur); }
#undef PG8_SA
#undef PG8_SB
#undef PG8_STAGE
#undef PG8_LDA
#undef PG8_LDB
#undef PG8_MMA
#undef PG8_WAIT_V
#undef PG8_WAIT_L
#undef PG8_BAR
#undef PG8_SCHED
}
}
#ifndef CPU_EMU
#include <hip/hip_cooperative_groups.h>
#include <cstdio>
namespace mk {
namespace cg = cooperative_groups;
using namespace cfg;
#define LAS __attribute__((address_space(3)))
#define GAS __attribute__((address_space(1)))
typedef float f32x4 __attribute__((ext_vector_type(4)));
typedef unsigned v4u __attribute__((ext_vector_type(4)));
typedef short bf16x8 __attribute__((ext_vector_type(8)));
constexpr int NWAVES = 8, NTHREADS = NWAVES * 64;
constexpr int LDS_BYTES = 163840;
#ifndef MK_EMBED_NB
#define MK_EMBED_NB 1
#endif
enum Phase { P_PRO = 0, P_FFN1A, P_FFN1B, P_INPROJ, P_PREP, P_MIXER, P_MERGE, P_OUTPROJ, P_FFN2A, P_FFN2B, P_FINAL, P_COUNT };

struct MArgs { const float* in[21]; float* out; unsigned char* ws; int ph_lo, ph_hi; };

__device__ __forceinline__ unsigned f2bf_u(float f) { unsigned u = __builtin_bit_cast(unsigned, f); return (u + 0x7fffu + ((u >> 16) & 1u)) >> 16; }
__device__ __forceinline__ unsigned pk2(float lo, float hi) { return f2bf_u(lo) | (f2bf_u(hi) << 16); }
__device__ __forceinline__ float wave_sum(float v) {
#pragma unroll
    for (int o = 1; o < 64; o <<= 1) v += __shfl_xor(v, o);
    return v;
}
__device__ __forceinline__ void transpose_item(const float* W, int ldw, int src_col0, bf16_t* WT, int K, int dst_row0, int nvalid, const float* kscale, LAS float* scr, int k0, int lane) {
#pragma unroll 8
    for (int i = 0; i < 32; ++i) { const int kk = 2 * i + (lane >> 5); float v = W[(size_t)(k0 + kk) * ldw + src_col0 + (lane & 31)]; if (kscale) v *= kscale[k0 + kk]; scr[kk * 33 + (lane & 31)] = v; }
    asm volatile("s_waitcnt lgkmcnt(0)" ::: "memory");
    const int c = lane & 7;
#pragma unroll
    for (int j = 0; j < 4; ++j) { const int n = (lane >> 3) + 8 * j; const LAS float* s = scr + (8 * c) * 33 + n;
        v4u o; o.x = pk2(s[0 * 33], s[1 * 33]); o.y = pk2(s[2 * 33], s[3 * 33]); o.z = pk2(s[4 * 33], s[5 * 33]); o.w = pk2(s[6 * 33], s[7 * 33]);
        if (n < nvalid) *(v4u*)(WT + (size_t)(dst_row0 + n) * K + k0 + 8 * c) = o; }
    asm volatile("s_waitcnt lgkmcnt(0)" ::: "memory");
}
struct Frame {
    LAS unsigned char* lds; int tid, lane, wave, G;
    const float* const* in; float* out; unsigned char* ws;
};
#define FB(off) ((bf16_t*)(F.ws + lay::off))
#define FF32(off) ((float*)(F.ws + lay::off))
enum { I_XP = 0, I_XS, I_SCONV, I_SGDN, I_CK, I_CV, I_NF1, I_W1IN, I_W1OUT, I_NMIX, I_WIN, I_CONVW, I_ALOG, I_DTB, I_GNORM, I_SINKS, I_WOUT, I_NF2, I_W2IN, I_W2OUT, I_NFIN };

__device__ __forceinline__ void p0_prologue(Frame& F) {
    LAS float* scr = (LAS float*)(F.lds + F.wave * 16384);
    const int gw = blockIdx.x * NWAVES + F.wave, NGW = F.G * NWAVES;
    constexpr int KB1 = D / 64, KB2 = FF / 64;
    constexpr int N_W1IN = KB1 * (2 * FF / 32), N_W1OUT = KB2 * (D / 32), N_WIN = KB1 * (7680 / 32), N_WAB = KB1, N_WOUT = KB1 * (D / 32);
    constexpr int NITEMS = 2 * N_W1IN + 2 * N_W1OUT + N_WIN + N_WAB + N_WOUT;
    for (int it = gw; it < NITEMS; it += NGW) {
        int r = it;
        if (r < 2 * N_W1IN) {
            const int second = r >= N_W1IN; if (second) r -= N_W1IN;
            const int nbs = 2 * FF / 32, kb = r / nbs, nb = r % nbs, pn = nb >> 3, bj = (nb >> 2) & 1, wi = nb & 3;
            transpose_item(F.in[second ? I_W2IN : I_W1IN], 2 * FF, bj * FF + pn * 128 + wi * 32, second ? FB(WS_W2IN) : FB(WS_W1IN), D, nb * 32, 32, second ? F.in[I_NF2] : nullptr, scr, kb * 64, F.lane);
            continue; }
        r -= 2 * N_W1IN;
        if (r < 2 * N_W1OUT) {
            const int second = r >= N_W1OUT; if (second) r -= N_W1OUT;
            const int nbs = D / 32, kb = r / nbs, nb = r % nbs;
            transpose_item(F.in[second ? I_W2OUT : I_W1OUT], D, nb * 32, second ? FB(WS_W2OUT) : FB(WS_W1OUT), FF, nb * 32, 32, nullptr, scr, kb * 64, F.lane);
            continue; }
        r -= 2 * N_W1OUT;
        if (r < N_WIN) {
            const int nbs = 7680 / 32, kb = r / nbs, nb = r % nbs, drow = nb * 32;
            transpose_item(F.in[I_WIN], DIN, drow + (drow >= 4096 ? 16 : 0), FB(WS_WIN), D, drow, 32, F.in[I_NMIX], scr, kb * 64, F.lane);
            continue; }
        r -= N_WIN;
        if (r < N_WAB) { transpose_item(F.in[I_WIN], DIN, 4096, FB(WS_WAB), D, 0, 16, F.in[I_NMIX], scr, r * 64, F.lane); continue; }
        r -= N_WAB;
        { const int nbs = D / 32, kb = r / nbs, nb = r % nbs; transpose_item(F.in[I_WOUT], D, nb * 32, FB(WS_WOUT), D, nb * 32, 32, nullptr, scr, kb * 64, F.lane); }
    }
    const float* nw = F.in[I_NF1];
    f32x4 wv[4];
#pragma unroll
    for (int j = 0; j < 4; ++j) wv[j] = *(const f32x4*)(nw + 4 * F.lane + 256 * j);
    for (int m = gw; m < M; m += NGW) {
        const float* xr = (m < MP ? F.in[I_XP] + (size_t)m * D : F.in[I_XS] + (size_t)(m - MP) * D) + 4 * F.lane;
        f32x4 v[4]; float s = 0.f;
#pragma unroll
        for (int j = 0; j < 4; ++j) { v[j] = *(const f32x4*)(xr + 256 * j); s += (v[j][0] * v[j][0] + v[j][1] * v[j][1]) + (v[j][2] * v[j][2] + v[j][3] * v[j][3]); }
        const float rs = 1.0f / sqrtf(wave_sum(s) * (1.0f / D) + EPS);
        unsigned long long* o8 = (unsigned long long*)(FB(WS_XN1) + (size_t)m * D) + F.lane;
#pragma unroll
        for (int j = 0; j < 4; ++j) { const f32x4 o = v[j] * rs * wv[j]; o8[64 * j] = (unsigned long long)pk2(o[0], o[1]) | ((unsigned long long)pk2(o[2], o[3]) << 32); }
    }
}
__device__ __forceinline__ void ab_tiles(Frame& F) {
    const int gw = blockIdx.x * NWAVES + F.wave, NGW = F.G * NWAVES; const int lane = F.lane, q = lane >> 4, c = lane & 15;
    const bf16_t* x1b = FB(WS_X1B); const bf16_t* wab = FB(WS_WAB); const float* ssq = FF32(WS_SSQ1); float* AB = FF32(WS_AB);
    for (int tile = gw; tile < M / 16; tile += NGW) {
        f32x4 acc = {0.f, 0.f, 0.f, 0.f};
        const bf16_t* ap = x1b + (size_t)(tile * 16 + c) * D + 8 * q; const bf16_t* bp = wab + (size_t)c * D + 8 * q;
#pragma unroll 8
        for (int s = 0; s < D / 32; ++s) { const bf16x8 a = *(const bf16x8*)(ap + 32 * s), b = *(const bf16x8*)(bp + 32 * s); acc = __builtin_amdgcn_mfma_f32_16x16x32_bf16(a, b, acc, 0, 0, 0); }
#pragma unroll
        for (int r = 0; r < 4; ++r) { const int row = tile * 16 + 4 * q + r; const float* sp = ssq + (size_t)row * 16;
            float s = 0.f;
#pragma unroll
            for (int i = 0; i < 4; ++i) { const f32x4 v = *(const f32x4*)(sp + 4 * i); s += (v[0] + v[1]) + (v[2] + v[3]); }
            AB[(size_t)row * 16 + c] = acc[r] * (1.0f / sqrtf(s * (1.0f / D) + EPS)); }
    }
}
__device__ __forceinline__ void final_norm(Frame& F) {
    const int gw = blockIdx.x * NWAVES + F.wave, NGW = F.G * NWAVES; const float* nw = F.in[I_NFIN];
    f32x4 wv[4];
#pragma unroll
    for (int j = 0; j < 4; ++j) wv[j] = *(const f32x4*)(nw + 4 * F.lane + 256 * j);
    for (int m = gw; m < M; m += NGW) {
        float* xr = F.out + O_YP + (size_t)m * D + 4 * F.lane;
        f32x4 v[4]; float s = 0.f;
#pragma unroll
        for (int j = 0; j < 4; ++j) { v[j] = *(const f32x4*)(xr + 256 * j); s += (v[j][0] * v[j][0] + v[j][1] * v[j][1]) + (v[j][2] * v[j][2] + v[j][3] * v[j][3]); }
        const float rs = 1.0f / sqrtf(wave_sum(s) * (1.0f / D) + EPS);
#pragma unroll
        for (int j = 0; j < 4; ++j) *(f32x4*)(xr + 256 * j) = v[j] * rs * wv[j];
    }
}

struct Gdn2 {
    static __device__ __forceinline__ void run(long g, const float* AB, const bf16_t* QKV, const float* state_gdn, const float* a_log, const float* dt_bias,
                        bf16_t* OG, float* out_gp, float* out_gs) {
        using namespace nv;
        const int half = (int)(g & 1); const long col = g >> 1;
        const int dv = (int)(col % DV); const int h = (int)((col / DV) % H); const int sq = (int)(col / (DV * H));
        const int is_s = sq >= BATCH; const int seq = is_s ? sq - BATCH : sq; const int L = is_s ? DS : SEQ;
        const long base = is_s ? MP + (long)seq * DS : (long)seq * SEQ;
        float S[64];
#pragma unroll
        for (int j = 0; j < 64; ++j) S[j] = is_s ? state_gdn[(((long)seq * H + h) * DK + 64 * half + j) * DV + dv] : 0.f;
        const float ea = expf(a_log[h]), dtb = dt_bias[h];
        for (int t = 0; t < L; ++t) {
            const long r = base + t;
            const float a = AB[r * 16 + h], b = AB[r * 16 + 8 + h];
            const float gg = -ea * softplus_f(a + dtb), beta = sigmoid_f(b), alpha = expf(gg);
            const bf16_t* q = QKV + r * CONV + h * DK + 64 * half; const bf16_t* k = QKV + r * CONV + 1024 + h * DK + 64 * half;
            const float v = bf2f(QKV[r * CONV + 2048 + h * DV + dv]);
            float ks = 0.f;
#pragma unroll
            for (int j = 0; j < 64; ++j) ks += bf2f(k[j]) * S[j];
            ks += __shfl_xor(ks, 1);
            const float vn = beta * (v - alpha * ks);
            float o = 0.f;
#pragma unroll
            for (int j = 0; j < 64; ++j) { S[j] = alpha * S[j] + bf2f(k[j]) * vn; o += bf2f(q[j]) * S[j]; }
            o += __shfl_xor(o, 1);
            if (half == 0) OG[r * 1024 + h * DV + dv] = f2bf(o * 0.08838834764831845f);
        }
        float* so = is_s ? out_gs : out_gp;
#pragma unroll
        for (int j = 0; j < 64; ++j) so[(((long)seq * H + h) * DK + 64 * half + j) * DV + dv] = S[j];
    }
};
namespace att {
typedef float f32x16 __attribute__((ext_vector_type(16)));
typedef unsigned u32x2 __attribute__((ext_vector_type(2)));
constexpr int KPB = 144;
constexpr int VPE = 196;
constexpr int NSLOT = 192;
constexpr int K_OFF = 0, V_OFF = NSLOT * KPB, BUF_BYTES = V_OFF + 64 * VPE * 2;
constexpr float LOG2E = 1.4426950408889634f;
__device__ __forceinline__ int crow(int r, int h) { return (r & 3) + 8 * (r >> 2) + 4 * h; }
__device__ __forceinline__ unsigned cvtpk(float lo, float hi) { unsigned r; asm volatile("v_cvt_pk_bf16_f32 %0, %1, %2" : "=v"(r) : "v"(lo), "v"(hi)); return r; }

__device__ __forceinline__ void attn_wave(const LAS unsigned char* Kl, const LAS unsigned char* Vl, const bf16x8 (&qf)[4], int kt0, int kpos0, int qpos, float sink, f32x16 (&o)[2], int lane) {
    const int r32 = lane & 31, h = lane >> 5;
    f32x16 S[5];
#pragma unroll
    for (int j = 0; j < 5; ++j) {
#pragma unroll
        for (int e = 0; e < 16; ++e) S[j][e] = 0.f;
        const LAS unsigned char* kp = Kl + (32 * (kt0 + j) + r32) * KPB + 16 * h;
#pragma unroll
        for (int s = 0; s < 4; ++s) { const bf16x8 a = *(const LAS bf16x8*)(kp + 32 * s); S[j] = __builtin_amdgcn_mfma_f32_32x32x16_bf16(a, qf[s], S[j], 0, 0, 0); }
    }
    const float sink2 = sink * LOG2E; float m = sink2;
    const int rel0 = qpos - kpos0 - 32 * kt0;
#pragma unroll
    for (int j = 0; j < 5; ++j)
#pragma unroll
        for (int e = 0; e < 16; ++e) { const int x = 32 * j + crow(e, h); const int rel = rel0 - x; const bool ok = (rel >= 0) && (rel <= 127) && (kpos0 + 32 * kt0 + x >= 0);
            const float v = ok ? S[j][e] * LOG2E : -INFINITY; S[j][e] = v; m = fmaxf(m, v); }
    m = fmaxf(m, __shfl_xor(m, 32));
    float l = 0.f;
#pragma unroll
    for (int j = 0; j < 5; ++j)
#pragma unroll
        for (int e = 0; e < 16; ++e) { const float p = __builtin_amdgcn_exp2f(S[j][e] - m); S[j][e] = p; l += p; }
    l += __shfl_xor(l, 32); l += __builtin_amdgcn_exp2f(sink2 - m);
    const float il = 1.0f / l;
#pragma unroll
    for (int mt = 0; mt < 2; ++mt) {
#pragma unroll
        for (int e = 0; e < 16; ++e) o[mt][e] = 0.f;
        const LAS unsigned char* vp = Vl + ((32 * mt + r32) * VPE + 32 * kt0 + 4 * h) * 2;
#pragma unroll
        for (int j = 0; j < 5; ++j)
#pragma unroll
            for (int s = 0; s < 2; ++s) {
                const u32x2 lo = *(const LAS u32x2*)(vp + (32 * j + 16 * s) * 2), hi = *(const LAS u32x2*)(vp + (32 * j + 16 * s + 8) * 2);
                v4u av; av.x = lo.x; av.y = lo.y; av.z = hi.x; av.w = hi.y;
                v4u pv; pv.x = cvtpk(S[j][8 * s + 0], S[j][8 * s + 1]); pv.y = cvtpk(S[j][8 * s + 2], S[j][8 * s + 3]); pv.z = cvtpk(S[j][8 * s + 4], S[j][8 * s + 5]); pv.w = cvtpk(S[j][8 * s + 6], S[j][8 * s + 7]);
                o[mt] = __builtin_amdgcn_mfma_f32_32x32x16_bf16(__builtin_bit_cast(bf16x8, av), __builtin_bit_cast(bf16x8, pv), o[mt], 0, 0, 0);
            }
#pragma unroll
        for (int e = 0; e < 16; ++e) o[mt][e] *= il;
    }
}
__device__ __forceinline__ void load_q(bf16x8 (&qf)[4], const bf16_t* qrow, int h) {
#pragma unroll
    for (int s = 0; s < 4; ++s) { const v4u w = *(const v4u*)(qrow + 16 * s + 8 * h); v4u o;
#pragma unroll
        for (int i = 0; i < 4; ++i) { const float a = __builtin_bit_cast(float, w[i] << 16) * 0.125f, b = __builtin_bit_cast(float, w[i] & 0xffff0000u) * 0.125f;
            o[i] = (__builtin_bit_cast(unsigned, a) >> 16) | (__builtin_bit_cast(unsigned, b) & 0xffff0000u); }
        qf[s] = __builtin_bit_cast(bf16x8, o); }
}
__device__ __forceinline__ void store_o(const f32x16 (&o)[2], bf16_t* orow, int h) {
#pragma unroll
    for (int mt = 0; mt < 2; ++mt)
#pragma unroll
        for (int g4 = 0; g4 < 4; ++g4) { u32x2 w; w.x = cvtpk(o[mt][4 * g4 + 0], o[mt][4 * g4 + 1]); w.y = cvtpk(o[mt][4 * g4 + 2], o[mt][4 * g4 + 3]);
            *(u32x2*)(orow + 32 * mt + 8 * g4 + 4 * h) = w; }
}
__device__ __forceinline__ void put_kv(LAS unsigned char* Kl, LAS unsigned char* Vl, int i, int part, v4u kv, v4u vv) {
    *(LAS v4u*)(Kl + i * KPB + part * 16) = kv;
#pragma unroll
    for (int e = 0; e < 8; ++e) { const unsigned short val = (unsigned short)((vv[e >> 1] >> (16 * (e & 1))) & 0xffffu); *(LAS unsigned short*)(Vl + ((part * 8 + e) * VPE + i) * 2) = val; }
}
__device__ __forceinline__ void attn_phase(Frame& F, int wg, int nwg) {
    LAS unsigned char* Kl = F.lds + K_OFF; LAS unsigned char* Vl = F.lds + V_OFF;
    bf16_t* QS = FB(WS_QS); const bf16_t* KS = FB(WS_KS); const bf16_t* VS = FB(WS_VS);
    const int lane = F.lane, r32 = lane & 31, h = lane >> 5, w = F.wave;
    constexpr int NPU = BATCH * KVH * (SEQ / 64), NSU = DB * KVH;
    for (int u = wg; u < NPU + NSU; u += nwg) {
        if (u < NPU) {
            const int b = u / (KVH * (SEQ / 64)), kvh = (u / (SEQ / 64)) % KVH, q0 = (u % (SEQ / 64)) * 64;
            for (int c = F.tid; c < NSLOT * 8; c += NTHREADS) { const int i = c >> 3, part = c & 7, kpos = q0 - 128 + i;
                v4u kv = {0u, 0u, 0u, 0u}, vv = {0u, 0u, 0u, 0u};
                if (kpos >= 0) { const size_t off = ((size_t)b * SEQ + kpos) * 256 + kvh * 64 + part * 8; kv = *(const v4u*)(KS + off); vv = *(const v4u*)(VS + off); }
                put_kv(Kl, Vl, i, part, kv, vv); }
            const int head = kvh * 4 + (w >> 1), hf = w & 1; const size_t row = (size_t)b * SEQ + q0 + 32 * hf + r32;
            bf16x8 qf[4]; load_q(qf, QS + row * 1024 + head * 64, h);
            __syncthreads();
            f32x16 o[2]; attn_wave(Kl, Vl, qf, hf, q0 - 128, q0 + 32 * hf + r32, F.in[I_SINKS][head], o, lane);
            store_o(o, QS + row * 1024 + head * 64, h);
            __syncthreads();
        } else {
            const int su = u - NPU, b = su / KVH, kvh = su % KVH;
            const float* ck = F.in[I_CK]; const float* cv = F.in[I_CV];
            for (int c = F.tid; c < 160 * 8; c += NTHREADS) { const int i = c >> 3, part = c & 7;
                v4u kv = {0u, 0u, 0u, 0u}, vv = {0u, 0u, 0u, 0u};
                if (i < WIN) { const size_t off = (((size_t)b * WIN + i) * KVH + kvh) * HD + part * 8;
                    const f32x4 k0 = *(const f32x4*)(ck + off), k1 = *(const f32x4*)(ck + off + 4), v0 = *(const f32x4*)(cv + off), v1 = *(const f32x4*)(cv + off + 4);
                    kv.x = pk2(k0[0], k0[1]); kv.y = pk2(k0[2], k0[3]); kv.z = pk2(k1[0], k1[1]); kv.w = pk2(k1[2], k1[3]);
                    vv.x = pk2(v0[0], v0[1]); vv.y = pk2(v0[2], v0[3]); vv.z = pk2(v1[0], v1[1]); vv.w = pk2(v1[2], v1[3]); }
                else if (i < WIN + DS) { const size_t off = ((size_t)MP + (size_t)b * DS + (i - WIN)) * 256 + kvh * 64 + part * 8; kv = *(const v4u*)(KS + off); vv = *(const v4u*)(VS + off); }
                put_kv(Kl, Vl, i, part, kv, vv); }
            const int head = kvh * 4 + (r32 >> 3), t = r32 & 7; const size_t row = (size_t)MP + (size_t)b * DS + t;
            bf16x8 qf[4];
            if (w == 0) load_q(qf, QS + row * 1024 + head * 64, h);
            __syncthreads();
            if (w == 0) { f32x16 o[2]; attn_wave(Kl, Vl, qf, 0, PAST - WIN, PAST + t, F.in[I_SINKS][head], o, lane); store_o(o, QS + row * 1024 + head * 64, h); }
            __syncthreads();
        }
    }
}
}
namespace gdn {
typedef unsigned u32x2 __attribute__((ext_vector_type(2)));
constexpr int NCH = SEQ / 64, NU = BATCH * H * NCH;
constexpr size_t WKB = 16384, QKPB = 8192, UVB = 32768;
constexpr int TEAM_LDS = 81920, PK = 272;
constexpr int KB_OFF = 0, QB_OFF = 17408, VB_OFF = 34816, A_OFF = 52224, QKP_OFF = 68608, SM_OFF = 76800;
__device__ __forceinline__ int permpos(int j) { return (j & ~31) + 8 * ((j >> 2) & 3) + 4 * ((j >> 4) & 1) + (j & 3); }
__device__ __forceinline__ float bfl(unsigned w) { return __builtin_bit_cast(float, w << 16); }
__device__ __forceinline__ float bfh(unsigned w) { return __builtin_bit_cast(float, w & 0xffff0000u); }
__device__ __forceinline__ unsigned cvtpk(float lo, float hi) { unsigned r; asm volatile("v_cvt_pk_bf16_f32 %0, %1, %2" : "=v"(r) : "v"(lo), "v"(hi)); return r; }
__device__ __forceinline__ float silu_a(float x) { return x * __builtin_amdgcn_rcpf(1.0f + __builtin_amdgcn_exp2f(-1.4426950408889634f * x)); }

__device__ __forceinline__ void prep_phase(Frame& F) {
    const int team = F.tid >> 8, lt0 = F.tid & 255, tw = lt0 >> 6, lane = F.lane;
    LAS unsigned char* L = F.lds + team * TEAM_LDS;
    LAS float* sm = (LAS float*)(L + SM_OFF);
    LAS float* Am = (LAS float*)(L + A_OFF);
    const int tg = blockIdx.x * 2 + team, ntg = F.G * 2;
    const int rounds = (NU + ntg - 1) / ntg;
#pragma unroll 1
    for (int rd = 0; rd < rounds; ++rd) {
        int lt = lt0; asm volatile("" : "+v"(lt));
        unsigned char* wsb = F.ws; asm volatile("" : "+s"(wsb));
        const float* AB = (const float*)(wsb + lay::WS_AB);
        unsigned char* wkb = wsb + lay::WS_WK; unsigned char* qgb = wsb + lay::WS_QG; unsigned char* kgtb = wsb + lay::WS_KGT; unsigned char* qkpb = wsb + lay::WS_QKP;
        float* uvb = (float*)(wsb + lay::WS_UV); float* glb = (float*)(wsb + lay::WS_GL);
        const int uid = tg + rd * ntg; const bool act = uid < NU;
        const int n = uid % NCH, h = (uid / NCH) % H, b = uid / (NCH * H);
        const size_t r0 = (size_t)b * SEQ + (size_t)n * 64;
        if (act && tw == 0) {
            const float a = AB[(r0 + lane) * 16 + h], bb = AB[(r0 + lane) * 16 + 8 + h];
            const float xg = a + F.in[I_DTB][h]; const float sp = xg > 20.f ? xg : log1pf(expf(xg));
            float v = -expf(F.in[I_ALOG][h]) * sp;
#pragma unroll
            for (int d = 1; d < 64; d <<= 1) { const float t2 = __shfl_up(v, d); if (lane >= d) v += t2; }
            const float gl = __shfl(v, 63);
            sm[lane] = v; sm[64 + lane] = 1.0f / (1.0f + expf(-bb)); sm[128 + lane] = expf(v); sm[192 + lane] = expf(gl - v);
            if (lane == 0) glb[uid] = expf(gl);
        }
        { v4u z = {0u, 0u, 0u, 0u}; *(LAS v4u*)(L + QKP_OFF + lt * 32) = z; *(LAS v4u*)(L + QKP_OFF + lt * 32 + 16) = z; }
        if (act) {
#pragma unroll
            for (int k = 0; k < 12; ++k) { const int id = lt + 256 * k, mat = id >> 10, i = (id >> 4) & 63, part = id & 15;
                const bf16_t* src = (const bf16_t*)(wsb + (mat == 0 ? lay::WS_QN : mat == 1 ? lay::WS_KN : lay::WS_VN));
                const v4u w = *(const v4u*)(src + (r0 + i) * 1024 + h * 128 + part * 8);
                *(LAS v4u*)(L + (mat == 0 ? QB_OFF : mat == 1 ? KB_OFF : VB_OFF) + i * PK + part * 16) = w; }
        }
        __syncthreads();
        if (act) {
            const int c = lane & 15, q = lane >> 4;
#pragma unroll 1
            for (int job = tw; job < 20; job += 4) {
                const int mat = job / 10, tau = job % 10, ti = tau >= 6 ? 3 : tau >= 3 ? 2 : tau >= 1 ? 1 : 0, tj = tau - ti * (ti + 1) / 2;
                const LAS unsigned char* ap = L + (mat == 0 ? KB_OFF : QB_OFF) + (16 * ti + c) * PK + 16 * q; const LAS unsigned char* bp = L + KB_OFF + (16 * tj + c) * PK + 16 * q;
                f32x4 acc = {0.f, 0.f, 0.f, 0.f};
#pragma unroll
                for (int s = 0; s < 4; ++s) acc = __builtin_amdgcn_mfma_f32_16x16x32_bf16(*(const LAS bf16x8*)(ap + 64 * s), *(const LAS bf16x8*)(bp + 64 * s), acc, 0, 0, 0);
                const int j = 16 * tj + c; const float gcj = sm[j];
#pragma unroll
                for (int r = 0; r < 4; ++r) { const int i = 16 * ti + 4 * q + r; const float dec = expf(sm[i] - gcj);
                    if (mat == 0) Am[i * 64 + j] = (i > j) ? acc[r] * sm[64 + i] * dec : 0.f;
                    else *(LAS unsigned short*)(L + QKP_OFF + i * 128 + permpos(j) * 2) = (unsigned short)f2bf_u((i >= j) ? acc[r] * dec : 0.f); }
            }
        }
        __syncthreads();
        float x[64];
        if (act) {
            if (lt < 128) {
#pragma unroll
                for (int i = 0; i < 64; ++i) x[i] = bfl((unsigned)*(const LAS unsigned short*)(L + VB_OFF + i * PK + lt * 2)) * sm[64 + i];
            } else {
#pragma unroll
                for (int i = 0; i < 64; ++i) x[i] = bfl((unsigned)*(const LAS unsigned short*)(L + KB_OFF + i * PK + (lt - 128) * 2)) * sm[64 + i] * sm[128 + i];
            }
#pragma clang loop unroll(full)
            for (int i = 1; i < 64; ++i) {
                float acc = x[i];
#pragma clang loop unroll(full)
                for (int j4 = 0; j4 < 16; ++j4) if (4 * j4 < i) { const f32x4 a = *(const LAS f32x4*)(Am + i * 64 + 4 * j4);
                    acc -= a[0] * x[4 * j4]; if (4 * j4 + 1 < i) acc -= a[1] * x[4 * j4 + 1]; if (4 * j4 + 2 < i) acc -= a[2] * x[4 * j4 + 2]; if (4 * j4 + 3 < i) acc -= a[3] * x[4 * j4 + 3]; }
                x[i] = acc;
            }
        }
        __syncthreads();
        const int lo_ = lt;
        if (act) {
            if (lt < 128) {
                float* up = uvb + (size_t)uid * (UVB / 4) + (size_t)((lo_ >> 4) * 4) * 256 + (lo_ & 15) * 4;
#pragma unroll
                for (int mt = 0; mt < 4; ++mt)
#pragma unroll
                    for (int q = 0; q < 4; ++q) { f32x4 o = {x[16 * mt + 4 * q], x[16 * mt + 4 * q + 1], x[16 * mt + 4 * q + 2], x[16 * mt + 4 * q + 3]}; *(f32x4*)(up + mt * 256 + q * 64) = o; }
            } else {
#pragma unroll
                for (int i = 0; i < 64; ++i) *(LAS unsigned short*)(L + VB_OFF + i * PK + (lo_ - 128) * 2) = (unsigned short)f2bf_u(x[i]);
            }
        }
        __syncthreads();
        if (act) {
#pragma unroll
            for (int k = 0; k < 4; ++k) { const int id = lo_ + 256 * k, i = id >> 4, s = (id >> 2) & 3, q = id & 3;
                { const LAS unsigned char* p = L + VB_OFF + i * PK + (32 * s + 4 * q) * 2; const u32x2 lo = *(const LAS u32x2*)p, hi = *(const LAS u32x2*)(p + 32);
                  v4u o; o.x = lo.x; o.y = lo.y; o.z = hi.x; o.w = hi.y; *(v4u*)(wkb + (size_t)uid * WKB + (size_t)id * 16) = o; }
                { const LAS unsigned char* p = L + QB_OFF + i * PK + (32 * s + 4 * q) * 2; const u32x2 lo = *(const LAS u32x2*)p, hi = *(const LAS u32x2*)(p + 32); const float e = sm[128 + i];
                  v4u o; o.x = cvtpk(bfl(lo.x) * e, bfh(lo.x) * e); o.y = cvtpk(bfl(lo.y) * e, bfh(lo.y) * e); o.z = cvtpk(bfl(hi.x) * e, bfh(hi.x) * e); o.w = cvtpk(bfl(hi.y) * e, bfh(hi.y) * e);
                  *(v4u*)(qgb + (size_t)uid * WKB + (size_t)id * 16) = o; }
            }
#pragma unroll
            for (int k = 0; k < 4; ++k) { const int id = lo_ + 256 * k, dk = id >> 3, s = (id >> 2) & 1, q = id & 3; float v[8];
#pragma unroll
                for (int j = 0; j < 8; ++j) { const int tok = 32 * s + 16 * (j >> 2) + 4 * q + (j & 3); v[j] = bfl((unsigned)*(const LAS unsigned short*)(L + KB_OFF + tok * PK + dk * 2)) * sm[192 + tok]; }
                v4u o; o.x = cvtpk(v[0], v[1]); o.y = cvtpk(v[2], v[3]); o.z = cvtpk(v[4], v[5]); o.w = cvtpk(v[6], v[7]);
                *(v4u*)(kgtb + (size_t)uid * WKB + (size_t)id * 16) = o; }
#pragma unroll
            for (int k = 0; k < 2; ++k) { const int id = lo_ + 256 * k; *(v4u*)(qkpb + (size_t)uid * QKPB + (size_t)id * 16) = *(const LAS v4u*)(L + QKP_OFF + id * 16); }
        }
        __syncthreads();
    }
}

constexpr int SC_WK = 0, SC_QG = 17408, SC_KGT = 34816, SC_QKP = 34816 + 18432, SC_BUF = SC_QKP + 9216;
__device__ __forceinline__ void scan_phase(Frame& F, int blk) {
    const int lane = F.lane, w = F.wave, c = lane & 15, q = lane >> 4;
    const int bh = blk >> 1, dvh = blk & 1, b = bh / H, h = bh % H, uid0 = bh * NCH;
    const unsigned char* wkb = F.ws + lay::WS_WK; const unsigned char* qgb = F.ws + lay::WS_QG; const unsigned char* kgtb = F.ws + lay::WS_KGT; const unsigned char* qkpb = F.ws + lay::WS_QKP;
    if (w >= 4) {
        const int lt = F.tid - 256;
        v4u sa[14], sb[14];
#define LD_LOAD(dstv, uid) do { _Pragma("unroll") for (int k = 0; k < 14; ++k) { const int g = lt + 256 * k; const unsigned char* src = g < 1024 ? wkb + (size_t)(uid) * WKB + (size_t)g * 16 : g < 2048 ? qgb + (size_t)(uid) * WKB + (size_t)(g - 1024) * 16 \
        : g < 3072 ? kgtb + (size_t)(uid) * WKB + (size_t)(g - 2048) * 16 : qkpb + (size_t)(uid) * QKPB + (size_t)(g - 3072) * 16; dstv[k] = *(const v4u*)src; } } while (0)
#define LD_WRITE(srcv, buf) do { _Pragma("unroll") for (int k = 0; k < 14; ++k) { const int g = lt + 256 * k; int off; \
        if (g < 1024) off = SC_WK + (g >> 4) * PK + (g & 15) * 16; else if (g < 2048) off = SC_QG + ((g - 1024) >> 4) * PK + (g & 15) * 16; \
        else if (g < 3072) off = SC_KGT + ((g - 2048) >> 3) * 144 + (g & 7) * 16; else off = SC_QKP + ((g - 3072) >> 3) * 144 + (g & 7) * 16; \
        *(LAS v4u*)(F.lds + (buf) * SC_BUF + off) = srcv[k]; } } while (0)
        LD_LOAD(sa, uid0); LD_LOAD(sb, uid0 + 1);
        LD_WRITE(sa, 0);
        __syncthreads();
        for (int n = 0; n < NCH; n += 2) {
            LD_WRITE(sb, 1); if (n + 2 < NCH) LD_LOAD(sa, uid0 + n + 2);
            __syncthreads();
            if (n + 2 < NCH) LD_WRITE(sa, 0);
            if (n + 3 < NCH) LD_LOAD(sb, uid0 + n + 3);
            __syncthreads();
        }
#undef LD_LOAD
#undef LD_WRITE
        return;
    }
    const float* uvb = (const float*)(F.ws + lay::WS_UV); const float* glb = (const float*)(F.ws + lay::WS_GL);
    bf16_t* OG = FB(WS_OG);
    const int dvw = 4 * dvh + w;
    f32x4 Sacc[8]; bf16x8 Sb[4];
#pragma unroll
    for (int i = 0; i < 8; ++i) Sacc[i] = (f32x4){0.f, 0.f, 0.f, 0.f};
#pragma unroll
    for (int i = 0; i < 4; ++i) Sb[i] = (bf16x8){0, 0, 0, 0, 0, 0, 0, 0};
    f32x4 un[4], un2[4]; float gln, gln2;
#define UV_LOAD(dstv, dstg, uid) do { _Pragma("unroll") for (int mt = 0; mt < 4; ++mt) dstv[mt] = *(const f32x4*)(uvb + (size_t)(uid) * (UVB / 4) + (size_t)((dvw * 4 + mt) * 64 + lane) * 4); dstg = glb[(uid)]; } while (0)
    UV_LOAD(un, gln, uid0); UV_LOAD(un2, gln2, uid0 + 1);
    __syncthreads();
#define SC_CHUNK(n_, uc, gl_) do { \
        const LAS unsigned char* B = F.lds + ((n_) & 1) * SC_BUF; \
        f32x4 vn[4]; \
        _Pragma("unroll") for (int mt = 0; mt < 4; ++mt) { f32x4 r = {0.f, 0.f, 0.f, 0.f}; const LAS unsigned char* ap = B + SC_WK + (16 * mt + c) * PK + 16 * q; \
            _Pragma("unroll") for (int s = 0; s < 4; ++s) r = __builtin_amdgcn_mfma_f32_16x16x32_bf16(*(const LAS bf16x8*)(ap + 64 * s), Sb[s], r, 0, 0, 0); \
            vn[mt] = uc[mt] - r; } \
        bf16x8 Vb[2]; \
        _Pragma("unroll") for (int s = 0; s < 2; ++s) { v4u p; p.x = cvtpk(vn[2 * s][0], vn[2 * s][1]); p.y = cvtpk(vn[2 * s][2], vn[2 * s][3]); p.z = cvtpk(vn[2 * s + 1][0], vn[2 * s + 1][1]); p.w = cvtpk(vn[2 * s + 1][2], vn[2 * s + 1][3]); Vb[s] = __builtin_bit_cast(bf16x8, p); } \
        _Pragma("unroll") for (int mt = 0; mt < 4; ++mt) { f32x4 o = {0.f, 0.f, 0.f, 0.f}; const LAS unsigned char* ap = B + SC_QG + (16 * mt + c) * PK + 16 * q; const LAS unsigned char* kp = B + SC_QKP + (16 * mt + c) * 144 + 16 * q; \
            _Pragma("unroll") for (int s = 0; s < 4; ++s) o = __builtin_amdgcn_mfma_f32_16x16x32_bf16(*(const LAS bf16x8*)(ap + 64 * s), Sb[s], o, 0, 0, 0); \
            _Pragma("unroll") for (int s = 0; s < 2; ++s) o = __builtin_amdgcn_mfma_f32_16x16x32_bf16(*(const LAS bf16x8*)(kp + 64 * s), Vb[s], o, 0, 0, 0); \
            bf16_t* op = OG + ((size_t)b * SEQ + (size_t)(n_) * 64 + 16 * mt + 4 * q) * 1024 + h * 128 + 16 * dvw + c; \
            _Pragma("unroll") for (int r = 0; r < 4; ++r) op[(size_t)r * 1024] = (bf16_t)f2bf_u(o[r]); } \
        _Pragma("unroll") for (int dt = 0; dt < 8; ++dt) { f32x4 a = Sacc[dt] * (gl_); const LAS unsigned char* ap = B + SC_KGT + (16 * dt + c) * 144 + 16 * q; \
            _Pragma("unroll") for (int s = 0; s < 2; ++s) a = __builtin_amdgcn_mfma_f32_16x16x32_bf16(*(const LAS bf16x8*)(ap + 64 * s), Vb[s], a, 0, 0, 0); \
            Sacc[dt] = a; } \
        _Pragma("unroll") for (int s = 0; s < 4; ++s) { v4u p; p.x = cvtpk(Sacc[2 * s][0], Sacc[2 * s][1]); p.y = cvtpk(Sacc[2 * s][2], Sacc[2 * s][3]); p.z = cvtpk(Sacc[2 * s + 1][0], Sacc[2 * s + 1][1]); p.w = cvtpk(Sacc[2 * s + 1][2], Sacc[2 * s + 1][3]); Sb[s] = __builtin_bit_cast(bf16x8, p); } \
    } while (0)
    for (int n = 0; n < NCH; n += 2) {
        { f32x4 u[4]; _Pragma("unroll") for (int mt = 0; mt < 4; ++mt) u[mt] = un[mt]; const float gl = gln;
          if (n + 2 < NCH) UV_LOAD(un, gln, uid0 + n + 2);
          SC_CHUNK(n, u, gl); }
        __syncthreads();
        { f32x4 u[4]; _Pragma("unroll") for (int mt = 0; mt < 4; ++mt) u[mt] = un2[mt]; const float gl = gln2;
          if (n + 3 < NCH) UV_LOAD(un2, gln2, uid0 + n + 3);
          SC_CHUNK(n + 1, u, gl); }
        __syncthreads();
    }
#undef SC_CHUNK
#undef UV_LOAD
    float* so = F.out + O_GP + ((size_t)(b * H + h) * DK) * DV + 16 * dvw + c;
#pragma unroll
    for (int dt = 0; dt < 8; ++dt)
#pragma unroll
        for (int r = 0; r < 4; ++r) so[(size_t)(16 * dt + 4 * q + r) * DV] = Sacc[dt][r];
}

__device__ __forceinline__ void sample_qkv(Frame& F) {
    const int gw = blockIdx.x * NWAVES + F.wave, NGW = F.G * NWAVES, lane = F.lane;
    const bf16_t* RAW = FB(WS_RAW); bf16_t* QKVS = FB(WS_QKVS); const float* sc = F.in[I_SCONV]; const float* conv_w = F.in[I_CONVW];
    for (int task = gw; task < DB * 24; task += NGW) {
        const int b = task / 24, hm = task % 24, col = hm * 128 + 2 * lane;
        float w0[4], w1[4], e0[3], e1[3];
#pragma unroll
        for (int j = 0; j < 4; ++j) { w0[j] = conv_w[j * CONV + col]; w1[j] = conv_w[j * CONV + col + 1]; }
#pragma unroll
        for (int j = 0; j < 3; ++j) { e0[j] = sc[((size_t)b * 3 + j) * CONV + col]; e1[j] = sc[((size_t)b * 3 + j) * CONV + col + 1]; }
        for (int t = 0; t < DS; ++t) {
            const unsigned rw = *(const unsigned*)(RAW + ((size_t)MP + (size_t)b * DS + t) * CONV + col);
            const float c0 = bfl(rw), c1 = bfh(rw);
            float v0 = silu_a(w0[0] * e0[0] + w0[1] * e0[1] + w0[2] * e0[2] + w0[3] * c0), v1 = silu_a(w1[0] * e1[0] + w1[1] * e1[1] + w1[2] * e1[2] + w1[3] * c1);
            e0[0] = e0[1]; e0[1] = e0[2]; e0[2] = c0; e1[0] = e1[1]; e1[1] = e1[2]; e1[2] = c1;
            if (hm < 16) { const float rs = 1.0f / sqrtf(wave_sum(v0 * v0 + v1 * v1) + EPS); v0 *= rs; v1 *= rs; }
            *(unsigned*)(QKVS + ((size_t)b * DS + t) * CONV + col) = cvtpk(v0, v1);
        }
    }
}
__device__ __forceinline__ void qkvn_pass(Frame& F) {
    const int gw = blockIdx.x * NWAVES + F.wave, NGW = F.G * NWAVES, lane = F.lane;
    const bf16_t* RAW = FB(WS_RAW); const float* conv_w = F.in[I_CONVW];
    for (int task = gw; task < BATCH * 24 * NCH; task += NGW) {
        const int st = task % NCH, hm = (task / NCH) % 24, b = task / (NCH * 24), col = hm * 128 + 2 * lane, mat = hm >> 3;
        bf16_t* dst = (mat == 0 ? FB(WS_QN) : mat == 1 ? FB(WS_KN) : FB(WS_VN)) + (hm & 7) * 128 + 2 * lane;
        float w0[4], w1[4], e0[3], e1[3];
#pragma unroll
        for (int j = 0; j < 4; ++j) { w0[j] = conv_w[j * CONV + col]; w1[j] = conv_w[j * CONV + col + 1]; }
        const size_t rb = (size_t)b * SEQ; const int t0 = st * 64;
#pragma unroll
        for (int j = 0; j < 3; ++j) { const int t = t0 - 3 + j; unsigned rw = 0u; if (t >= 0) rw = *(const unsigned*)(RAW + (rb + t) * CONV + col); e0[j] = bfl(rw); e1[j] = bfh(rw); }
#pragma unroll 1
        for (int tb = t0; tb < t0 + 64; tb += 8) {
            unsigned rw[8]; float v0[8], v1[8], ss[8];
#pragma unroll
            for (int i = 0; i < 8; ++i) rw[i] = *(const unsigned*)(RAW + (rb + tb + i) * CONV + col);
#pragma unroll
            for (int i = 0; i < 8; ++i) { const float c0 = bfl(rw[i]), c1 = bfh(rw[i]);
                v0[i] = silu_a(w0[0] * e0[0] + w0[1] * e0[1] + w0[2] * e0[2] + w0[3] * c0); v1[i] = silu_a(w1[0] * e1[0] + w1[1] * e1[1] + w1[2] * e1[2] + w1[3] * c1);
                e0[0] = e0[1]; e0[1] = e0[2]; e0[2] = c0; e1[0] = e1[1]; e1[1] = e1[2]; e1[2] = c1; ss[i] = v0[i] * v0[i] + v1[i] * v1[i]; }
            if (mat < 2) {
#pragma unroll
                for (int d = 1; d < 64; d <<= 1)
#pragma unroll
                    for (int i = 0; i < 8; ++i) ss[i] += __shfl_xor(ss[i], d);
#pragma unroll
                for (int i = 0; i < 8; ++i) { float rs = 1.0f / sqrtf(ss[i] + EPS); if (mat == 0) rs *= 0.08838834764831845f; v0[i] *= rs; v1[i] *= rs; }
            }
#pragma unroll
            for (int i = 0; i < 8; ++i) *(unsigned*)(dst + (rb + tb + i) * 1024) = cvtpk(v0[i], v1[i]);
        }
    }
}
__device__ __forceinline__ void merge_phase(Frame& F) {
    const int gw = blockIdx.x * NWAVES + F.wave, NGW = F.G * NWAVES, lane = F.lane;
    const bf16_t* OGp = FB(WS_OG); const bf16_t* OSp = FB(WS_OS); const bf16_t* Zp = FB(WS_Z); bf16_t* GAp = FB(WS_GA); const bf16_t* GBp = FB(WS_GB);
    float gn[16];
#pragma unroll
    for (int i = 0; i < 4; ++i) { const f32x4 v = *(const f32x4*)(F.in[I_GNORM] + (lane & 7) * 16 + 4 * i); gn[4 * i] = v[0]; gn[4 * i + 1] = v[1]; gn[4 * i + 2] = v[2]; gn[4 * i + 3] = v[3]; }
    for (int m = gw; m < M; m += NGW) {
        const size_t off = (size_t)m * 1024 + 16 * lane;
        v4u og[2], os[2], z[2], ga[2], gb[2];
#pragma unroll
        for (int k = 0; k < 2; ++k) { og[k] = *(const v4u*)(OGp + off + 8 * k); os[k] = *(const v4u*)(OSp + off + 8 * k); z[k] = *(const v4u*)(Zp + off + 8 * k); ga[k] = *(const v4u*)(GAp + off + 8 * k); gb[k] = *(const v4u*)(GBp + off + 8 * k); }
        float o[16]; float ss = 0.f;
#pragma unroll
        for (int k = 0; k < 2; ++k)
#pragma unroll
            for (int e = 0; e < 4; ++e) { o[8 * k + 2 * e] = bfl(og[k][e]); o[8 * k + 2 * e + 1] = bfh(og[k][e]); }
#pragma unroll
        for (int e = 0; e < 16; ++e) ss += o[e] * o[e];
        ss += __shfl_xor(ss, 1); ss += __shfl_xor(ss, 2); ss += __shfl_xor(ss, 4);
        const float rs = 1.0f / sqrtf(ss * (1.0f / 128.0f) + EPS);
        v4u out[2];
#pragma unroll
        for (int k = 0; k < 2; ++k)
#pragma unroll
            for (int e = 0; e < 4; ++e) {
                const float r0 = pg8::fast_sigmoid(bfl(ga[k][e])) * (o[8 * k + 2 * e] * rs * gn[8 * k + 2 * e] * pg8::fast_silu(bfl(z[k][e]))) + pg8::fast_sigmoid(bfl(gb[k][e])) * bfl(os[k][e]);
                const float r1 = pg8::fast_sigmoid(bfh(ga[k][e])) * (o[8 * k + 2 * e + 1] * rs * gn[8 * k + 2 * e + 1] * pg8::fast_silu(bfh(z[k][e]))) + pg8::fast_sigmoid(bfh(gb[k][e])) * bfh(os[k][e]);
                out[k][e] = cvtpk(r0, r1); }
#pragma unroll
        for (int k = 0; k < 2; ++k) *(v4u*)(GAp + off + 8 * k) = out[k];
    }
}
}
template <class K, class... A> __device__ __forceinline__ void run_items(long n, A... a) {
    for (long g = (long)blockIdx.x * NTHREADS + threadIdx.x; g < n; g += (long)gridDim.x * NTHREADS) K::run(g, a...);
}

template <class K, class... A> __device__ __forceinline__ void run_items_sub(long lo, long hi, int wg, int nwg, A... a) {
    for (long g = lo + (long)wg * NTHREADS + threadIdx.x; g < hi; g += (long)nwg * NTHREADS) K::run(g, a...);
}

__global__ void __launch_bounds__(NTHREADS, 2) mega_fwd(MArgs args) {
    extern __shared__ __attribute__((aligned(16))) unsigned char lds_raw[];
    Frame F;
    F.lds = (LAS unsigned char*)lds_raw; F.tid = threadIdx.x; F.lane = F.tid & 63; F.wave = __builtin_amdgcn_readfirstlane(F.tid >> 6); F.G = gridDim.x;
    F.in = args.in; F.out = args.out; F.ws = args.ws;
    const int lo = args.ph_lo, hi = args.ph_hi;
#define IN(k) (lo <= (k) && (k) < hi)
#ifndef MK_PROBE
#define MK_PROBE (-1)
#endif
#if MK_PROBE >= 0
    unsigned long long ts_prev = __builtin_amdgcn_s_memrealtime(), ts_dt = 0ull;
#define SEAM(k) do { if (IN(k) && IN((k) + 1)) cg::this_grid().sync(); { const unsigned long long t_ = __builtin_amdgcn_s_memrealtime(); if ((k) == MK_PROBE) ts_dt = t_ - ts_prev; ts_prev = t_; } } while (0)
#else
#define SEAM(k) do { if (IN(k) && IN((k) + 1)) cg::this_grid().sync(); } while (0)
#endif
    typedef pg8::StaticOrder SO;
    if (IN(P_PRO)) { p0_prologue(F); } SEAM(P_PRO);
    if (IN(P_FFN1A)) {
        pg8::Gemm g{FB(WS_XN1), FB(WS_W1IN), M, 2 * FF, D}; SO S; S.init(M, 2 * FF, F.G, (int)blockIdx.x);
        pg8::EpiSwiglu E{FB(WS_HB), FF, nullptr};
        pg8::gemm_phase<pg8::EpiSwiglu, SO, true, true>(F.lds, g, S, E);
    } SEAM(P_FFN1A);
    if (IN(P_FFN1B)) {
        pg8::Gemm g{FB(WS_HB), FB(WS_W1OUT), M, D, FF}; SO S; S.init(M, D, F.G, (int)blockIdx.x);
        pg8::EpiResid E{F.in[I_XP], F.in[I_XS], MP, 0.5f, FF32(WS_X1), FB(WS_X1B), FF32(WS_SSQ1)};
        pg8::gemm_phase<pg8::EpiResid, SO, true, true>(F.lds, g, S, E);
    } SEAM(P_FFN1B);
    if (IN(P_INPROJ)) {
        ab_tiles(F);
        pg8::Gemm g{FB(WS_X1B), FB(WS_WIN), M, 7680, D}; SO S; S.init(M, 7680, F.G, (int)blockIdx.x);
        pg8::EpiInProj E{FB(WS_RAW), FB(WS_Z), FB(WS_QS), FB(WS_KS), FB(WS_VS), FB(WS_GA), FB(WS_GB), FF32(WS_SSQ1)};
        pg8::gemm_phase<pg8::EpiInProj, SO, true, true>(F.lds, g, S, E);
    } SEAM(P_INPROJ);
#if MK_EMBED_NB
    if (IN(P_PREP)) {
        run_items<nv::OutConv>((long)(BATCH + DB) * 3 * CONV, (const bf16_t*)FB(WS_RAW), F.out + O_CP, F.out + O_CS);
        run_items<nv::Rope>((long)M * 160, FB(WS_QS), FB(WS_KS));
        gdn::sample_qkv(F);
        gdn::qkvn_pass(F);
        cg::this_grid().sync();
#if MK_PROBE == 40 || MK_PROBE == 41
        { const unsigned long long t_ = __builtin_amdgcn_s_memrealtime(); if (MK_PROBE == 40) ts_dt = t_ - ts_prev; ts_prev = t_; }
#endif
        gdn::prep_phase(F);
#if MK_PROBE == 41
        cg::this_grid().sync();
        { const unsigned long long t_ = __builtin_amdgcn_s_memrealtime(); ts_dt = t_ - ts_prev; ts_prev = t_; }
#endif
    } SEAM(P_PREP);
    if (IN(P_MIXER)) {
        constexpr int NSCAN = BATCH * H * 2;
        if ((int)blockIdx.x < NSCAN) gdn::scan_phase(F, (int)blockIdx.x);
        else {
            const int wg = (int)blockIdx.x - NSCAN, nwg = F.G - NSCAN;
            run_items_sub<nv::OutKV>(0, (long)(BATCH + DB) * WIN * 256, wg, nwg, (const bf16_t*)FB(WS_KS), (const bf16_t*)FB(WS_VS), F.in[I_CK], F.in[I_CV], F.out + O_KP, F.out + O_KS, F.out + O_VP, F.out + O_VS);
            run_items_sub<Gdn2>((long)BATCH * H * DV * 2, (long)(BATCH + DB) * H * DV * 2, wg, nwg, (const float*)FF32(WS_AB), (const bf16_t*)(FB(WS_QKVS) - (size_t)MP * CONV), F.in[I_SGDN], F.in[I_ALOG], F.in[I_DTB], FB(WS_OG), F.out + O_GP, F.out + O_GS);
            att::attn_phase(F, wg, nwg);
        }
    } SEAM(P_MIXER);
    if (IN(P_MERGE)) {
        gdn::merge_phase(F);
    } SEAM(P_MERGE);
#endif
    if (IN(P_OUTPROJ)) {
        pg8::Gemm g{FB(WS_MIXED), FB(WS_WOUT), M, D, D}; SO S; S.init(M, D, F.G, (int)blockIdx.x);
        pg8::EpiResid E{FF32(WS_X1), FF32(WS_X1), M, 1.0f, FF32(WS_X1), FB(WS_X2B), FF32(WS_SSQ2)};
        pg8::gemm_phase<pg8::EpiResid, SO, true, true>(F.lds, g, S, E);
    } SEAM(P_OUTPROJ);
    if (IN(P_FFN2A)) {
        pg8::Gemm g{FB(WS_X2B), FB(WS_W2IN), M, 2 * FF, D}; SO S; S.init(M, 2 * FF, F.G, (int)blockIdx.x);
        pg8::EpiSwiglu E{FB(WS_HB), FF, FF32(WS_SSQ2)};
        pg8::gemm_phase<pg8::EpiSwiglu, SO, true, true>(F.lds, g, S, E);
    } SEAM(P_FFN2A);
    if (IN(P_FFN2B)) {
        pg8::Gemm g{FB(WS_HB), FB(WS_W2OUT), M, D, FF}; SO S; S.init(M, D, F.G, (int)blockIdx.x);
        pg8::EpiResid E{FF32(WS_X1), FF32(WS_X1), M, 0.5f, F.out + O_YP, nullptr, FF32(WS_SSQ3)};
        pg8::gemm_phase<pg8::EpiResid, SO, true, true>(F.lds, g, S, E);
    } SEAM(P_FFN2B);
    if (IN(P_FINAL)) { final_norm(F); }
#if MK_PROBE >= 0
    { const unsigned long long t_ = __builtin_amdgcn_s_memrealtime(); if (MK_PROBE == P_FINAL) ts_dt = t_ - ts_prev;
      if (blockIdx.x == 0 && threadIdx.x == 0) F.out[0] += (float)ts_dt * (1.0f / 500.0f); }
#endif
#undef IN
#undef SEAM
}

static int g_grid = 0;
static bool mega_setup() {
    if (g_grid != 0) return g_grid > 0;
    int dev = 0, cus = 0, per_cu = 0;
    if (hipGetDevice(&dev) != hipSuccess || hipDeviceGetAttribute(&cus, hipDeviceAttributeMultiprocessorCount, dev) != hipSuccess) { g_grid = -1; return false; }
    if (hipFuncSetAttribute((const void*)mega_fwd, hipFuncAttributeMaxDynamicSharedMemorySize, LDS_BYTES) != hipSuccess) { fprintf(stderr, "mega: hipFuncSetAttribute failed\n"); g_grid = -1; return false; }
    if (hipOccupancyMaxActiveBlocksPerMultiprocessor(&per_cu, (const void*)mega_fwd, NTHREADS, LDS_BYTES) != hipSuccess || per_cu < 1) { fprintf(stderr, "mega: occupancy query says %d blocks per CU\n", per_cu); g_grid = -1; return false; }
    g_grid = cus;
    return true;
}
static void mega_launch(void* const* d_in, void* d_out, void* d_ws, int ph_lo, int ph_hi, hipStream_t stream) {
    if (!mega_setup()) return;
    MArgs a{};
    for (int i = 0; i < 21; ++i) a.in[i] = (const float*)d_in[i];
    a.out = (float*)d_out; a.ws = (unsigned char*)d_ws; a.ph_lo = ph_lo; a.ph_hi = ph_hi;
    void* kargs[] = {&a};
    const hipError_t e = hipLaunchCooperativeKernel((const void*)mega_fwd, dim3(g_grid), dim3(NTHREADS), kargs, LDS_BYTES, stream);
    if (e != hipSuccess) fprintf(stderr, "mega: cooperative launch failed: %s (grid %d)\n", hipGetErrorString(e), g_grid);
}
}
#endif
#ifdef CPU_EMU
typedef int hipStream_t;
#endif

struct Ptrs {
    const float *x_prompt, *x_sample, *state_conv, *state_gdn, *cache_k, *cache_v, *norm_ffn1, *w_ffn1_in, *w_ffn1_out, *norm_mix, *w_in, *conv_w,
                *a_log, *dt_bias, *gdn_norm, *sinks, *w_out, *norm_ffn2, *w_ffn2_in, *w_ffn2_out, *norm_final;
    float* out; unsigned char* ws;
};
static Ptrs make_ptrs(void* const* d_in, void* d_out, void* d_ws) {
    Ptrs p;
    p.x_prompt = (const float*)d_in[0]; p.x_sample = (const float*)d_in[1]; p.state_conv = (const float*)d_in[2]; p.state_gdn = (const float*)d_in[3];
    p.cache_k = (const float*)d_in[4]; p.cache_v = (const float*)d_in[5]; p.norm_ffn1 = (const float*)d_in[6]; p.w_ffn1_in = (const float*)d_in[7];
    p.w_ffn1_out = (const float*)d_in[8]; p.norm_mix = (const float*)d_in[9]; p.w_in = (const float*)d_in[10]; p.conv_w = (const float*)d_in[11];
    p.a_log = (const float*)d_in[12]; p.dt_bias = (const float*)d_in[13]; p.gdn_norm = (const float*)d_in[14]; p.sinks = (const float*)d_in[15];
    p.w_out = (const float*)d_in[16]; p.norm_ffn2 = (const float*)d_in[17]; p.w_ffn2_in = (const float*)d_in[18]; p.w_ffn2_out = (const float*)d_in[19];
    p.norm_final = (const float*)d_in[20]; p.out = (float*)d_out; p.ws = (unsigned char*)d_ws; return p;
}
#define WSB(off) ((bf16_t*)(p.ws + lay::off))
#define WSF(off) ((float*)(p.ws + lay::off))

static void nb_ffn1(const Ptrs& p, hipStream_t stream) {
    using namespace cfg; using namespace nv;
    NV_LAUNCH(RmsnormIn, M, p.x_prompt, p.x_sample, p.norm_ffn1, WSB(WS_XN1));
    NV_LAUNCH(GemmSwiglu, (long)(M / 4) * (FF / 4), (const bf16_t*)WSB(WS_XN1), p.w_ffn1_in, WSB(WS_HB), D);
    NV_LAUNCH(Gemm<float>, (long)(M / 4) * (D / 4), (const bf16_t*)WSB(WS_HB), FF, p.w_ffn1_out, D, WSF(WS_T1), D, D, FF);
    NV_LAUNCH(AxpyIn, (long)M * D, p.x_prompt, p.x_sample, (const float*)WSF(WS_T1), 0.5f, WSF(WS_X1));
}
static void nb_inproj(const Ptrs& p, hipStream_t stream) {
    using namespace cfg; using namespace nv;
    NV_LAUNCH(Rmsnorm<bf16_t>, M, (const float*)WSF(WS_X1), p.norm_mix, WSB(WS_X1B));
    const bf16_t* A = WSB(WS_X1B);
    NV_LAUNCH(Gemm<bf16_t>, (long)(M / 4) * (CONV / 4), A, D, p.w_in + U_RAW, DIN, WSB(WS_RAW), CONV, CONV, D);
    NV_LAUNCH(Gemm<bf16_t>, (long)(M / 4) * (1024 / 4), A, D, p.w_in + U_Z, DIN, WSB(WS_Z), 1024, 1024, D);
    NV_LAUNCH(Gemm<float>, (long)(M / 4) * (16 / 4), A, D, p.w_in + U_A, DIN, WSF(WS_AB), 16, 16, D);
    NV_LAUNCH(Gemm<bf16_t>, (long)(M / 4) * (1024 / 4), A, D, p.w_in + U_QS, DIN, WSB(WS_QS), 1024, 1024, D);
    NV_LAUNCH(Gemm<bf16_t>, (long)(M / 4) * (256 / 4), A, D, p.w_in + U_KS, DIN, WSB(WS_KS), 256, 256, D);
    NV_LAUNCH(Gemm<bf16_t>, (long)(M / 4) * (256 / 4), A, D, p.w_in + U_VS, DIN, WSB(WS_VS), 256, 256, D);
    NV_LAUNCH(Gemm<bf16_t>, (long)(M / 4) * (1024 / 4), A, D, p.w_in + U_GA, DIN, WSB(WS_GA), 1024, 1024, D);
    NV_LAUNCH(Gemm<bf16_t>, (long)(M / 4) * (1024 / 4), A, D, p.w_in + U_GB, DIN, WSB(WS_GB), 1024, 1024, D);
}
static void nb_mixer(const Ptrs& p, hipStream_t stream) {
    using namespace cfg; using namespace nv;
    float* out = p.out;
    NV_LAUNCH(OutConv, (long)(BATCH + DB) * 3 * CONV, (const bf16_t*)WSB(WS_RAW), out + O_CP, out + O_CS);
    NV_LAUNCH(ConvInPlace, (long)(BATCH + DB) * CONV, WSB(WS_RAW), p.state_conv, p.conv_w);
    NV_LAUNCH(L2norm, (long)M * 16, WSB(WS_RAW));
    NV_LAUNCH(Gdn, (long)(BATCH + DB) * H * DV, (const float*)WSF(WS_AB), (const bf16_t*)WSB(WS_RAW), p.state_gdn, p.a_log, p.dt_bias, WSB(WS_OG), out + O_GP, out + O_GS);
    NV_LAUNCH(Rope, (long)M * 160, WSB(WS_QS), WSB(WS_KS));
    NV_LAUNCH(OutKV, (long)(BATCH + DB) * WIN * 256, (const bf16_t*)WSB(WS_KS), (const bf16_t*)WSB(WS_VS), p.cache_k, p.cache_v, out + O_KP, out + O_KS, out + O_VP, out + O_VS);
    NV_LAUNCH(SwaPrompt, (long)MP * QH, WSB(WS_QS), (const bf16_t*)WSB(WS_KS), (const bf16_t*)WSB(WS_VS), p.sinks);
    NV_LAUNCH(SwaSample, (long)MS * QH, WSB(WS_QS), (const bf16_t*)WSB(WS_KS), (const bf16_t*)WSB(WS_VS), p.cache_k, p.cache_v, p.sinks);
    NV_LAUNCH(Mix, (long)M * H, (const bf16_t*)WSB(WS_Z), WSB(WS_GA), (const bf16_t*)WSB(WS_GB), (const bf16_t*)WSB(WS_OG), (const bf16_t*)WSB(WS_OS), p.gdn_norm);
}
static void nb_tail(const Ptrs& p, hipStream_t stream) {
    using namespace cfg; using namespace nv;
    NV_LAUNCH(Gemm<float>, (long)(M / 4) * (D / 4), (const bf16_t*)WSB(WS_MIXED), 1024, p.w_out, D, WSF(WS_T1), D, D, 1024);
    NV_LAUNCH(Axpy, (long)M * D, (const float*)WSF(WS_X1), (const float*)WSF(WS_T1), 1.0f, WSF(WS_X1));
    NV_LAUNCH(Rmsnorm<bf16_t>, M, (const float*)WSF(WS_X1), p.norm_ffn2, WSB(WS_X2B));
    NV_LAUNCH(GemmSwiglu, (long)(M / 4) * (FF / 4), (const bf16_t*)WSB(WS_X2B), p.w_ffn2_in, WSB(WS_HB), D);
    NV_LAUNCH(Gemm<float>, (long)(M / 4) * (D / 4), (const bf16_t*)WSB(WS_HB), FF, p.w_ffn2_out, D, WSF(WS_T1), D, D, FF);
    NV_LAUNCH(Axpy, (long)M * D, (const float*)WSF(WS_X1), (const float*)WSF(WS_T1), 0.5f, WSF(WS_X1));
    NV_LAUNCH(Rmsnorm<float>, M, (const float*)WSF(WS_X1), p.norm_final, p.out + O_YP);
}
extern "C" void kernel_launch(void* const* d_in, const int* in_sizes, int n_in, void* d_out, int out_size, void* d_ws, size_t ws_size, hipStream_t stream) {
    (void)in_sizes; (void)n_in; (void)out_size;
    if (ws_size < lay::WS_END) return;
#ifndef CPU_EMU
    mk::mega_launch(d_in, d_out, d_ws, mk::P_PRO, mk::P_COUNT, stream);
#else
    const Ptrs p = make_ptrs(d_in, d_out, d_ws);
    nb_ffn1(p, stream); nb_inproj(p, stream); nb_mixer(p, stream); nb_tail(p, stream);
#endif
}
```

```cpp
#ifndef CPU_EMU
#include <hip/hip_runtime.h>
#endif
#include <cmath>
#include <cstdint>
#include <cstddef>

#ifndef CFG_D_MODEL
#define CFG_D_MODEL 1024
#define CFG_BATCH 4
#define CFG_SEQ 4096
#define CFG_DEC_BATCH 128
#define CFG_DEC_SEQ 8
#define CFG_D_FF 2816
#endif
namespace cfg {
constexpr int D = CFG_D_MODEL, BATCH = CFG_BATCH, SEQ = CFG_SEQ, DB = CFG_DEC_BATCH, DS = CFG_DEC_SEQ, FF = CFG_D_FF;
constexpr int PAST = 16384;
constexpr int MP = BATCH * SEQ, MS = DB * DS, M = MP + MS;
constexpr int H = 8, DK = 128, DV = 128, CONV = 3072, QH = 16, KVH = 4, HD = 64, WIN = 128;
constexpr int DIN = 3072 + 1024 + 16 + 1024 + 256 + 256 + 2 * D;
constexpr int U_RAW = 0, U_Z = 3072, U_A = 4096, U_B = 4104, U_QS = 4112, U_KS = 5136, U_VS = 5392, U_GA = 5648, U_GB = 5648 + D;
constexpr float EPS = 1e-6f;
constexpr size_t O_YP = 0, O_YS = O_YP + (size_t)MP * D, O_CP = O_YS + (size_t)MS * D, O_CS = O_CP + (size_t)BATCH * 3 * CONV,
                 O_GP = O_CS + (size_t)DB * 3 * CONV, O_GS = O_GP + (size_t)BATCH * H * DK * DV, O_KP = O_GS + (size_t)DB * H * DK * DV,
                 O_KS = O_KP + (size_t)BATCH * WIN * KVH * HD, O_VP = O_KS + (size_t)DB * WIN * KVH * HD,
                 O_VS = O_VP + (size_t)BATCH * WIN * KVH * HD, O_END = O_VS + (size_t)DB * WIN * KVH * HD;
}

#ifdef CPU_EMU
#define HDI inline
template <class K, class... A> void nv_launch(long n, A... a) { for (long g = 0; g < n; ++g) K::run(g, a...); }
#define NV_LAUNCH(K, n, ...) nv_launch<K>((long)(n), __VA_ARGS__)
#else
#define HDI __device__ __forceinline__
template <class K, class... A> __global__ void __launch_bounds__(256) nv_kernel(long n, A... a) {
    for (long g = (long)blockIdx.x * blockDim.x + threadIdx.x; g < n; g += (long)gridDim.x * blockDim.x) K::run(g, a...);
}
#define NV_LAUNCH(K, n, ...) do { long _n = (long)(n); long _b = (_n + 255) / 256; if (_b > 65536 * 4) _b = 65536 * 4; if (_b < 1) _b = 1; \
    nv_kernel<K><<<dim3((unsigned)_b), dim3(256), 0, stream>>>(_n, __VA_ARGS__); } while (0)
#endif

typedef unsigned short bf16_t;
namespace lay {
using namespace cfg;
constexpr size_t MiB = (size_t)1 << 20;
constexpr size_t WS_CTL = 0, WS_W1IN = 1 * MiB, WS_W1OUT = 12 * MiB, WS_WIN = 18 * MiB, WS_WAB = 33 * MiB, WS_WOUT = 34 * MiB, WS_W2IN = 36 * MiB, WS_W2OUT = 47 * MiB;
constexpr size_t WS_SSQ1 = 53 * MiB, WS_SSQ2 = 55 * MiB, WS_SSQ3 = 57 * MiB, WS_AB = 59 * MiB;
constexpr size_t WS_XN1 = 62 * MiB, WS_X2B = WS_XN1, WS_X1B = 96 * MiB, WS_X1 = 130 * MiB, WS_RAW = 198 * MiB, WS_Z = 300 * MiB, WS_QS = 334 * MiB, WS_OS = WS_QS;
constexpr size_t WS_KS = 368 * MiB, WS_VS = 377 * MiB, WS_GA = 386 * MiB, WS_MIXED = WS_GA, WS_GB = 420 * MiB, WS_OG = 454 * MiB, WS_HB = 488 * MiB, WS_END = 671 * MiB;
constexpr size_t WS_WK = 488 * MiB, WS_QG = 520 * MiB, WS_KGT = 552 * MiB, WS_QKP = 584 * MiB, WS_UV = 600 * MiB, WS_GL = 664 * MiB, WS_QKVS = 665 * MiB;
constexpr size_t WS_T1 = WS_RAW;
static_assert((size_t)M * D * 2 <= 34 * MiB && (size_t)M * D * 4 <= 68 * MiB && (size_t)M * CONV * 2 <= 102 * MiB && (size_t)M * FF * 2 <= 144 * MiB && (size_t)M * 256 * 2 <= 9 * MiB && (size_t)M * 16 * 4 <= 2 * MiB, "layout");
constexpr size_t WS_VN = 1 * MiB, WS_QN = 62 * MiB, WS_KN = 94 * MiB;
static_assert((size_t)MP * 1024 * 2 <= 32 * MiB, "layout");
}
namespace nv {
using namespace cfg;
HDI float bf2f(bf16_t v) { union { unsigned u; float f; } c; c.u = (unsigned)v << 16; return c.f; }
HDI bf16_t f2bf(float f) { union { unsigned u; float f; } c; c.f = f; return (bf16_t)((c.u + 0x7fffu + ((c.u >> 16) & 1u)) >> 16); }
HDI float ld(const float* p) { return *p; }
HDI float ld(const bf16_t* p) { return bf2f(*p); }
HDI void st(float* p, float v) { *p = v; }
HDI void st(bf16_t* p, float v) { *p = f2bf(v); }
HDI float silu_f(float x) { return x / (1.0f + expf(-x)); }
HDI float sigmoid_f(float x) { return 1.0f / (1.0f + expf(-x)); }
HDI float softplus_f(float x) { return x > 20.f ? x : log1pf(expf(x)); }
HDI const float* xrow(const float* xp, const float* xs, long r) { return r < MP ? xp + r * D : xs + (r - MP) * D; }

struct RmsnormIn {
    static HDI void run(long r, const float* xp, const float* xs, const float* w, bf16_t* out) {
        const float* xr = xrow(xp, xs, r); float s = 0.f;
        for (int c = 0; c < D; ++c) s += xr[c] * xr[c];
        const float rs = 1.0f / sqrtf(s / (float)D + EPS);
        for (int c = 0; c < D; ++c) out[r * D + c] = f2bf(xr[c] * rs * w[c]);
    }
};
template <class TO> struct Rmsnorm {
    static HDI void run(long r, const float* x, const float* w, TO* out) {
        const float* xr = x + r * D; float s = 0.f;
        for (int c = 0; c < D; ++c) s += xr[c] * xr[c];
        const float rs = 1.0f / sqrtf(s / (float)D + EPS);
        for (int c = 0; c < D; ++c) st(out + r * D + c, xr[c] * rs * w[c]);
    }
};
template <class TC> struct Gemm {
    static HDI void run(long g, const bf16_t* A, int lda, const float* B, int ldb, TC* C, int ldc, int N, int K) {
        const int nq = N / 4; const long mi = g / nq; const int ni = (int)(g % nq);
        float acc[4][4];
#pragma unroll
        for (int i = 0; i < 4; ++i)
#pragma unroll
            for (int j = 0; j < 4; ++j) acc[i][j] = 0.f;
        const bf16_t* a0 = A + (mi * 4) * lda; const float* bp = B + ni * 4;
        for (int k = 0; k < K; ++k) {
            const float b0 = bp[(long)k * ldb], b1 = bp[(long)k * ldb + 1], b2 = bp[(long)k * ldb + 2], b3 = bp[(long)k * ldb + 3];
#pragma unroll
            for (int i = 0; i < 4; ++i) { const float a = bf2f(a0[(long)i * lda + k]); acc[i][0] += a * b0; acc[i][1] += a * b1; acc[i][2] += a * b2; acc[i][3] += a * b3; }
        }
#pragma unroll
        for (int i = 0; i < 4; ++i)
#pragma unroll
            for (int j = 0; j < 4; ++j) st(C + (mi * 4 + i) * ldc + ni * 4 + j, acc[i][j]);
    }
};
struct GemmSwiglu {
    static HDI void run(long g, const bf16_t* A, const float* B, bf16_t* Hh, int K) {
        const int nq = FF / 4; const long mi = g / nq; const int ni = (int)(g % nq);
        float ag[4][4], au[4][4];
#pragma unroll
        for (int i = 0; i < 4; ++i)
#pragma unroll
            for (int j = 0; j < 4; ++j) { ag[i][j] = 0.f; au[i][j] = 0.f; }
        const bf16_t* a0 = A + (mi * 4) * K; const float* bp = B + ni * 4;
        for (int k = 0; k < K; ++k) {
            float bg[4], bu[4];
#pragma unroll
            for (int j = 0; j < 4; ++j) { bg[j] = bp[(long)k * 2 * FF + j]; bu[j] = bp[(long)k * 2 * FF + FF + j]; }
#pragma unroll
            for (int i = 0; i < 4; ++i) { const float a = bf2f(a0[(long)i * K + k]);
#pragma unroll
                for (int j = 0; j < 4; ++j) { ag[i][j] += a * bg[j]; au[i][j] += a * bu[j]; } }
        }
#pragma unroll
        for (int i = 0; i < 4; ++i)
#pragma unroll
            for (int j = 0; j < 4; ++j) Hh[(mi * 4 + i) * FF + ni * 4 + j] = f2bf(silu_f(ag[i][j]) * au[i][j]);
    }
};
struct AxpyIn {
    static HDI void run(long g, const float* xp, const float* xs, const float* T, float alpha, float* out) { const long r = g / D; const int c = (int)(g % D); out[g] = xrow(xp, xs, r)[c] + alpha * T[g]; }
};
struct Axpy {
    static HDI void run(long g, const float* a, const float* b, float alpha, float* out) { out[g] = a[g] + alpha * b[g]; }
};
HDI void row_info(long r, int& is_s, int& seq, int& t, int& L, long& base) {
    if (r < MP) { is_s = 0; seq = (int)(r / SEQ); t = (int)(r % SEQ); L = SEQ; base = (long)seq * SEQ; }
    else { const long rr = r - MP; is_s = 1; seq = (int)(rr / DS); t = (int)(rr % DS); L = DS; base = MP + (long)seq * DS; }
}
struct ConvInPlace {
    static HDI void run(long g, bf16_t* RAW, const float* state_conv, const float* conv_w) {
        const int c = (int)(g % CONV); const int sq = (int)(g / CONV);
        const int is_s = sq >= BATCH; const int seq = is_s ? sq - BATCH : sq; const int L = is_s ? DS : SEQ;
        const long base = is_s ? MP + (long)seq * DS : (long)seq * SEQ;
        const float w0 = conv_w[0 * CONV + c], w1 = conv_w[1 * CONV + c], w2 = conv_w[2 * CONV + c], w3 = conv_w[3 * CONV + c];
        float e0 = is_s ? state_conv[((long)seq * 3 + 0) * CONV + c] : 0.f;
        float e1 = is_s ? state_conv[((long)seq * 3 + 1) * CONV + c] : 0.f;
        float e2 = is_s ? state_conv[((long)seq * 3 + 2) * CONV + c] : 0.f;
        for (int t = 0; t < L; ++t) {
            const float e3 = bf2f(RAW[(base + t) * CONV + c]);
            RAW[(base + t) * CONV + c] = f2bf(silu_f(w0 * e0 + w1 * e1 + w2 * e2 + w3 * e3));
            e0 = e1; e1 = e2; e2 = e3;
        }
    }
};
struct L2norm {
    static HDI void run(long g, bf16_t* QKV) {
        const long r = g / 16; const int hh = (int)(g % 16);
        bf16_t* p = QKV + r * CONV + hh * 128; float s = 0.f;
        for (int j = 0; j < 128; ++j) { const float v = bf2f(p[j]); s += v * v; }
        const float rs = 1.0f / sqrtf(s + EPS);
        for (int j = 0; j < 128; ++j) p[j] = f2bf(bf2f(p[j]) * rs);
    }
};
struct Gdn {
    static HDI void run(long g, const float* AB, const bf16_t* QKV, const float* state_gdn, const float* a_log, const float* dt_bias,
                        bf16_t* OG, float* out_gp, float* out_gs) {
        const int dv = (int)(g % DV); const int h = (int)((g / DV) % H); const int sq = (int)(g / (DV * H));
        const int is_s = sq >= BATCH; const int seq = is_s ? sq - BATCH : sq; const int L = is_s ? DS : SEQ;
        const long base = is_s ? MP + (long)seq * DS : (long)seq * SEQ;
        float S[DK];
#pragma unroll
        for (int j = 0; j < DK; ++j) S[j] = is_s ? state_gdn[(((long)seq * H + h) * DK + j) * DV + dv] : 0.f;
        const float ea = expf(a_log[h]), dtb = dt_bias[h];
        for (int t = 0; t < L; ++t) {
            const long r = base + t;
            const float a = AB[r * 16 + h], b = AB[r * 16 + 8 + h];
            const float gg = -ea * softplus_f(a + dtb), beta = sigmoid_f(b), alpha = expf(gg);
            const bf16_t* q = QKV + r * CONV + h * DK; const bf16_t* k = QKV + r * CONV + 1024 + h * DK;
            const float v = bf2f(QKV[r * CONV + 2048 + h * DV + dv]);
            float ks = 0.f;
#pragma unroll
            for (int j = 0; j < DK; ++j) ks += bf2f(k[j]) * S[j];
            const float vn = beta * (v - alpha * ks);
            float o = 0.f;
#pragma unroll
            for (int j = 0; j < DK; ++j) { S[j] = alpha * S[j] + bf2f(k[j]) * vn; o += bf2f(q[j]) * S[j]; }
            OG[r * 1024 + h * DV + dv] = f2bf(o * 0.08838834764831845f);
        }
        float* so = is_s ? out_gs : out_gp;
#pragma unroll
        for (int j = 0; j < DK; ++j) so[(((long)seq * H + h) * DK + j) * DV + dv] = S[j];
    }
};
struct Rope {
    static HDI void run(long g, bf16_t* QS, bf16_t* KS) {
        const int i = (int)(g % 8); const int hh = (int)((g / 8) % 20); const long r = g / 160;
        int is_s, seq, t, L; long base; row_info(r, is_s, seq, t, L, base);
        const float pos = (float)(is_s ? PAST + t : t);
        const float inv = powf(500000.0f, -(float)(2 * i) / 16.0f);
        const float ang = pos * inv; const float cs = cosf(ang), sn = sinf(ang);
        bf16_t* p = hh < 16 ? QS + r * 1024 + hh * 64 : KS + r * 256 + (hh - 16) * 64;
        const float x1 = bf2f(p[i]), x2 = bf2f(p[i + 8]);
        p[i] = f2bf(x1 * cs - x2 * sn); p[i + 8] = f2bf(x2 * cs + x1 * sn);
    }
};
struct SwaPrompt {
    static HDI void run(long g, bf16_t* QS, const bf16_t* KS, const bf16_t* VS, const float* sinks) {
        const int qh = (int)(g % QH); const long r = g / QH; const int b = (int)(r / SEQ), t = (int)(r % SEQ); const int kvh = qh / 4;
        float q[HD], o[HD];
#pragma unroll
        for (int d = 0; d < HD; ++d) { q[d] = bf2f(QS[r * 1024 + qh * HD + d]); o[d] = 0.f; }
        float m = sinks[qh], l = 1.0f;
        const int j0 = t - (WIN - 1) < 0 ? 0 : t - (WIN - 1);
        for (int j = j0; j <= t; ++j) {
            const long rk = (long)b * SEQ + j; const bf16_t* kp = KS + rk * 256 + kvh * HD; const bf16_t* vp = VS + rk * 256 + kvh * HD;
            float s = 0.f;
#pragma unroll
            for (int d = 0; d < HD; ++d) s += q[d] * bf2f(kp[d]);
            s *= 0.125f;
            const float mn = fmaxf(m, s), sc = expf(m - mn), p = expf(s - mn);
            l = l * sc + p;
#pragma unroll
            for (int d = 0; d < HD; ++d) o[d] = o[d] * sc + p * bf2f(vp[d]);
            m = mn;
        }
        const float il = 1.0f / l;
#pragma unroll
        for (int d = 0; d < HD; ++d) QS[r * 1024 + qh * HD + d] = f2bf(o[d] * il);
    }
};
struct SwaSample {
    static HDI void run(long g, bf16_t* QS, const bf16_t* KS, const bf16_t* VS, const float* ck, const float* cv, const float* sinks) {
        const int qh = (int)(g % QH); const long rr = g / QH; const int b = (int)(rr / DS), t = (int)(rr % DS); const int kvh = qh / 4;
        const long r = MP + rr;
        float q[HD], o[HD];
#pragma unroll
        for (int d = 0; d < HD; ++d) { q[d] = bf2f(QS[r * 1024 + qh * HD + d]); o[d] = 0.f; }
        float m = sinks[qh], l = 1.0f;
        for (int j = t + 1; j < WIN + t + 1; ++j) {
            float s = 0.f; float vv[HD];
            if (j < WIN) { const float* kp = ck + (((long)b * WIN + j) * KVH + kvh) * HD; const float* vp = cv + (((long)b * WIN + j) * KVH + kvh) * HD;
#pragma unroll
                for (int d = 0; d < HD; ++d) { s += q[d] * kp[d]; vv[d] = vp[d]; } }
            else { const long rk = MP + (long)b * DS + (j - WIN); const bf16_t* kp = KS + rk * 256 + kvh * HD; const bf16_t* vp = VS + rk * 256 + kvh * HD;
#pragma unroll
                for (int d = 0; d < HD; ++d) { s += q[d] * bf2f(kp[d]); vv[d] = bf2f(vp[d]); } }
            s *= 0.125f;
            const float mn = fmaxf(m, s), sc = expf(m - mn), p = expf(s - mn);
            l = l * sc + p;
#pragma unroll
            for (int d = 0; d < HD; ++d) o[d] = o[d] * sc + p * vv[d];
            m = mn;
        }
        const float il = 1.0f / l;
#pragma unroll
        for (int d = 0; d < HD; ++d) QS[r * 1024 + qh * HD + d] = f2bf(o[d] * il);
    }
};
struct Mix {
    static HDI void run(long g, const bf16_t* Z, bf16_t* GA, const bf16_t* GB, const bf16_t* OG, const bf16_t* OS, const float* gdn_norm) {
        const int h = (int)(g % H); const long r = g / H;
        const bf16_t* og = OG + r * 1024 + h * DV; float s = 0.f;
        for (int j = 0; j < DV; ++j) { const float v = bf2f(og[j]); s += v * v; }
        const float rs = 1.0f / sqrtf(s / (float)DV + EPS);
        for (int j = 0; j < DV; ++j) {
            const long c = r * 1024 + h * DV + j;
            const float z = bf2f(Z[c]), ga = bf2f(GA[c]), gb = bf2f(GB[c]);
            GA[c] = f2bf(sigmoid_f(ga) * (bf2f(og[j]) * rs * gdn_norm[j] * silu_f(z)) + sigmoid_f(gb) * bf2f(OS[c]));
        }
    }
};
struct OutConv {
    static HDI void run(long g, const bf16_t* RAW, float* out_cp, float* out_cs) {
        const int c = (int)(g % CONV); const int i = (int)((g / CONV) % 3); const int sq = (int)(g / (3 * CONV));
        const int is_s = sq >= BATCH; const int seq = is_s ? sq - BATCH : sq; const int L = is_s ? DS : SEQ;
        const long base = is_s ? MP + (long)seq * DS : (long)seq * SEQ;
        const float v = bf2f(RAW[(base + L - 3 + i) * CONV + c]);
        (is_s ? out_cs : out_cp)[((long)seq * 3 + i) * CONV + c] = v;
    }
};
struct OutKV {
    static HDI void run(long g, const bf16_t* KS, const bf16_t* VS, const float* ck, const float* cv, float* out_kp, float* out_ks, float* out_vp, float* out_vs) {
        const int c = (int)(g % 256); const int j = (int)((g / 256) % WIN); const int sq = (int)(g / (256 * WIN));
        if (sq < BATCH) {
            const long r = (long)sq * SEQ + SEQ - WIN + j;
            out_kp[((long)sq * WIN + j) * 256 + c] = bf2f(KS[r * 256 + c]); out_vp[((long)sq * WIN + j) * 256 + c] = bf2f(VS[r * 256 + c]);
        } else {
            const int b = sq - BATCH; float kv, vv;
            if (j + DS < WIN) { kv = ck[((long)b * WIN + j + DS) * 256 + c]; vv = cv[((long)b * WIN + j + DS) * 256 + c]; }
            else { const long r = MP + (long)b * DS + (j + DS - WIN); kv = bf2f(KS[r * 256 + c]); vv = bf2f(VS[r * 256 + c]); }
            out_ks[((long)b * WIN + j) * 256 + c] = kv; out_vs[((long)b * WIN + j) * 256 + c] = vv;
        }
    }
};
}
namespace pg8 {
#define PG8_LAS __attribute__((address_space(3)))
typedef short bf16x8 __attribute__((ext_vector_type(8)));
typedef float f32x4 __attribute__((ext_vector_type(4)));
typedef unsigned u32x4 __attribute__((ext_vector_type(4)));
constexpr int BM = 256, BK = 64, HALF = 128, HTB = HALF * BK * 2  , STAGE_BYTES = 8 * HTB, NXCD = 8, WGM = 8;

__host__ __device__ __forceinline__ int lds_byte(int r, int c) { const int st = (r >> 4) * 2 + (c >> 5), rr = r & 15, cc = c & 31, ob = rr * 64 + cc * 2; return st * 1024 + (ob ^ (((ob >> 9) & 1) << 5)); }
__host__ __device__ __forceinline__ void stage_rc(int b, int& R, int& C) { const int st = b / 1024, sb = b % 1024, swz = sb ^ (((sb >> 9) & 1) << 5); R = (st >> 1) * 16 + swz / 64; C = (st & 1) * 32 + (swz % 64) / 2; }
__host__ __device__ __forceinline__ int perm32(int rho) { const int n = rho >> 4, i = rho & 15; return 8 * (i >> 2) + 4 * n + (i & 3); }

struct Unit { int pm, pn; };
struct Gemm { const bf16_t* A; const bf16_t* Bt; int M, N, K; };

struct StaticOrder {
    int nM, nN, nwg, G, c;
    __host__ __device__ void init(int M, int N, int G_, int c_) { nM = M / BM; nN = N / BM; nwg = nM * nN; G = G_; c = c_; }
    __host__ __device__ bool next(int i, Unit& u) const {
        const long L = (long)i * G + c; if (L >= nwg) return false;
        int wgid = (int)L; { const int q = nwg / NXCD, r = nwg % NXCD, xcd = wgid % NXCD, off = wgid / NXCD; wgid = (xcd < r ? xcd * (q + 1) : r * (q + 1) + (xcd - r) * q) + off; }
        const int nig = WGM * nN, gid = wgid / nig, fm = gid * WGM, gsz = (nM - fm) < WGM ? (nM - fm) : WGM;
        u.pm = fm + ((wgid % nig) % gsz); u.pn = (wgid % nig) / gsz; return true;
    }
    __device__ __forceinline__ void a_ready(const Unit&) const {}
    __device__ __forceinline__ void done(const Unit&) const {}
};
typedef unsigned u32x2 __attribute__((ext_vector_type(2)));
__device__ __forceinline__ unsigned cvt_pk_bf16(float lo, float hi) { unsigned r; asm volatile("v_cvt_pk_bf16_f32 %0, %1, %2" : "=v"(r) : "v"(lo), "v"(hi)); return r; }
__device__ __forceinline__ float fast_sigmoid(float x) { return __builtin_amdgcn_rcpf(1.0f + __builtin_amdgcn_exp2f(-1.4426950408889634f * x)); }
__device__ __forceinline__ float fast_silu(float x) { return x * fast_sigmoid(x); }
__device__ __forceinline__ void load_rs(float (&rs)[2][4], const float* ssq, int pm, int wr, int fr, int fq) {
#pragma unroll
    for (int ai = 0; ai < 2; ++ai)
#pragma unroll
        for (int m = 0; m < 4; ++m) {
            const int row = pm * BM + ai * HALF + wr * 64 + m * 16 + fr;
            const f32x4 v = *(const f32x4*)(ssq + (size_t)row * 16 + 4 * fq);
            float s = (v[0] + v[1]) + (v[2] + v[3]);
            s += __shfl_xor(s, 16); s += __shfl_xor(s, 32);
            rs[ai][m] = 1.0f / sqrtf(s * (1.0f / 1024.0f) + 1e-6f);
        }
}
struct EpiSwiglu {
    static constexpr bool PERM = true, AFTER_DRAIN = false;
    bf16_t* Hh; int ldh; const float* ssq;
    __device__ __forceinline__ void operator()(const f32x4 (&acc)[2][2][4][2], const Unit& u, int wr, int wc, int fr, int fq) const {
        float rs[2][4];
        if (ssq) load_rs(rs, ssq, u.pm, wr, fr, fq);
        const int col0 = u.pn * HALF + wc * 32 + 8 * fq;
#pragma unroll
        for (int ai = 0; ai < 2; ++ai)
#pragma unroll
            for (int m = 0; m < 4; ++m) {
                const float r_ = ssq ? rs[ai][m] : 1.0f;
                const int row = u.pm * BM + ai * HALF + wr * 64 + m * 16 + fr;
                float hv[8];
#pragma unroll
                for (int n = 0; n < 2; ++n)
#pragma unroll
                    for (int i = 0; i < 4; ++i) { const float g = acc[ai][0][m][n][i] * r_, up = acc[ai][1][m][n][i] * r_; hv[4 * n + i] = fast_silu(g) * up; }
                u32x4 w; w.x = cvt_pk_bf16(hv[0], hv[1]); w.y = cvt_pk_bf16(hv[2], hv[3]); w.z = cvt_pk_bf16(hv[4], hv[5]); w.w = cvt_pk_bf16(hv[6], hv[7]);
                *(u32x4*)(Hh + (size_t)row * ldh + col0) = w;
            }
    }
};
struct EpiInProj {
    static constexpr bool PERM = true, AFTER_DRAIN = false;
    bf16_t *raw, *z, *qs, *ks, *vs, *ga, *gb; const float* ssq;
    __device__ __forceinline__ void operator()(const f32x4 (&acc)[2][2][4][2], const Unit& u, int wr, int wc, int fr, int fq) const {
        float rs[2][4]; load_rs(rs, ssq, u.pm, wr, fr, fq);
        bf16_t* base; int ldc, colt; const int pn = u.pn;
        if (pn < 12) { base = raw; ldc = 3072; colt = pn * 256; }
        else if (pn < 16) { base = z; ldc = 1024; colt = (pn - 12) * 256; }
        else if (pn < 20) { base = qs; ldc = 1024; colt = (pn - 16) * 256; }
        else if (pn == 20) { base = ks; ldc = 256; colt = 0; }
        else if (pn == 21) { base = vs; ldc = 256; colt = 0; }
        else if (pn < 26) { base = ga; ldc = 1024; colt = (pn - 22) * 256; }
        else { base = gb; ldc = 1024; colt = (pn - 26) * 256; }
        const int col0 = colt + wc * 32 + 8 * fq;
#pragma unroll
        for (int ai = 0; ai < 2; ++ai)
#pragma unroll
            for (int m = 0; m < 4; ++m) {
                const float r_ = rs[ai][m];
                bf16_t* rowp = base + (size_t)(u.pm * BM + ai * HALF + wr * 64 + m * 16 + fr) * ldc + col0;
#pragma unroll
                for (int bj = 0; bj < 2; ++bj) { const f32x4 v0 = acc[ai][bj][m][0] * r_, v1 = acc[ai][bj][m][1] * r_;
                    u32x4 w; w.x = cvt_pk_bf16(v0[0], v0[1]); w.y = cvt_pk_bf16(v0[2], v0[3]); w.z = cvt_pk_bf16(v1[0], v1[1]); w.w = cvt_pk_bf16(v1[2], v1[3]);
                    *(u32x4*)(rowp + bj * HALF) = w; }
            }
    }
};
struct EpiResid {
    static constexpr bool PERM = false, AFTER_DRAIN = false;
    const float* xin_p; const float* xin_s; int split_row; float alpha; float* xout; bf16_t* xb; float* ssq;
    __device__ __forceinline__ void operator()(const f32x4 (&acc)[2][2][4][2], const Unit& u, int wr, int wc, int fr, int fq) const {
        const int col0 = u.pn * BM + wc * 32 + 4 * fq;
#pragma unroll
        for (int ai = 0; ai < 2; ++ai)
#pragma unroll
            for (int m = 0; m < 4; ++m) {
                const int row = u.pm * BM + ai * HALF + wr * 64 + m * 16 + fr;
                const float* xr = (row < split_row ? xin_p + (size_t)row * 1024 : xin_s + (size_t)(row - split_row) * 1024) + col0;
                float* orow = xout + (size_t)row * 1024 + col0;
                float ss = 0.f;
#pragma unroll
                for (int bj = 0; bj < 2; ++bj)
#pragma unroll
                    for (int n = 0; n < 2; ++n) {
                        const f32x4 xi = *(const f32x4*)(xr + bj * HALF + n * 16);
                        const f32x4 o = xi + acc[ai][bj][m][n] * alpha;
                        *(f32x4*)(orow + bj * HALF + n * 16) = o;
                        if (xb) { u32x2 w; w.x = cvt_pk_bf16(o[0], o[1]); w.y = cvt_pk_bf16(o[2], o[3]); *(u32x2*)(xb + (size_t)row * 1024 + col0 + bj * HALF + n * 16) = w; }
                        ss += (o[0] * o[0] + o[1] * o[1]) + (o[2] * o[2] + o[3] * o[3]);
                    }
                ss += __shfl_xor(ss, 16); ss += __shfl_xor(ss, 32);
                if (fq == 0) ssq[(size_t)row * 16 + u.pn * 4 + wc] = ss;
                if (m & 1) asm volatile("" ::: "memory");
            }
    }
};
template <class Epi, class Sched, bool ALIGN_EPI = false, bool SP2 = false>
__device__ __forceinline__ void gemm_phase(PG8_LAS unsigned char* lds, const Gemm g, const Sched& S, const Epi& E) {
    const int tid = threadIdx.x, wid = __builtin_amdgcn_readfirstlane(tid >> 6), lane = tid & 63, wr = wid >> 2, wc = wid & 3, fr = lane & 15, fq = lane >> 4;
    const int K = g.K, nt = K / BK;
    unsigned voffA[2], voffB[2];
#pragma unroll
    for (int i = 0; i < 2; ++i) { int R, C; stage_rc(tid * 16 + i * 8192, R, C); const int Rb = Epi::PERM ? ((R & ~31) + perm32(R & 31)) : R;
        voffA[i] = (unsigned)(R * K + C) * 2u; voffB[i] = (unsigned)(Rb * K + C) * 2u; }
    const size_t kstep = (size_t)(BK * 2);
    const size_t hstep = (size_t)HALF * K * 2;
    const size_t tstep = 2 * hstep;
    const unsigned ldsw = (unsigned)wid * 1024u;
    const int aoff = lds_byte(wr * 64 + fr, fq * 8), boff = lds_byte(wc * 32 + fr, fq * 8);
#define PG8_SA(b, h) (((b) * 2 + (h)) * HTB)
#define PG8_SB(b, h) ((4 + (b) * 2 + (h)) * HTB)
#define PG8_STAGE(bufoff, gbase, voff) do { _Pragma("unroll") for (int _i = 0; _i < 2; ++_i) \
        __builtin_amdgcn_global_load_lds((const unsigned*)((const char*)(gbase) + (voff)[_i]), (PG8_LAS unsigned*)(lds + (bufoff) + ldsw + _i * 8192), 16, 0, 0); } while (0)
#define PG8_LDA(dst, b, h) do { _Pragma("unroll") for (int m = 0; m < 4; ++m) _Pragma("unroll") for (int k = 0; k < 2; ++k) dst[m][k] = *(const PG8_LAS bf16x8*)(lds + PG8_SA(b, h) + aoff + m * 2048 + k * 1024); } while (0)
#define PG8_LDB(dst, b, h) do { _Pragma("unroll") for (int n = 0; n < 2; ++n) _Pragma("unroll") for (int k = 0; k < 2; ++k) dst[n][k] = *(const PG8_LAS bf16x8*)(lds + PG8_SB(b, h) + boff + n * 2048 + k * 1024); } while (0)
#define PG8_MMA(ai, bj, At, Bt) do { __builtin_amdgcn_s_setprio(1); _Pragma("unroll") for (int m = 0; m < 4; ++m) _Pragma("unroll") for (int n = 0; n < 2; ++n) _Pragma("unroll") for (int k = 0; k < 2; ++k) \
        acc[ai][bj][m][n] = __builtin_amdgcn_mfma_f32_16x16x32_bf16(Bt[n][k], At[m][k], acc[ai][bj][m][n], 0, 0, 0); __builtin_amdgcn_s_setprio(0); } while (0)
#define PG8_WAIT_V(n) asm volatile("s_waitcnt vmcnt(" #n ")" ::: "memory")
#define PG8_WAIT_L(n) asm volatile("s_waitcnt lgkmcnt(" #n ")" ::: "memory")
#define PG8_BAR __builtin_amdgcn_s_barrier()
#define PG8_SCHED __builtin_amdgcn_sched_barrier(0)
    Unit cur, nxt; int ui = 0;
    if (!S.next(0, cur)) return;
    f32x4 acc[2][2][4][2];
#pragma unroll
    for (int a = 0; a < 2; ++a)
#pragma unroll
        for (int b = 0; b < 2; ++b)
#pragma unroll
            for (int m = 0; m < 4; ++m)
#pragma unroll
                for (int n = 0; n < 2; ++n) acc[a][b][m][n] = (f32x4){0.f, 0.f, 0.f, 0.f};
    bf16x8 At[4][2], B0[2][2], B1[2][2];
    const char* cA = (const char*)g.A + (size_t)cur.pm * tstep; const char* cB = (const char*)g.Bt + (size_t)cur.pn * tstep;
    S.a_ready(cur);
    if constexpr (SP2) {
        PG8_STAGE(PG8_SB(0, 0), cB, voffB); PG8_STAGE(PG8_SB(0, 1), cB + hstep, voffB); PG8_STAGE(PG8_SA(0, 0), cA, voffA); PG8_STAGE(PG8_SA(0, 1), cA + hstep, voffA);
        if (wr == 1) PG8_BAR;
        PG8_WAIT_V(2); PG8_BAR;
        PG8_STAGE(PG8_SB(1, 0), cB + kstep, voffB); PG8_STAGE(PG8_SA(1, 0), cA + kstep, voffA); PG8_STAGE(PG8_SB(1, 1), cB + hstep + kstep, voffB);
        PG8_WAIT_V(6); PG8_BAR;
    } else {
        PG8_STAGE(PG8_SB(0, 0), cB, voffB); PG8_STAGE(PG8_SA(0, 0), cA, voffA); PG8_STAGE(PG8_SB(0, 1), cB + hstep, voffB); PG8_STAGE(PG8_SA(0, 1), cA + hstep, voffA);
        if (wr == 1) PG8_BAR;
        PG8_WAIT_V(4); PG8_BAR;
        PG8_STAGE(PG8_SB(1, 0), cB + kstep, voffB); PG8_STAGE(PG8_SA(1, 0), cA + kstep, voffA); PG8_STAGE(PG8_SB(1, 1), cB + hstep + kstep, voffB);
        PG8_WAIT_V(6); PG8_BAR;
    }
    for (;;) {
        const bool has_next = S.next(ui + 1, nxt);
        const char* nA = has_next ? (const char*)g.A + (size_t)nxt.pm * tstep : cA; const char* nB = has_next ? (const char*)g.Bt + (size_t)nxt.pn * tstep : cB;
        for (int t = 0; t < nt; t += 2) {
            const bool last = (t == nt - 2);
            const char* a1 = cA + (size_t)(t + 1) * kstep;
            const char* a2 = last ? nA : cA + (size_t)(t + 2) * kstep; const char* b2 = last ? nB : cB + (size_t)(t + 2) * kstep;
            const char* a3 = a2 + kstep; const char* b3 = b2 + kstep;
            if (last && has_next) S.a_ready(nxt);
            if constexpr (SP2) {
            PG8_LDB(B0, 0, 0); PG8_LDB(B1, 0, 1); PG8_SCHED; PG8_LDA(At, 0, 0); PG8_STAGE(PG8_SA(1, 1), a1 + hstep, voffA);
            PG8_WAIT_V(8); PG8_WAIT_L(0); PG8_BAR; PG8_MMA(0, 0, At, B0); PG8_MMA(0, 1, At, B1); PG8_BAR; PG8_SCHED;
            PG8_LDA(At, 0, 1); PG8_STAGE(PG8_SB(0, 0), b2, voffB); PG8_STAGE(PG8_SB(0, 1), b2 + hstep, voffB); PG8_STAGE(PG8_SA(0, 0), a2, voffA);
            PG8_WAIT_V(8); PG8_WAIT_L(0); PG8_BAR; PG8_MMA(1, 0, At, B0); PG8_MMA(1, 1, At, B1); PG8_BAR; PG8_SCHED;
            PG8_LDB(B0, 1, 0); PG8_LDB(B1, 1, 1); PG8_SCHED; PG8_LDA(At, 1, 0); PG8_STAGE(PG8_SA(0, 1), a2 + hstep, voffA);
            PG8_WAIT_V(8); PG8_WAIT_L(0); PG8_BAR; PG8_MMA(0, 0, At, B0); PG8_MMA(0, 1, At, B1); PG8_BAR; PG8_SCHED;
            PG8_LDA(At, 1, 1); PG8_STAGE(PG8_SB(1, 0), b3, voffB); PG8_STAGE(PG8_SB(1, 1), b3 + hstep, voffB); PG8_STAGE(PG8_SA(1, 0), a3, voffA);
            PG8_WAIT_V(8); PG8_WAIT_L(0); PG8_BAR; PG8_MMA(1, 0, At, B0); PG8_MMA(1, 1, At, B1); PG8_BAR; PG8_SCHED;
            } else {
            PG8_LDB(B0, 0, 0); PG8_SCHED; PG8_LDA(At, 0, 0); PG8_STAGE(PG8_SA(1, 1), a1 + hstep, voffA);
            PG8_WAIT_L(8); PG8_BAR; PG8_WAIT_L(0); PG8_MMA(0, 0, At, B0); PG8_BAR; PG8_SCHED;
            PG8_LDB(B1, 0, 1); PG8_STAGE(PG8_SB(0, 0), b2, voffB);
            PG8_BAR; PG8_WAIT_L(0); PG8_MMA(0, 1, At, B1); PG8_BAR;
            PG8_LDA(At, 0, 1); PG8_STAGE(PG8_SA(0, 0), a2, voffA);
            PG8_BAR; PG8_WAIT_L(0); PG8_MMA(1, 0, At, B0); PG8_BAR; PG8_SCHED;
            PG8_STAGE(PG8_SB(0, 1), b2 + hstep, voffB);
            PG8_WAIT_V(6); PG8_BAR; PG8_MMA(1, 1, At, B1); PG8_BAR;
            PG8_LDB(B0, 1, 0); PG8_SCHED; PG8_LDA(At, 1, 0); PG8_STAGE(PG8_SA(0, 1), a2 + hstep, voffA);
            PG8_WAIT_L(8); PG8_BAR; PG8_WAIT_L(0); PG8_MMA(0, 0, At, B0); PG8_BAR; PG8_SCHED;
            PG8_LDB(B1, 1, 1); PG8_STAGE(PG8_SB(1, 0), b3, voffB);
            PG8_BAR; PG8_WAIT_L(0); PG8_MMA(0, 1, At, B1); PG8_BAR;
            PG8_LDA(At, 1, 1); PG8_STAGE(PG8_SA(1, 0), a3, voffA);
            PG8_BAR; PG8_WAIT_L(0); PG8_MMA(1, 0, At, B0); PG8_BAR; PG8_SCHED;
            PG8_STAGE(PG8_SB(1, 1), b3 + hstep, voffB);
            PG8_WAIT_V(6); PG8_BAR; PG8_MMA(1, 1, At, B1); PG8_BAR;
            }
        }
        if constexpr (ALIGN_EPI) { if (wr == 0) PG8_BAR; }
        if constexpr (!Epi::AFTER_DRAIN) { E(acc, cur, wr, wc, fr, fq); S.done(cur); }
        if (!has_next) break;
#pragma unroll
        for (int a = 0; a < 2; ++a)
#pragma unroll
            for (int b = 0; b < 2; ++b)
#pragma unroll
                for (int m = 0; m < 4; ++m)
#pragma unroll
                    for (int n = 0; n < 2; ++n) acc[a][b][m][n] = (f32x4){0.f, 0.f, 0.f, 0.f};
        cur = nxt; cA = nA; cB = nB; ++ui;
        if constexpr (ALIGN_EPI) { if (wr == 1) PG8_BAR; }
    }
    PG8_WAIT_V(0);
    if constexpr (!ALIGN_EPI) { if (wr == 0) PG8_BAR; }
    PG8_BAR;
    if constexpr (Epi::AFTER_DRAIN) { E.fused(acc, cur, wr, wc, fr, fq, lds, wid, lane); S.done(cur); }
#undef PG8_SA
#undef PG8_SB
#undef PG8_STAGE
#undef PG8_LDA
#undef PG8_LDB
#undef PG8_MMA
#undef PG8_WAIT_V
#undef PG8_WAIT_L
#undef PG8_BAR
#undef PG8_SCHED
}
}
#ifndef CPU_EMU
#include <hip/hip_cooperative_groups.h>
#include <cstdio>
namespace mk {
namespace cg = cooperative_groups;
using namespace cfg;
#define LAS __attribute__((address_space(3)))
#define GAS __attribute__((address_space(1)))
typedef float f32x4 __attribute__((ext_vector_type(4)));
typedef unsigned v4u __attribute__((ext_vector_type(4)));
typedef short bf16x8 __attribute__((ext_vector_type(8)));
constexpr int NWAVES = 8, NTHREADS = NWAVES * 64;
constexpr int LDS_BYTES = 163840;
#ifndef MK_EMBED_NB
#define MK_EMBED_NB 1
#endif
enum Phase { P_PRO = 0, P_FFN1A, P_FFN1B, P_INPROJ, P_PREP, P_MIXER, P_MERGE, P_OUTPROJ, P_FFN2A, P_FFN2B, P_FINAL, P_COUNT };

struct MArgs { const float* in[21]; float* out; unsigned char* ws; int ph_lo, ph_hi; };

__device__ __forceinline__ unsigned f2bf_u(float f) { unsigned u = __builtin_bit_cast(unsigned, f); return (u + 0x7fffu + ((u >> 16) & 1u)) >> 16; }
__device__ __forceinline__ unsigned pk2(float lo, float hi) { return f2bf_u(lo) | (f2bf_u(hi) << 16); }
__device__ __forceinline__ float wave_sum(float v) {
#pragma unroll
    for (int o = 1; o < 64; o <<= 1) v += __shfl_xor(v, o);
    return v;
}
__device__ __forceinline__ void transpose_item(const float* W, int ldw, int src_col0, bf16_t* WT, int K, int dst_row0, int nvalid, const float* kscale, LAS float* scr, int k0, int lane) {
#pragma unroll 8
    for (int i = 0; i < 32; ++i) { const int kk = 2 * i + (lane >> 5); float v = W[(size_t)(k0 + kk) * ldw + src_col0 + (lane & 31)]; if (kscale) v *= kscale[k0 + kk]; scr[kk * 33 + (lane & 31)] = v; }
    asm volatile("s_waitcnt lgkmcnt(0)" ::: "memory");
    const int c = lane & 7;
#pragma unroll
    for (int j = 0; j < 4; ++j) { const int n = (lane >> 3) + 8 * j; const LAS float* s = scr + (8 * c) * 33 + n;
        v4u o; o.x = pk2(s[0 * 33], s[1 * 33]); o.y = pk2(s[2 * 33], s[3 * 33]); o.z = pk2(s[4 * 33], s[5 * 33]); o.w = pk2(s[6 * 33], s[7 * 33]);
        if (n < nvalid) *(v4u*)(WT + (size_t)(dst_row0 + n) * K + k0 + 8 * c) = o; }
    asm volatile("s_waitcnt lgkmcnt(0)" ::: "memory");
}
struct Frame {
    LAS unsigned char* lds; int tid, lane, wave, G;
    const float* const* in; float* out; unsigned char* ws;
};
#define FB(off) ((bf16_t*)(F.ws + lay::off))
#define FF32(off) ((float*)(F.ws + lay::off))
enum { I_XP = 0, I_XS, I_SCONV, I_SGDN, I_CK, I_CV, I_NF1, I_W1IN, I_W1OUT, I_NMIX, I_WIN, I_CONVW, I_ALOG, I_DTB, I_GNORM, I_SINKS, I_WOUT, I_NF2, I_W2IN, I_W2OUT, I_NFIN };

#define XB_TMO      128
#define XB_XCNT(j)  (256  + 64 * (j))
#define XB_XSUB(j)  (1280 + 64 * (j))
#define XB_XGEN(j)  (2304 + 64 * (j))
#define XB_TOP      3328
#define XB_TOPGEN   3392
#define XCD_BAR_WORDS 3456
#define XB_SPIN_CAP (1u << 18)

__device__ __forceinline__ unsigned xb_ld(unsigned* p)              { return __hip_atomic_load(p, __ATOMIC_RELAXED, __HIP_MEMORY_SCOPE_AGENT); }
__device__ __forceinline__ unsigned xb_add(unsigned* p, unsigned v) { return __hip_atomic_fetch_add(p, v, __ATOMIC_RELAXED, __HIP_MEMORY_SCOPE_AGENT); }
__device__ __forceinline__ unsigned xb_xcc_id() { return (unsigned)__builtin_amdgcn_s_getreg((3 << 11) | 20) & 0xFu; }
#define XB_SPIN(cond, bar) do { unsigned _sp = 0; while (cond) { __builtin_amdgcn_s_sleep(1); \
    if ((++_sp & 255u) == 0u) { if (xb_ld(&(bar)[XB_TMO])) break; if (_sp > XB_SPIN_CAP) { atomicAdd(&(bar)[XB_TMO], 1u); break; } } } } while (0)

struct XcdBarrier {
    unsigned* bar; unsigned x;
    volatile LAS unsigned* st;
};

__device__ __forceinline__ XcdBarrier xcd_barrier_post(unsigned* bar, volatile LAS unsigned* st) {
    XcdBarrier b; b.bar = bar; b.x = xb_xcc_id(); b.st = st;
    if (threadIdx.x == 0) (void)xb_add(&bar[XB_XCNT(b.x)], 1u);
    return b;
}
__device__ __forceinline__ void xcd_barrier_complete(unsigned* bar, unsigned x, unsigned& nloc, unsigned& nx) {
    const unsigned G = gridDim.x * gridDim.y * gridDim.z;
    unsigned sum, cnt, mine, sp = 0u;
    for (;;) {
        sum = 0u; cnt = 0u; mine = 0u;
#pragma unroll
        for (unsigned j = 0; j < 16; ++j) { const unsigned c = xb_ld(&bar[XB_XCNT(j)]); sum += c; cnt += (c > 0u) ? 1u : 0u; mine = (j == x) ? c : mine; }
        if (sum == G) break;
        __builtin_amdgcn_s_sleep(1);
        if ((++sp & 255u) == 0u) { if (xb_ld(&bar[XB_TMO])) break; if (sp > XB_SPIN_CAP) { atomicAdd(&bar[XB_TMO], 1u); break; } }
    }
    nloc = mine > 0u ? mine : 1u; nx = cnt > 0u ? cnt : 1u;
}

__device__ __forceinline__ void xcd_barrier(const XcdBarrier& b) {
    asm volatile("s_waitcnt vmcnt(0)" ::: "memory");
    __syncthreads();
    if (threadIdx.x == 0) {
        unsigned* bar = b.bar;
        __builtin_amdgcn_s_waitcnt(0);
        unsigned nloc = b.st[0], nx = b.st[1];
        if (nloc == 0u) { xcd_barrier_complete(bar, b.x, nloc, nx); b.st[0] = nloc; b.st[1] = nx; }
        const unsigned old = xb_add(&bar[XB_XSUB(b.x)], 1u);
        const unsigned gen = old / nloc;
        if (old + 1u == (gen + 1u) * nloc) {
            __builtin_amdgcn_fence(__ATOMIC_RELEASE, "agent");
            asm volatile("s_waitcnt vmcnt(0)" ::: "memory");
            const unsigned og = xb_add(&bar[XB_TOP], 1u);
            const unsigned tg = og / nx;
            if (og + 1u == (tg + 1u) * nx) xb_add(&bar[XB_TOPGEN], 1u);
            else XB_SPIN(xb_ld(&bar[XB_TOPGEN]) == tg, bar);
            __builtin_amdgcn_fence(__ATOMIC_ACQUIRE, "agent");
            xb_add(&bar[XB_XGEN(b.x)], 1u);
            asm volatile("s_waitcnt vmcnt(0)" ::: "memory");
        } else {
            XB_SPIN(xb_ld(&bar[XB_XGEN(b.x)]) == gen, bar);
            __builtin_amdgcn_fence(__ATOMIC_ACQUIRE, "agent");
            asm volatile("s_waitcnt vmcnt(0)" ::: "memory");
        }
    }
    __syncthreads();
}

constexpr int XB_LDS_OFF = LDS_BYTES - 64;

__device__ __forceinline__ void p0_prologue(Frame& F) {
    LAS float* scr = (LAS float*)(F.lds + F.wave * 16384);
    const int gw = blockIdx.x * NWAVES + F.wave, NGW = F.G * NWAVES;
    constexpr int KB1 = D / 64, KB2 = FF / 64;
    constexpr int N_W1IN = KB1 * (2 * FF / 32), N_W1OUT = KB2 * (D / 32), N_WIN = KB1 * (7680 / 32), N_WAB = KB1, N_WOUT = KB1 * (D / 32);
    constexpr int NITEMS = 2 * N_W1IN + 2 * N_W1OUT + N_WIN + N_WAB + N_WOUT;
    for (int it = gw; it < NITEMS; it += NGW) {
        int r = it;
        if (r < 2 * N_W1IN) {
            const int second = r >= N_W1IN; if (second) r -= N_W1IN;
            const int nbs = 2 * FF / 32, kb = r / nbs, nb = r % nbs, pn = nb >> 3, bj = (nb >> 2) & 1, wi = nb & 3;
            transpose_item(F.in[second ? I_W2IN : I_W1IN], 2 * FF, bj * FF + pn * 128 + wi * 32, second ? FB(WS_W2IN) : FB(WS_W1IN), D, nb * 32, 32, second ? F.in[I_NF2] : nullptr, scr, kb * 64, F.lane);
            continue; }
        r -= 2 * N_W1IN;
        if (r < 2 * N_W1OUT) {
            const int second = r >= N_W1OUT; if (second) r -= N_W1OUT;
            const int nbs = D / 32, kb = r / nbs, nb = r % nbs;
            transpose_item(F.in[second ? I_W2OUT : I_W1OUT], D, nb * 32, second ? FB(WS_W2OUT) : FB(WS_W1OUT), FF, nb * 32, 32, nullptr, scr, kb * 64, F.lane);
            continue; }
        r -= 2 * N_W1OUT;
        if (r < N_WIN) {
            const int nbs = 7680 / 32, kb = r / nbs, nb = r % nbs, drow = nb * 32;
            transpose_item(F.in[I_WIN], DIN, drow + (drow >= 4096 ? 16 : 0), FB(WS_WIN), D, drow, 32, F.in[I_NMIX], scr, kb * 64, F.lane);
            continue; }
        r -= N_WIN;
        if (r < N_WAB) { transpose_item(F.in[I_WIN], DIN, 4096, FB(WS_WAB), D, 0, 16, F.in[I_NMIX], scr, r * 64, F.lane); continue; }
        r -= N_WAB;
        { const int nbs = D / 32, kb = r / nbs, nb = r % nbs; transpose_item(F.in[I_WOUT], D, nb * 32, FB(WS_WOUT), D, nb * 32, 32, nullptr, scr, kb * 64, F.lane); }
    }
    const float* nw = F.in[I_NF1];
    f32x4 wv[4];
#pragma unroll
    for (int j = 0; j < 4; ++j) wv[j] = *(const f32x4*)(nw + 4 * F.lane + 256 * j);
    for (int m = gw; m < M; m += NGW) {
        const float* xr = (m < MP ? F.in[I_XP] + (size_t)m * D : F.in[I_XS] + (size_t)(m - MP) * D) + 4 * F.lane;
        f32x4 v[4]; float s = 0.f;
#pragma unroll
        for (int j = 0; j < 4; ++j) { v[j] = *(const f32x4*)(xr + 256 * j); s += (v[j][0] * v[j][0] + v[j][1] * v[j][1]) + (v[j][2] * v[j][2] + v[j][3] * v[j][3]); }
        const float rs = 1.0f / sqrtf(wave_sum(s) * (1.0f / D) + EPS);
        unsigned long long* o8 = (unsigned long long*)(FB(WS_XN1) + (size_t)m * D) + F.lane;
#pragma unroll
        for (int j = 0; j < 4; ++j) { const f32x4 o = v[j] * rs * wv[j]; o8[64 * j] = (unsigned long long)pk2(o[0], o[1]) | ((unsigned long long)pk2(o[2], o[3]) << 32); }
    }
}
__device__ __forceinline__ void ab_tiles(Frame& F) {
    const int gw = blockIdx.x * NWAVES + F.wave, NGW = F.G * NWAVES; const int lane = F.lane, q = lane >> 4, c = lane & 15;
    const bf16_t* x1b = FB(WS_X1B); const bf16_t* wab = FB(WS_WAB); const float* ssq = FF32(WS_SSQ1); float* AB = FF32(WS_AB);
    for (int tile = gw; tile < M / 16; tile += NGW) {
        f32x4 acc = {0.f, 0.f, 0.f, 0.f};
        const bf16_t* ap = x1b + (size_t)(tile * 16 + c) * D + 8 * q; const bf16_t* bp = wab + (size_t)c * D + 8 * q;
#pragma unroll 8
        for (int s = 0; s < D / 32; ++s) { const bf16x8 a = *(const bf16x8*)(ap + 32 * s), b = *(const bf16x8*)(bp + 32 * s); acc = __builtin_amdgcn_mfma_f32_16x16x32_bf16(a, b, acc, 0, 0, 0); }
#pragma unroll
        for (int r = 0; r < 4; ++r) { const int row = tile * 16 + 4 * q + r; const float* sp = ssq + (size_t)row * 16;
            float s = 0.f;
#pragma unroll
            for (int i = 0; i < 4; ++i) { const f32x4 v = *(const f32x4*)(sp + 4 * i); s += (v[0] + v[1]) + (v[2] + v[3]); }
            AB[(size_t)row * 16 + c] = acc[r] * (1.0f / sqrtf(s * (1.0f / D) + EPS)); }
    }
}
__device__ __forceinline__ void final_norm(Frame& F) {
    const int gw = blockIdx.x * NWAVES + F.wave, NGW = F.G * NWAVES; const float* nw = F.in[I_NFIN];
    f32x4 wv[4];
#pragma unroll
    for (int j = 0; j < 4; ++j) wv[j] = *(const f32x4*)(nw + 4 * F.lane + 256 * j);
    for (int m = gw; m < M; m += NGW) {
        float* xr = F.out + O_YP + (size_t)m * D + 4 * F.lane;
        f32x4 v[4]; float s = 0.f;
#pragma unroll
        for (int j = 0; j < 4; ++j) { v[j] = *(const f32x4*)(xr + 256 * j); s += (v[j][0] * v[j][0] + v[j][1] * v[j][1]) + (v[j][2] * v[j][2] + v[j][3] * v[j][3]); }
        const float rs = 1.0f / sqrtf(wave_sum(s) * (1.0f / D) + EPS);
#pragma unroll
        for (int j = 0; j < 4; ++j) *(f32x4*)(xr + 256 * j) = v[j] * rs * wv[j];
    }
}

struct Gdn2 {
    static __device__ __forceinline__ void run(long g, const float* AB, const bf16_t* QKV, const float* state_gdn, const float* a_log, const float* dt_bias,
                        bf16_t* OG, float* out_gp, float* out_gs) {
        using namespace nv;
        const int half = (int)(g & 1); const long col = g >> 1;
        const int dv = (int)(col % DV); const int h = (int)((col / DV) % H); const int sq = (int)(col / (DV * H));
        const int is_s = sq >= BATCH; const int seq = is_s ? sq - BATCH : sq; const int L = is_s ? DS : SEQ;
        const long base = is_s ? MP + (long)seq * DS : (long)seq * SEQ;
        float S[64];
#pragma unroll
        for (int j = 0; j < 64; ++j) S[j] = is_s ? state_gdn[(((long)seq * H + h) * DK + 64 * half + j) * DV + dv] : 0.f;
        const float ea = expf(a_log[h]), dtb = dt_bias[h];
        for (int t = 0; t < L; ++t) {
            const long r = base + t;
            const float a = AB[r * 16 + h], b = AB[r * 16 + 8 + h];
            const float gg = -ea * softplus_f(a + dtb), beta = sigmoid_f(b), alpha = expf(gg);
            const bf16_t* q = QKV + r * CONV + h * DK + 64 * half; const bf16_t* k = QKV + r * CONV + 1024 + h * DK + 64 * half;
            const float v = bf2f(QKV[r * CONV + 2048 + h * DV + dv]);
            float ks = 0.f;
#pragma unroll
            for (int j = 0; j < 64; ++j) ks += bf2f(k[j]) * S[j];
            ks += __shfl_xor(ks, 1);
            const float vn = beta * (v - alpha * ks);
            float o = 0.f;
#pragma unroll
            for (int j = 0; j < 64; ++j) { S[j] = alpha * S[j] + bf2f(k[j]) * vn; o += bf2f(q[j]) * S[j]; }
            o += __shfl_xor(o, 1);
            if (half == 0) OG[r * 1024 + h * DV + dv] = f2bf(o * 0.08838834764831845f);
        }
        float* so = is_s ? out_gs : out_gp;
#pragma unroll
        for (int j = 0; j < 64; ++j) so[(((long)seq * H + h) * DK + 64 * half + j) * DV + dv] = S[j];
    }
};
namespace att {
typedef float f32x16 __attribute__((ext_vector_type(16)));
typedef unsigned u32x2 __attribute__((ext_vector_type(2)));
constexpr int KPB = 144;
constexpr int VPE = 196;
constexpr int NSLOT = 192;
constexpr int K_OFF = 0, V_OFF = NSLOT * KPB, BUF_BYTES = V_OFF + 64 * VPE * 2;
constexpr float LOG2E = 1.4426950408889634f;
__device__ __forceinline__ int crow(int r, int h) { return (r & 3) + 8 * (r >> 2) + 4 * h; }
__device__ __forceinline__ unsigned cvtpk(float lo, float hi) { unsigned r; asm volatile("v_cvt_pk_bf16_f32 %0, %1, %2" : "=v"(r) : "v"(lo), "v"(hi)); return r; }

__device__ __forceinline__ void attn_wave(const LAS unsigned char* Kl, const LAS unsigned char* Vl, const bf16x8 (&qf)[4], int kt0, int kpos0, int qpos, float sink, f32x16 (&o)[2], int lane) {
    const int r32 = lane & 31, h = lane >> 5;
    f32x16 S[5];
#pragma unroll
    for (int j = 0; j < 5; ++j) {
#pragma unroll
        for (int e = 0; e < 16; ++e) S[j][e] = 0.f;
        const LAS unsigned char* kp = Kl + (32 * (kt0 + j) + r32) * KPB + 16 * h;
#pragma unroll
        for (int s = 0; s < 4; ++s) { const bf16x8 a = *(const LAS bf16x8*)(kp + 32 * s); S[j] = __builtin_amdgcn_mfma_f32_32x32x16_bf16(a, qf[s], S[j], 0, 0, 0); }
    }
    const float sink2 = sink * LOG2E; float m = sink2;
    const int rel0 = qpos - kpos0 - 32 * kt0;
#pragma unroll
    for (int j = 0; j < 5; ++j)
#pragma unroll
        for (int e = 0; e < 16; ++e) { const int x = 32 * j + crow(e, h); const int rel = rel0 - x; const bool ok = (rel >= 0) && (rel <= 127) && (kpos0 + 32 * kt0 + x >= 0);
            const float v = ok ? S[j][e] * LOG2E : -INFINITY; S[j][e] = v; m = fmaxf(m, v); }
    m = fmaxf(m, __shfl_xor(m, 32));
    float l = 0.f;
#pragma unroll
    for (int j = 0; j < 5; ++j)
#pragma unroll
        for (int e = 0; e < 16; ++e) { const float p = __builtin_amdgcn_exp2f(S[j][e] - m); S[j][e] = p; l += p; }
    l += __shfl_xor(l, 32); l += __builtin_amdgcn_exp2f(sink2 - m);
    const float il = 1.0f / l;
#pragma unroll
    for (int mt = 0; mt < 2; ++mt) {
#pragma unroll
        for (int e = 0; e < 16; ++e) o[mt][e] = 0.f;
        const LAS unsigned char* vp = Vl + ((32 * mt + r32) * VPE + 32 * kt0 + 4 * h) * 2;
#pragma unroll
        for (int j = 0; j < 5; ++j)
#pragma unroll
            for (int s = 0; s < 2; ++s) {
                const u32x2 lo = *(const LAS u32x2*)(vp + (32 * j + 16 * s) * 2), hi = *(const LAS u32x2*)(vp + (32 * j + 16 * s + 8) * 2);
                v4u av; av.x = lo.x; av.y = lo.y; av.z = hi.x; av.w = hi.y;
                v4u pv; pv.x = cvtpk(S[j][8 * s + 0], S[j][8 * s + 1]); pv.y = cvtpk(S[j][8 * s + 2], S[j][8 * s + 3]); pv.z = cvtpk(S[j][8 * s + 4], S[j][8 * s + 5]); pv.w = cvtpk(S[j][8 * s + 6], S[j][8 * s + 7]);
                o[mt] = __builtin_amdgcn_mfma_f32_32x32x16_bf16(__builtin_bit_cast(bf16x8, av), __builtin_bit_cast(bf16x8, pv), o[mt], 0, 0, 0);
            }
#pragma unroll
        for (int e = 0; e < 16; ++e) o[mt][e] *= il;
    }
}
__device__ __forceinline__ void load_q(bf16x8 (&qf)[4], const bf16_t* qrow, int h) {
#pragma unroll
    for (int s = 0; s < 4; ++s) { const v4u w = *(const v4u*)(qrow + 16 * s + 8 * h); v4u o;
#pragma unroll
        for (int i = 0; i < 4; ++i) { const float a = __builtin_bit_cast(float, w[i] << 16) * 0.125f, b = __builtin_bit_cast(float, w[i] & 0xffff0000u) * 0.125f;
            o[i] = (__builtin_bit_cast(unsigned, a) >> 16) | (__builtin_bit_cast(unsigned, b) & 0xffff0000u); }
        qf[s] = __builtin_bit_cast(bf16x8, o); }
}
__device__ __forceinline__ void store_o(const f32x16 (&o)[2], bf16_t* orow, int h) {
#pragma unroll
    for (int mt = 0; mt < 2; ++mt)
#pragma unroll
        for (int g4 = 0; g4 < 4; ++g4) { u32x2 w; w.x = cvtpk(o[mt][4 * g4 + 0], o[mt][4 * g4 + 1]); w.y = cvtpk(o[mt][4 * g4 + 2], o[mt][4 * g4 + 3]);
            *(u32x2*)(orow + 32 * mt + 8 * g4 + 4 * h) = w; }
}
__device__ __forceinline__ void put_kv(LAS unsigned char* Kl, LAS unsigned char* Vl, int i, int part, v4u kv, v4u vv) {
    *(LAS v4u*)(Kl + i * KPB + part * 16) = kv;
#pragma unroll
    for (int e = 0; e < 8; ++e) { const unsigned short val = (unsigned short)((vv[e >> 1] >> (16 * (e & 1))) & 0xffffu); *(LAS unsigned short*)(Vl + ((part * 8 + e) * VPE + i) * 2) = val; }
}
__device__ __forceinline__ void attn_phase(Frame& F, int wg, int nwg) {
    LAS unsigned char* Kl = F.lds + K_OFF; LAS unsigned char* Vl = F.lds + V_OFF;
    bf16_t* QS = FB(WS_QS); const bf16_t* KS = FB(WS_KS); const bf16_t* VS = FB(WS_VS);
    const int lane = F.lane, r32 = lane & 31, h = lane >> 5, w = F.wave;
    constexpr int NPU = BATCH * KVH * (SEQ / 64), NSU = DB * KVH;
    for (int u = wg; u < NPU + NSU; u += nwg) {
        if (u < NPU) {
            const int b = u / (KVH * (SEQ / 64)), kvh = (u / (SEQ / 64)) % KVH, q0 = (u % (SEQ / 64)) * 64;
            for (int c = F.tid; c < NSLOT * 8; c += NTHREADS) { const int i = c >> 3, part = c & 7, kpos = q0 - 128 + i;
                v4u kv = {0u, 0u, 0u, 0u}, vv = {0u, 0u, 0u, 0u};
                if (kpos >= 0) { const size_t off = ((size_t)b * SEQ + kpos) * 256 + kvh * 64 + part * 8; kv = *(const v4u*)(KS + off); vv = *(const v4u*)(VS + off); }
                put_kv(Kl, Vl, i, part, kv, vv); }
            const int head = kvh * 4 + (w >> 1), hf = w & 1; const size_t row = (size_t)b * SEQ + q0 + 32 * hf + r32;
            bf16x8 qf[4]; load_q(qf, QS + row * 1024 + head * 64, h);
            __syncthreads();
            f32x16 o[2]; attn_wave(Kl, Vl, qf, hf, q0 - 128, q0 + 32 * hf + r32, F.in[I_SINKS][head], o, lane);
            store_o(o, QS + row * 1024 + head * 64, h);
            __syncthreads();
        } else {
            const int su = u - NPU, b = su / KVH, kvh = su % KVH;
            const float* ck = F.in[I_CK]; const float* cv = F.in[I_CV];
            for (int c = F.tid; c < 160 * 8; c += NTHREADS) { const int i = c >> 3, part = c & 7;
                v4u kv = {0u, 0u, 0u, 0u}, vv = {0u, 0u, 0u, 0u};
                if (i < WIN) { const size_t off = (((size_t)b * WIN + i) * KVH + kvh) * HD + part * 8;
                    const f32x4 k0 = *(const f32x4*)(ck + off), k1 = *(const f32x4*)(ck + off + 4), v0 = *(const f32x4*)(cv + off), v1 = *(const f32x4*)(cv + off + 4);
                    kv.x = pk2(k0[0], k0[1]); kv.y = pk2(k0[2], k0[3]); kv.z = pk2(k1[0], k1[1]); kv.w = pk2(k1[2], k1[3]);
                    vv.x = pk2(v0[0], v0[1]); vv.y = pk2(v0[2], v0[3]); vv.z = pk2(v1[0], v1[1]); vv.w = pk2(v1[2], v1[3]); }
                else if (i < WIN + DS) { const size_t off = ((size_t)MP + (size_t)b * DS + (i - WIN)) * 256 + kvh * 64 + part * 8; kv = *(const v4u*)(KS + off); vv = *(const v4u*)(VS + off); }
                put_kv(Kl, Vl, i, part, kv, vv); }
            const int head = kvh * 4 + (r32 >> 3), t = r32 & 7; const size_t row = (size_t)MP + (size_t)b * DS + t;
            bf16x8 qf[4];
            if (w == 0) load_q(qf, QS + row * 1024 + head * 64, h);
            __syncthreads();
            if (w == 0) { f32x16 o[2]; attn_wave(Kl, Vl, qf, 0, PAST - WIN, PAST + t, F.in[I_SINKS][head], o, lane); store_o(o, QS + row * 1024 + head * 64, h); }
            __syncthreads();
        }
    }
}
}
namespace gdn {
typedef unsigned u32x2 __attribute__((ext_vector_type(2)));
constexpr int NCH = SEQ / 64, NU = BATCH * H * NCH;
constexpr size_t WKB = 16384, QKPB = 8192, UVB = 32768;
constexpr int TEAM_LDS = 81920, PK = 272;
constexpr int KB_OFF = 0, QB_OFF = 17408, VB_OFF = 34816, A_OFF = 52224, QKP_OFF = 68608, SM_OFF = 76800;
__device__ __forceinline__ int permpos(int j) { return (j & ~31) + 8 * ((j >> 2) & 3) + 4 * ((j >> 4) & 1) + (j & 3); }
__device__ __forceinline__ float bfl(unsigned w) { return __builtin_bit_cast(float, w << 16); }
__device__ __forceinline__ float bfh(unsigned w) { return __builtin_bit_cast(float, w & 0xffff0000u); }
__device__ __forceinline__ unsigned cvtpk(float lo, float hi) { unsigned r; asm volatile("v_cvt_pk_bf16_f32 %0, %1, %2" : "=v"(r) : "v"(lo), "v"(hi)); return r; }
__device__ __forceinline__ float silu_a(float x) { return x * __builtin_amdgcn_rcpf(1.0f + __builtin_amdgcn_exp2f(-1.4426950408889634f * x)); }

__device__ __forceinline__ void prep_phase(Frame& F) {
    const int team = F.tid >> 8, lt0 = F.tid & 255, tw = lt0 >> 6, lane = F.lane;
    LAS unsigned char* L = F.lds + team * TEAM_LDS;
    LAS float* sm = (LAS float*)(L + SM_OFF);
    LAS float* Am = (LAS float*)(L + A_OFF);
    const int tg = blockIdx.x * 2 + team, ntg = F.G * 2;
    const int rounds = (NU + ntg - 1) / ntg;
#pragma unroll 1
    for (int rd = 0; rd < rounds; ++rd) {
        int lt = lt0; asm volatile("" : "+v"(lt));
        unsigned char* wsb = F.ws; asm volatile("" : "+s"(wsb));
        const float* AB = (const float*)(wsb + lay::WS_AB);
        unsigned char* wkb = wsb + lay::WS_WK; unsigned char* qgb = wsb + lay::WS_QG; unsigned char* kgtb = wsb + lay::WS_KGT; unsigned char* qkpb = wsb + lay::WS_QKP;
        float* uvb = (float*)(wsb + lay::WS_UV); float* glb = (float*)(wsb + lay::WS_GL);
        const int uid = tg + rd * ntg; const bool act = uid < NU;
        const int n = uid % NCH, h = (uid / NCH) % H, b = uid / (NCH * H);
        const size_t r0 = (size_t)b * SEQ + (size_t)n * 64;
        if (act && tw == 0) {
            const float a = AB[(r0 + lane) * 16 + h], bb = AB[(r0 + lane) * 16 + 8 + h];
            const float xg = a + F.in[I_DTB][h]; const float sp = xg > 20.f ? xg : log1pf(expf(xg));
            float v = -expf(F.in[I_ALOG][h]) * sp;
#pragma unroll
            for (int d = 1; d < 64; d <<= 1) { const float t2 = __shfl_up(v, d); if (lane >= d) v += t2; }
            const float gl = __shfl(v, 63);
            sm[lane] = v; sm[64 + lane] = 1.0f / (1.0f + expf(-bb)); sm[128 + lane] = expf(v); sm[192 + lane] = expf(gl - v);
            if (lane == 0) glb[uid] = expf(gl);
        }
        { v4u z = {0u, 0u, 0u, 0u}; *(LAS v4u*)(L + QKP_OFF + lt * 32) = z; *(LAS v4u*)(L + QKP_OFF + lt * 32 + 16) = z; }
        if (act) {
#pragma unroll
            for (int k = 0; k < 12; ++k) { const int id = lt + 256 * k, mat = id >> 10, i = (id >> 4) & 63, part = id & 15;
                const bf16_t* src = (const bf16_t*)(wsb + (mat == 0 ? lay::WS_QN : mat == 1 ? lay::WS_KN : lay::WS_VN));
                const v4u w = *(const v4u*)(src + (r0 + i) * 1024 + h * 128 + part * 8);
                *(LAS v4u*)(L + (mat == 0 ? QB_OFF : mat == 1 ? KB_OFF : VB_OFF) + i * PK + part * 16) = w; }
        }
        __syncthreads();
        if (act) {
            const int c = lane & 15, q = lane >> 4;
#pragma unroll 1
            for (int job = tw; job < 20; job += 4) {
                const int mat = job / 10, tau = job % 10, ti = tau >= 6 ? 3 : tau >= 3 ? 2 : tau >= 1 ? 1 : 0, tj = tau - ti * (ti + 1) / 2;
                const LAS unsigned char* ap = L + (mat == 0 ? KB_OFF : QB_OFF) + (16 * ti + c) * PK + 16 * q; const LAS unsigned char* bp = L + KB_OFF + (16 * tj + c) * PK + 16 * q;
                f32x4 acc = {0.f, 0.f, 0.f, 0.f};
#pragma unroll
                for (int s = 0; s < 4; ++s) acc = __builtin_amdgcn_mfma_f32_16x16x32_bf16(*(const LAS bf16x8*)(ap + 64 * s), *(const LAS bf16x8*)(bp + 64 * s), acc, 0, 0, 0);
                const int j = 16 * tj + c; const float gcj = sm[j];
#pragma unroll
                for (int r = 0; r < 4; ++r) { const int i = 16 * ti + 4 * q + r; const float dec = expf(sm[i] - gcj);
                    if (mat == 0) Am[i * 64 + j] = (i > j) ? acc[r] * sm[64 + i] * dec : 0.f;
                    else *(LAS unsigned short*)(L + QKP_OFF + i * 128 + permpos(j) * 2) = (unsigned short)f2bf_u((i >= j) ? acc[r] * dec : 0.f); }
            }
        }
        __syncthreads();
        float x[64];
        if (act) {
            if (lt < 128) {
#pragma unroll
                for (int i = 0; i < 64; ++i) x[i] = bfl((unsigned)*(const LAS unsigned short*)(L + VB_OFF + i * PK + lt * 2)) * sm[64 + i];
            } else {
#pragma unroll
                for (int i = 0; i < 64; ++i) x[i] = bfl((unsigned)*(const LAS unsigned short*)(L + KB_OFF + i * PK + (lt - 128) * 2)) * sm[64 + i] * sm[128 + i];
            }
#pragma clang loop unroll(full)
            for (int i = 1; i < 64; ++i) {
                float acc = x[i];
#pragma clang loop unroll(full)
                for (int j4 = 0; j4 < 16; ++j4) if (4 * j4 < i) { const f32x4 a = *(const LAS f32x4*)(Am + i * 64 + 4 * j4);
                    acc -= a[0] * x[4 * j4]; if (4 * j4 + 1 < i) acc -= a[1] * x[4 * j4 + 1]; if (4 * j4 + 2 < i) acc -= a[2] * x[4 * j4 + 2]; if (4 * j4 + 3 < i) acc -= a[3] * x[4 * j4 + 3]; }
                x[i] = acc;
            }
        }
        __syncthreads();
        const int lo_ = lt;
        if (act) {
            if (lt < 128) {
                float* up = uvb + (size_t)uid * (UVB / 4) + (size_t)((lo_ >> 4) * 4) * 256 + (lo_ & 15) * 4;
#pragma unroll
                for (int mt = 0; mt < 4; ++mt)
#pragma unroll
                    for (int q = 0; q < 4; ++q) { f32x4 o = {x[16 * mt + 4 * q], x[16 * mt + 4 * q + 1], x[16 * mt + 4 * q + 2], x[16 * mt + 4 * q + 3]}; *(f32x4*)(up + mt * 256 + q * 64) = o; }
            } else {
#pragma unroll
                for (int i = 0; i < 64; ++i) *(LAS unsigned short*)(L + VB_OFF + i * PK + (lo_ - 128) * 2) = (unsigned short)f2bf_u(x[i]);
            }
        }
        __syncthreads();
        if (act) {
#pragma unroll
            for (int k = 0; k < 4; ++k) { const int id = lo_ + 256 * k, i = id >> 4, s = (id >> 2) & 3, q = id & 3;
                { const LAS unsigned char* p = L + VB_OFF + i * PK + (32 * s + 4 * q) * 2; const u32x2 lo = *(const LAS u32x2*)p, hi = *(const LAS u32x2*)(p + 32);
                  v4u o; o.x = lo.x; o.y = lo.y; o.z = hi.x; o.w = hi.y; *(v4u*)(wkb + (size_t)uid * WKB + (size_t)id * 16) = o; }
                { const LAS unsigned char* p = L + QB_OFF + i * PK + (32 * s + 4 * q) * 2; const u32x2 lo = *(const LAS u32x2*)p, hi = *(const LAS u32x2*)(p + 32); const float e = sm[128 + i];
                  v4u o; o.x = cvtpk(bfl(lo.x) * e, bfh(lo.x) * e); o.y = cvtpk(bfl(lo.y) * e, bfh(lo.y) * e); o.z = cvtpk(bfl(hi.x) * e, bfh(hi.x) * e); o.w = cvtpk(bfl(hi.y) * e, bfh(hi.y) * e);
                  *(v4u*)(qgb + (size_t)uid * WKB + (size_t)id * 16) = o; }
            }
#pragma unroll
            for (int k = 0; k < 4; ++k) { const int id = lo_ + 256 * k, dk = id >> 3, s = (id >> 2) & 1, q = id & 3; float v[8];
#pragma unroll
                for (int j = 0; j < 8; ++j) { const int tok = 32 * s + 16 * (j >> 2) + 4 * q + (j & 3); v[j] = bfl((unsigned)*(const LAS unsigned short*)(L + KB_OFF + tok * PK + dk * 2)) * sm[192 + tok]; }
                v4u o; o.x = cvtpk(v[0], v[1]); o.y = cvtpk(v[2], v[3]); o.z = cvtpk(v[4], v[5]); o.w = cvtpk(v[6], v[7]);
                *(v4u*)(kgtb + (size_t)uid * WKB + (size_t)id * 16) = o; }
#pragma unroll
            for (int k = 0; k < 2; ++k) { const int id = lo_ + 256 * k; *(v4u*)(qkpb + (size_t)uid * QKPB + (size_t)id * 16) = *(const LAS v4u*)(L + QKP_OFF + id * 16); }
        }
        __syncthreads();
    }
}

constexpr int SC_WK = 0, SC_QG = 17408, SC_KGT = 34816, SC_QKP = 34816 + 18432, SC_BUF = SC_QKP + 9216;
__device__ __forceinline__ void scan_phase(Frame& F, int blk) {
#define SCBAR() __syncthreads()
    const int lane = F.lane, w = F.wave, c = lane & 15, q = lane >> 4;
    const int bh = blk >> 1, dvh = blk & 1, b = bh / H, h = bh % H, uid0 = bh * NCH;
    const unsigned char* wkb = F.ws + lay::WS_WK; const unsigned char* qgb = F.ws + lay::WS_QG; const unsigned char* kgtb = F.ws + lay::WS_KGT; const unsigned char* qkpb = F.ws + lay::WS_QKP;
    if (w >= 4) {
        const int lt = F.tid - 256;
        v4u sa[14], sb[14];
#define LD_LOAD(dstv, uid) do { _Pragma("unroll") for (int k = 0; k < 14; ++k) { const int g = lt + 256 * k; const unsigned char* src = g < 1024 ? wkb + (size_t)(uid) * WKB + (size_t)g * 16 : g < 2048 ? qgb + (size_t)(uid) * WKB + (size_t)(g - 1024) * 16 \
        : g < 3072 ? kgtb + (size_t)(uid) * WKB + (size_t)(g - 2048) * 16 : qkpb + (size_t)(uid) * QKPB + (size_t)(g - 3072) * 16; dstv[k] = *(const v4u*)src; } } while (0)
#define LD_WRITE(srcv, buf) do { _Pragma("unroll") for (int k = 0; k < 14; ++k) { const int g = lt + 256 * k; int off; \
        if (g < 1024) off = SC_WK + (g >> 4) * PK + (g & 15) * 16; else if (g < 2048) off = SC_QG + ((g - 1024) >> 4) * PK + (g & 15) * 16; \
        else if (g < 3072) off = SC_KGT + ((g - 2048) >> 3) * 144 + (g & 7) * 16; else off = SC_QKP + ((g - 3072) >> 3) * 144 + (g & 7) * 16; \
        *(LAS v4u*)(F.lds + (buf) * SC_BUF + off) = srcv[k]; } } while (0)
        LD_LOAD(sa, uid0); LD_LOAD(sb, uid0 + 1);
        LD_WRITE(sa, 0);
        SCBAR();
        for (int n = 0; n < NCH; n += 2) {
            LD_WRITE(sb, 1); if (n + 2 < NCH) LD_LOAD(sa, uid0 + n + 2);
            SCBAR();
            if (n + 2 < NCH) LD_WRITE(sa, 0);
            if (n + 3 < NCH) LD_LOAD(sb, uid0 + n + 3);
            SCBAR();
        }
#undef LD_LOAD
#undef LD_WRITE
        return;
    }
    const float* uvb = (const float*)(F.ws + lay::WS_UV); const float* glb = (const float*)(F.ws + lay::WS_GL);
    bf16_t* OG = FB(WS_OG);
    const int dvw = 4 * dvh + w;
    f32x4 Sacc[8]; bf16x8 Sb[4];
#pragma unroll
    for (int i = 0; i < 8; ++i) Sacc[i] = (f32x4){0.f, 0.f, 0.f, 0.f};
#pragma unroll
    for (int i = 0; i < 4; ++i) Sb[i] = (bf16x8){0, 0, 0, 0, 0, 0, 0, 0};
    f32x4 un[4]; float gln;
#define UV_LOAD(dstv, dstg, uid) do { _Pragma("unroll") for (int mt = 0; mt < 4; ++mt) dstv[mt] = *(const f32x4*)(uvb + (size_t)(uid) * (UVB / 4) + (size_t)((dvw * 4 + mt) * 64 + lane) * 4); dstg = glb[(uid)]; } while (0)
    UV_LOAD(un, gln, uid0);
    SCBAR();
#define SB_ __builtin_amdgcn_sched_barrier(0)
#define MF_(a_, b_, c_) __builtin_amdgcn_mfma_f32_16x16x32_bf16(a_, b_, c_, 0, 0, 0)
#define LDROWS(dst, off_, pitch_, r0_) do { _Pragma("unroll") for (int i_ = 0; i_ < 2; ++i_) _Pragma("unroll") for (int s_ = 0; s_ < 4; ++s_) dst[4 * i_ + s_] = *(const LAS bf16x8*)(B + (off_) + (16 * ((r0_) + i_) + c) * (pitch_) + 16 * q + 64 * s_); } while (0)
#define LDROWS2(dst, off_, r0_) do { _Pragma("unroll") for (int i_ = 0; i_ < 4; ++i_) _Pragma("unroll") for (int s_ = 0; s_ < 2; ++s_) dst[2 * i_ + s_] = *(const LAS bf16x8*)(B + (off_) + (16 * ((r0_) + i_) + c) * 144 + 16 * q + 64 * s_); } while (0)
#define SC_CHUNK(n_, uc, gl_) do { \
        const LAS unsigned char* B = F.lds + ((n_) & 1) * SC_BUF; \
        bf16x8 fa[8], fb[8]; f32x4 vn[4], o[4]; const f32x4 z4 = {0.f, 0.f, 0.f, 0.f}; \
        LDROWS(fa, SC_WK, PK, 0); LDROWS(fb, SC_WK, PK, 2); SB_; \
        { f32x4 r0 = z4, r1 = z4; _Pragma("unroll") for (int s = 0; s < 4; ++s) { r0 = MF_(fa[s], Sb[s], r0); r1 = MF_(fa[4 + s], Sb[s], r1); } vn[0] = uc[0] - r0; vn[1] = uc[1] - r1; } \
        LDROWS(fa, SC_QG, PK, 0); SB_; \
        { f32x4 r0 = z4, r1 = z4; _Pragma("unroll") for (int s = 0; s < 4; ++s) { r0 = MF_(fb[s], Sb[s], r0); r1 = MF_(fb[4 + s], Sb[s], r1); } vn[2] = uc[2] - r0; vn[3] = uc[3] - r1; } \
        LDROWS(fb, SC_QG, PK, 2); SB_; \
        bf16x8 Vb[2]; \
        _Pragma("unroll") for (int s = 0; s < 2; ++s) { v4u p; p.x = cvtpk(vn[2 * s][0], vn[2 * s][1]); p.y = cvtpk(vn[2 * s][2], vn[2 * s][3]); p.z = cvtpk(vn[2 * s + 1][0], vn[2 * s + 1][1]); p.w = cvtpk(vn[2 * s + 1][2], vn[2 * s + 1][3]); Vb[s] = __builtin_bit_cast(bf16x8, p); } \
        { f32x4 r0 = z4, r1 = z4; _Pragma("unroll") for (int s = 0; s < 4; ++s) { r0 = MF_(fa[s], Sb[s], r0); r1 = MF_(fa[4 + s], Sb[s], r1); } o[0] = r0; o[1] = r1; } \
        LDROWS2(fa, SC_QKP, 0); SB_; \
        { f32x4 r0 = z4, r1 = z4; _Pragma("unroll") for (int s = 0; s < 4; ++s) { r0 = MF_(fb[s], Sb[s], r0); r1 = MF_(fb[4 + s], Sb[s], r1); } o[2] = r0; o[3] = r1; } \
        LDROWS2(fb, SC_KGT, 0); SB_; \
        _Pragma("unroll") for (int mt = 0; mt < 4; ++mt) { o[mt] = MF_(fa[2 * mt], Vb[0], o[mt]); o[mt] = MF_(fa[2 * mt + 1], Vb[1], o[mt]); } \
        LDROWS2(fa, SC_KGT, 4); SB_; \
        _Pragma("unroll") for (int dt = 0; dt < 4; ++dt) { f32x4 a = Sacc[dt] * (gl_); a = MF_(fb[2 * dt], Vb[0], a); a = MF_(fb[2 * dt + 1], Vb[1], a); Sacc[dt] = a; } \
        _Pragma("unroll") for (int mt = 0; mt < 4; ++mt) { bf16_t* op = OG + ((size_t)b * SEQ + (size_t)(n_) * 64 + 16 * mt + 4 * q) * 1024 + h * 128 + 16 * dvw + c; \
            _Pragma("unroll") for (int r = 0; r < 4; ++r) op[(size_t)r * 1024] = (bf16_t)f2bf_u(o[mt][r]); } \
        SB_; \
        _Pragma("unroll") for (int dt = 4; dt < 8; ++dt) { f32x4 a = Sacc[dt] * (gl_); a = MF_(fa[2 * (dt - 4)], Vb[0], a); a = MF_(fa[2 * (dt - 4) + 1], Vb[1], a); Sacc[dt] = a; } \
        _Pragma("unroll") for (int s = 0; s < 4; ++s) { v4u p; p.x = cvtpk(Sacc[2 * s][0], Sacc[2 * s][1]); p.y = cvtpk(Sacc[2 * s][2], Sacc[2 * s][3]); p.z = cvtpk(Sacc[2 * s + 1][0], Sacc[2 * s + 1][1]); p.w = cvtpk(Sacc[2 * s + 1][2], Sacc[2 * s + 1][3]); Sb[s] = __builtin_bit_cast(bf16x8, p); } \
    } while (0)
#pragma unroll 1
    for (int n = 0; n < NCH; ++n) {
        f32x4 u[4]; _Pragma("unroll") for (int mt = 0; mt < 4; ++mt) u[mt] = un[mt]; const float gl = gln;
        if (n + 1 < NCH) UV_LOAD(un, gln, uid0 + n + 1);
        SC_CHUNK(n, u, gl);
        SCBAR();
    }
#undef SC_CHUNK
#undef SCBAR
#undef UV_LOAD
#undef LDROWS
#undef LDROWS2
#undef MF_
#undef SB_
    float* so = F.out + O_GP + ((size_t)(b * H + h) * DK) * DV + 16 * dvw + c;
#pragma unroll
    for (int dt = 0; dt < 8; ++dt)
#pragma unroll
        for (int r = 0; r < 4; ++r) so[(size_t)(16 * dt + 4 * q + r) * DV] = Sacc[dt][r];
}

__device__ __forceinline__ void sample_qkv(Frame& F) {
    const int gw = blockIdx.x * NWAVES + F.wave, NGW = F.G * NWAVES, lane = F.lane;
    const bf16_t* RAW = FB(WS_RAW); bf16_t* QKVS = FB(WS_QKVS); const float* sc = F.in[I_SCONV]; const float* conv_w = F.in[I_CONVW];
    for (int task = gw; task < DB * 24; task += NGW) {
        const int b = task / 24, hm = task % 24, col = hm * 128 + 2 * lane;
        float w0[4], w1[4], e0[3], e1[3];
#pragma unroll
        for (int j = 0; j < 4; ++j) { w0[j] = conv_w[j * CONV + col]; w1[j] = conv_w[j * CONV + col + 1]; }
#pragma unroll
        for (int j = 0; j < 3; ++j) { e0[j] = sc[((size_t)b * 3 + j) * CONV + col]; e1[j] = sc[((size_t)b * 3 + j) * CONV + col + 1]; }
        for (int t = 0; t < DS; ++t) {
            const unsigned rw = *(const unsigned*)(RAW + ((size_t)MP + (size_t)b * DS + t) * CONV + col);
            const float c0 = bfl(rw), c1 = bfh(rw);
            float v0 = silu_a(w0[0] * e0[0] + w0[1] * e0[1] + w0[2] * e0[2] + w0[3] * c0), v1 = silu_a(w1[0] * e1[0] + w1[1] * e1[1] + w1[2] * e1[2] + w1[3] * c1);
            e0[0] = e0[1]; e0[1] = e0[2]; e0[2] = c0; e1[0] = e1[1]; e1[1] = e1[2]; e1[2] = c1;
            if (hm < 16) { const float rs = 1.0f / sqrtf(wave_sum(v0 * v0 + v1 * v1) + EPS); v0 *= rs; v1 *= rs; }
            *(unsigned*)(QKVS + ((size_t)b * DS + t) * CONV + col) = cvtpk(v0, v1);
        }
    }
}
__device__ __forceinline__ void qkvn_pass(Frame& F) {
    const int gw = blockIdx.x * NWAVES + F.wave, NGW = F.G * NWAVES, lane = F.lane;
    const bf16_t* RAW = FB(WS_RAW); const float* conv_w = F.in[I_CONVW];
    for (int task = gw; task < BATCH * 24 * NCH; task += NGW) {
        const int st = task % NCH, hm = (task / NCH) % 24, b = task / (NCH * 24), col = hm * 128 + 2 * lane, mat = hm >> 3;
        bf16_t* dst = (mat == 0 ? FB(WS_QN) : mat == 1 ? FB(WS_KN) : FB(WS_VN)) + (hm & 7) * 128 + 2 * lane;
        float w0[4], w1[4], e0[3], e1[3];
#pragma unroll
        for (int j = 0; j < 4; ++j) { w0[j] = conv_w[j * CONV + col]; w1[j] = conv_w[j * CONV + col + 1]; }
        const size_t rb = (size_t)b * SEQ; const int t0 = st * 64;
#pragma unroll
        for (int j = 0; j < 3; ++j) { const int t = t0 - 3 + j; unsigned rw = 0u; if (t >= 0) rw = *(const unsigned*)(RAW + (rb + t) * CONV + col); e0[j] = bfl(rw); e1[j] = bfh(rw); }
#pragma unroll 1
        for (int tb = t0; tb < t0 + 64; tb += 8) {
            unsigned rw[8]; float v0[8], v1[8], ss[8];
#pragma unroll
            for (int i = 0; i < 8; ++i) rw[i] = *(const unsigned*)(RAW + (rb + tb + i) * CONV + col);
#pragma unroll
            for (int i = 0; i < 8; ++i) { const float c0 = bfl(rw[i]), c1 = bfh(rw[i]);
                v0[i] = silu_a(w0[0] * e0[0] + w0[1] * e0[1] + w0[2] * e0[2] + w0[3] * c0); v1[i] = silu_a(w1[0] * e1[0] + w1[1] * e1[1] + w1[2] * e1[2] + w1[3] * c1);
                e0[0] = e0[1]; e0[1] = e0[2]; e0[2] = c0; e1[0] = e1[1]; e1[1] = e1[2]; e1[2] = c1; ss[i] = v0[i] * v0[i] + v1[i] * v1[i]; }
            if (mat < 2) {
#pragma unroll
                for (int d = 1; d < 64; d <<= 1)
#pragma unroll
                    for (int i = 0; i < 8; ++i) ss[i] += __shfl_xor(ss[i], d);
#pragma unroll
                for (int i = 0; i < 8; ++i) { float rs = 1.0f / sqrtf(ss[i] + EPS); if (mat == 0) rs *= 0.08838834764831845f; v0[i] *= rs; v1[i] *= rs; }
            }
#pragma unroll
            for (int i = 0; i < 8; ++i) *(unsigned*)(dst + (rb + tb + i) * 1024) = cvtpk(v0[i], v1[i]);
        }
    }
}
__device__ __forceinline__ void merge_phase(Frame& F) {
    const int gw = blockIdx.x * NWAVES + F.wave, NGW = F.G * NWAVES, lane = F.lane;
    const bf16_t* OGp = FB(WS_OG); const bf16_t* OSp = FB(WS_OS); const bf16_t* Zp = FB(WS_Z); bf16_t* GAp = FB(WS_GA); const bf16_t* GBp = FB(WS_GB);
    float gn[16];
#pragma unroll
    for (int i = 0; i < 4; ++i) { const f32x4 v = *(const f32x4*)(F.in[I_GNORM] + (lane & 7) * 16 + 4 * i); gn[4 * i] = v[0]; gn[4 * i + 1] = v[1]; gn[4 * i + 2] = v[2]; gn[4 * i + 3] = v[3]; }
    for (int m = gw; m < M; m += NGW) {
        const size_t off = (size_t)m * 1024 + 16 * lane;
        v4u og[2], os[2], z[2], ga[2], gb[2];
#pragma unroll
        for (int k = 0; k < 2; ++k) { og[k] = *(const v4u*)(OGp + off + 8 * k); os[k] = *(const v4u*)(OSp + off + 8 * k); z[k] = *(const v4u*)(Zp + off + 8 * k); ga[k] = *(const v4u*)(GAp + off + 8 * k); gb[k] = *(const v4u*)(GBp + off + 8 * k); }
        float o[16]; float ss = 0.f;
#pragma unroll
        for (int k = 0; k < 2; ++k)
#pragma unroll
            for (int e = 0; e < 4; ++e) { o[8 * k + 2 * e] = bfl(og[k][e]); o[8 * k + 2 * e + 1] = bfh(og[k][e]); }
#pragma unroll
        for (int e = 0; e < 16; ++e) ss += o[e] * o[e];
        ss += __shfl_xor(ss, 1); ss += __shfl_xor(ss, 2); ss += __shfl_xor(ss, 4);
        const float rs = 1.0f / sqrtf(ss * (1.0f / 128.0f) + EPS);
        v4u out[2];
#pragma unroll
        for (int k = 0; k < 2; ++k)
#pragma unroll
            for (int e = 0; e < 4; ++e) {
                const float r0 = pg8::fast_sigmoid(bfl(ga[k][e])) * (o[8 * k + 2 * e] * rs * gn[8 * k + 2 * e] * pg8::fast_silu(bfl(z[k][e]))) + pg8::fast_sigmoid(bfl(gb[k][e])) * bfl(os[k][e]);
                const float r1 = pg8::fast_sigmoid(bfh(ga[k][e])) * (o[8 * k + 2 * e + 1] * rs * gn[8 * k + 2 * e + 1] * pg8::fast_silu(bfh(z[k][e]))) + pg8::fast_sigmoid(bfh(gb[k][e])) * bfh(os[k][e]);
                out[k][e] = cvtpk(r0, r1); }
#pragma unroll
        for (int k = 0; k < 2; ++k) *(v4u*)(GAp + off + 8 * k) = out[k];
    }
}
__device__ __forceinline__ void sample_gdn(Frame& F, int wg, int nwg) {
    const int team = F.tid >> 8, lt = F.tid & 255, dv = lt >> 1, half = lt & 1;
    LAS float* T = (LAS float*)(F.lds + team * 16384);
    const bf16_t* QKVS = FB(WS_QKVS); const float* AB = FF32(WS_AB); bf16_t* OG = FB(WS_OG);
    constexpr int NPAIR = DB * H / 2;
    for (int pr = wg; pr < NPAIR; pr += nwg) {
        const int unit = 2 * pr + team, b = unit / H, h = unit % H;
#pragma unroll
        for (int k = 0; k < 12; ++k) { const int id = lt + 256 * k, mat = id >> 10, t = (id >> 7) & 7, j = id & 127;
            const float v = bfl((unsigned)QKVS[((size_t)b * DS + t) * CONV + (mat == 0 ? 1024 : mat == 1 ? 0 : 2048) + h * 128 + j]);
            T[mat * 1024 + t * 128 + j] = mat == 1 ? v * 0.08838834764831845f : v; }
        if (lt < DS) { const size_t r = (size_t)MP + (size_t)b * DS + lt; const float a = AB[r * 16 + h], bb = AB[r * 16 + 8 + h];
            const float xg = a + F.in[I_DTB][h]; const float sp = xg > 20.f ? xg : log1pf(expf(xg));
            T[3072 + lt] = expf(-expf(F.in[I_ALOG][h]) * sp); T[3080 + lt] = 1.0f / (1.0f + expf(-bb)); }
        float S[64];
        const float* sp0 = F.in[I_SGDN] + (((size_t)b * H + h) * DK + 64 * half) * DV + dv;
#pragma unroll
        for (int j = 0; j < 64; ++j) S[j] = sp0[(size_t)j * DV];
        __syncthreads();
#pragma unroll 1
        for (int t = 0; t < DS; ++t) {
            const LAS float* kp = T + t * 128 + 64 * half; const LAS float* qp = T + 1024 + t * 128 + 64 * half;
            const float alpha = T[3072 + t], beta = T[3080 + t], v = T[2048 + t * 128 + dv];
            float ks = 0.f;
#pragma unroll
            for (int j4 = 0; j4 < 16; ++j4) { const f32x4 k4 = *(const LAS f32x4*)(kp + 4 * j4); ks += k4[0] * S[4 * j4] + k4[1] * S[4 * j4 + 1] + k4[2] * S[4 * j4 + 2] + k4[3] * S[4 * j4 + 3]; }
            ks += __shfl_xor(ks, 1);
            const float vn = beta * (v - alpha * ks);
            float o = 0.f;
#pragma unroll
            for (int j4 = 0; j4 < 16; ++j4) { const f32x4 k4 = *(const LAS f32x4*)(kp + 4 * j4), q4 = *(const LAS f32x4*)(qp + 4 * j4);
#pragma unroll
                for (int e = 0; e < 4; ++e) { S[4 * j4 + e] = alpha * S[4 * j4 + e] + k4[e] * vn; o += q4[e] * S[4 * j4 + e]; } }
            o += __shfl_xor(o, 1);
            if (half == 0) OG[((size_t)MP + (size_t)b * DS + t) * 1024 + h * DV + dv] = (bf16_t)f2bf_u(o);
        }
        float* so = F.out + O_GS + (((size_t)b * H + h) * DK + 64 * half) * DV + dv;
#pragma unroll
        for (int j = 0; j < 64; ++j) so[(size_t)j * DV] = S[j];
        __syncthreads();
    }
}
__device__ __forceinline__ void outkv_vec(Frame& F, int wg, int nwg) {
    const bf16_t* KS = FB(WS_KS); const bf16_t* VS = FB(WS_VS); const float* ck = F.in[I_CK]; const float* cv = F.in[I_CV];
    const long n = (long)(BATCH + DB) * WIN * 64;
    for (long g = (long)wg * NTHREADS + F.tid; g < n; g += (long)nwg * NTHREADS) {
        const int c4 = (int)(g & 63) * 4, j = (int)((g >> 6) & (WIN - 1)), sq = (int)(g >> 13);
        f32x4 kv, vv; float *ko, *vo;
        if (sq < BATCH) { const size_t r = (size_t)sq * SEQ + SEQ - WIN + j; const u32x2 a = *(const u32x2*)(KS + r * 256 + c4), bq = *(const u32x2*)(VS + r * 256 + c4);
            kv = (f32x4){bfl(a.x), bfh(a.x), bfl(a.y), bfh(a.y)}; vv = (f32x4){bfl(bq.x), bfh(bq.x), bfl(bq.y), bfh(bq.y)};
            ko = F.out + O_KP + ((size_t)sq * WIN + j) * 256 + c4; vo = F.out + O_VP + ((size_t)sq * WIN + j) * 256 + c4; }
        else { const int b = sq - BATCH;
            if (j + DS < WIN) { kv = *(const f32x4*)(ck + ((size_t)b * WIN + j + DS) * 256 + c4); vv = *(const f32x4*)(cv + ((size_t)b * WIN + j + DS) * 256 + c4); }
            else { const size_t r = (size_t)MP + (size_t)b * DS + (j + DS - WIN); const u32x2 a = *(const u32x2*)(KS + r * 256 + c4), bq = *(const u32x2*)(VS + r * 256 + c4);
                kv = (f32x4){bfl(a.x), bfh(a.x), bfl(a.y), bfh(a.y)}; vv = (f32x4){bfl(bq.x), bfh(bq.x), bfl(bq.y), bfh(bq.y)}; }
            ko = F.out + O_KS + ((size_t)b * WIN + j) * 256 + c4; vo = F.out + O_VS + ((size_t)b * WIN + j) * 256 + c4; }
        *(f32x4*)ko = kv; *(f32x4*)vo = vv;
    }
}
}
template <class K, class... A> __device__ __forceinline__ void run_items(long n, A... a) {
    for (long g = (long)blockIdx.x * NTHREADS + threadIdx.x; g < n; g += (long)gridDim.x * NTHREADS) K::run(g, a...);
}

template <class K, class... A> __device__ __forceinline__ void run_items_sub(long lo, long hi, int wg, int nwg, A... a) {
    for (long g = lo + (long)wg * NTHREADS + threadIdx.x; g < hi; g += (long)nwg * NTHREADS) K::run(g, a...);
}

__global__ void __launch_bounds__(NTHREADS, 2) mega_fwd(MArgs args) {
    extern __shared__ __attribute__((aligned(16))) unsigned char lds_raw[];
    Frame F;
    F.lds = (LAS unsigned char*)lds_raw; F.tid = threadIdx.x; F.lane = F.tid & 63; F.wave = __builtin_amdgcn_readfirstlane(F.tid >> 6); F.G = gridDim.x;
    F.in = args.in; F.out = args.out; F.ws = args.ws;
    const int lo = args.ph_lo, hi = args.ph_hi;
    if (F.tid < 16) ((LAS unsigned*)(F.lds + XB_LDS_OFF))[F.tid] = 0u;
    __syncthreads();
    XcdBarrier bar = xcd_barrier_post((unsigned*)(F.ws + lay::WS_CTL), (volatile LAS unsigned*)(F.lds + XB_LDS_OFF));
#define IN(k) (lo <= (k) && (k) < hi)
#ifndef MK_PROBE
#define MK_PROBE (-1)
#endif
#if MK_PROBE >= 0
    unsigned long long ts_prev = __builtin_amdgcn_s_memrealtime(), ts_dt = 0ull;
#define SEAM(k) do { if (IN(k) && IN((k) + 1)) { if ((k) == P_PRO) cg::this_grid().sync(); else xcd_barrier(bar); } { const unsigned long long t_ = __builtin_amdgcn_s_memrealtime(); if ((k) == MK_PROBE) ts_dt = t_ - ts_prev; ts_prev = t_; } } while (0)
#else
#define SEAM(k) do { if (IN(k) && IN((k) + 1)) { if ((k) == P_PRO) cg::this_grid().sync(); else xcd_barrier(bar); } } while (0)
#endif
    typedef pg8::StaticOrder SO;
    if (IN(P_PRO)) { p0_prologue(F); } SEAM(P_PRO);
    if (IN(P_FFN1A)) {
        pg8::Gemm g{FB(WS_XN1), FB(WS_W1IN), M, 2 * FF, D}; SO S; S.init(M, 2 * FF, F.G, (int)blockIdx.x);
        pg8::EpiSwiglu E{FB(WS_HB), FF, nullptr};
        pg8::gemm_phase<pg8::EpiSwiglu, SO, true, true>(F.lds, g, S, E);
    } SEAM(P_FFN1A);
    if (IN(P_FFN1B)) {
        pg8::Gemm g{FB(WS_HB), FB(WS_W1OUT), M, D, FF}; SO S; S.init(M, D, F.G, (int)blockIdx.x);
        pg8::EpiResid E{F.in[I_XP], F.in[I_XS], MP, 0.5f, FF32(WS_X1), FB(WS_X1B), FF32(WS_SSQ1)};
        pg8::gemm_phase<pg8::EpiResid, SO, true, true>(F.lds, g, S, E);
    } SEAM(P_FFN1B);
    if (IN(P_INPROJ)) {
        ab_tiles(F);
        pg8::Gemm g{FB(WS_X1B), FB(WS_WIN), M, 7680, D}; SO S; S.init(M, 7680, F.G, (int)blockIdx.x);
        pg8::EpiInProj E{FB(WS_RAW), FB(WS_Z), FB(WS_QS), FB(WS_KS), FB(WS_VS), FB(WS_GA), FB(WS_GB), FF32(WS_SSQ1)};
        pg8::gemm_phase<pg8::EpiInProj, SO, true, true>(F.lds, g, S, E);
    } SEAM(P_INPROJ);
#if MK_EMBED_NB
    if (IN(P_PREP)) {
        run_items<nv::OutConv>((long)(BATCH + DB) * 3 * CONV, (const bf16_t*)FB(WS_RAW), F.out + O_CP, F.out + O_CS);
        run_items<nv::Rope>((long)M * 160, FB(WS_QS), FB(WS_KS));
        gdn::sample_qkv(F);
        gdn::qkvn_pass(F);
        xcd_barrier(bar);
#if MK_PROBE == 40 || MK_PROBE == 41
        { const unsigned long long t_ = __builtin_amdgcn_s_memrealtime(); if (MK_PROBE == 40) ts_dt = t_ - ts_prev; ts_prev = t_; }
#endif
        gdn::prep_phase(F);
#if MK_PROBE == 41
        cg::this_grid().sync();
        { const unsigned long long t_ = __builtin_amdgcn_s_memrealtime(); ts_dt = t_ - ts_prev; ts_prev = t_; }
#endif
    } SEAM(P_PREP);
    if (IN(P_MIXER)) {
        constexpr int NSCAN = BATCH * H * 2;
        if ((int)blockIdx.x < NSCAN) gdn::scan_phase(F, (int)blockIdx.x);
        else {
            const int wg = (int)blockIdx.x - NSCAN, nwg = F.G - NSCAN;
            gdn::outkv_vec(F, wg, nwg);
            gdn::sample_gdn(F, wg, nwg);
            att::attn_phase(F, wg, nwg);
        }
    } SEAM(P_MIXER);
    if (IN(P_MERGE)) {
        gdn::merge_phase(F);
    } SEAM(P_MERGE);
#endif
    if (IN(P_OUTPROJ)) {
        pg8::Gemm g{FB(WS_MIXED), FB(WS_WOUT), M, D, D}; SO S; S.init(M, D, F.G, (int)blockIdx.x);
        pg8::EpiResid E{FF32(WS_X1), FF32(WS_X1), M, 1.0f, FF32(WS_X1), FB(WS_X2B), FF32(WS_SSQ2)};
        pg8::gemm_phase<pg8::EpiResid, SO, true, true>(F.lds, g, S, E);
    } SEAM(P_OUTPROJ);
    if (IN(P_FFN2A)) {
        pg8::Gemm g{FB(WS_X2B), FB(WS_W2IN), M, 2 * FF, D}; SO S; S.init(M, 2 * FF, F.G, (int)blockIdx.x);
        pg8::EpiSwiglu E{FB(WS_HB), FF, FF32(WS_SSQ2)};
        pg8::gemm_phase<pg8::EpiSwiglu, SO, true, true>(F.lds, g, S, E);
    } SEAM(P_FFN2A);
    if (IN(P_FFN2B)) {
        pg8::Gemm g{FB(WS_HB), FB(WS_W2OUT), M, D, FF}; SO S; S.init(M, D, F.G, (int)blockIdx.x);
        pg8::EpiResid E{FF32(WS_X1), FF32(WS_X1), M, 0.5f, F.out + O_YP, nullptr, FF32(WS_SSQ3)};
        pg8::gemm_phase<pg8::EpiResid, SO, true, true>(F.lds, g, S, E);
    } SEAM(P_FFN2B);
    if (IN(P_FINAL)) { final_norm(F); }
#if MK_PROBE >= 0
    { const unsigned long long t_ = __builtin_amdgcn_s_memrealtime(); if (MK_PROBE == P_FINAL) ts_dt = t_ - ts_prev;
      if (blockIdx.x == 0 && threadIdx.x == 0) F.out[0] += (float)ts_dt * (1.0f / 500.0f); }
#endif
#undef IN
#undef SEAM
}

static int g_grid = 0;
static bool mega_setup() {
    if (g_grid != 0) return g_grid > 0;
    int dev = 0, cus = 0, per_cu = 0;
    if (hipGetDevice(&dev) != hipSuccess || hipDeviceGetAttribute(&cus, hipDeviceAttributeMultiprocessorCount, dev) != hipSuccess) { g_grid = -1; return false; }
    if (hipFuncSetAttribute((const void*)mega_fwd, hipFuncAttributeMaxDynamicSharedMemorySize, LDS_BYTES) != hipSuccess) { fprintf(stderr, "mega: hipFuncSetAttribute failed\n"); g_grid = -1; return false; }
    if (hipOccupancyMaxActiveBlocksPerMultiprocessor(&per_cu, (const void*)mega_fwd, NTHREADS, LDS_BYTES) != hipSuccess || per_cu < 1) { fprintf(stderr, "mega: occupancy query says %d blocks per CU\n", per_cu); g_grid = -1; return false; }
    g_grid = cus;
    return true;
}
static void mega_launch(void* const* d_in, void* d_out, void* d_ws, int ph_lo, int ph_hi, hipStream_t stream) {
    if (!mega_setup()) return;
    MArgs a{};
    for (int i = 0; i < 21; ++i) a.in[i] = (const float*)d_in[i];
    a.out = (float*)d_out; a.ws = (unsigned char*)d_ws; a.ph_lo = ph_lo; a.ph_hi = ph_hi;
    (void)hipMemsetAsync((char*)d_ws + lay::WS_CTL, 0, XCD_BAR_WORDS * 4, stream);
    void* kargs[] = {&a};
    const hipError_t e = hipLaunchCooperativeKernel((const void*)mega_fwd, dim3(g_grid), dim3(NTHREADS), kargs, LDS_BYTES, stream);
    if (e != hipSuccess) fprintf(stderr, "mega: cooperative launch failed: %s (grid %d)\n", hipGetErrorString(e), g_grid);
}
}
#endif
#ifdef CPU_EMU
typedef int hipStream_t;
#endif

struct Ptrs {
    const float *x_prompt, *x_sample, *state_conv, *state_gdn, *cache_k, *cache_v, *norm_ffn1, *w_ffn1_in, *w_ffn1_out, *norm_mix, *w_in, *conv_w,
                *a_log, *dt_bias, *gdn_norm, *sinks, *w_out, *norm_ffn2, *w_ffn2_in, *w_ffn2_out, *norm_final;
    float* out; unsigned char* ws;
};
static Ptrs make_ptrs(void* const* d_in, void* d_out, void* d_ws) {
    Ptrs p;
    p.x_prompt = (const float*)d_in[0]; p.x_sample = (const float*)d_in[1]; p.state_conv = (const float*)d_in[2]; p.state_gdn = (const float*)d_in[3];
    p.cache_k = (const float*)d_in[4]; p.cache_v = (const float*)d_in[5]; p.norm_ffn1 = (const float*)d_in[6]; p.w_ffn1_in = (const float*)d_in[7];
    p.w_ffn1_out = (const float*)d_in[8]; p.norm_mix = (const float*)d_in[9]; p.w_in = (const float*)d_in[10]; p.conv_w = (const float*)d_in[11];
    p.a_log = (const float*)d_in[12]; p.dt_bias = (const float*)d_in[13]; p.gdn_norm = (const float*)d_in[14]; p.sinks = (const float*)d_in[15];
    p.w_out = (const float*)d_in[16]; p.norm_ffn2 = (const float*)d_in[17]; p.w_ffn2_in = (const float*)d_in[18]; p.w_ffn2_out = (const float*)d_in[19];
    p.norm_final = (const float*)d_in[20]; p.out = (float*)d_out; p.ws = (unsigned char*)d_ws; return p;
}
#define WSB(off) ((bf16_t*)(p.ws + lay::off))
#define WSF(off) ((float*)(p.ws + lay::off))

static void nb_ffn1(const Ptrs& p, hipStream_t stream) {
    using namespace cfg; using namespace nv;
    NV_LAUNCH(RmsnormIn, M, p.x_prompt, p.x_sample, p.norm_ffn1, WSB(WS_XN1));
    NV_LAUNCH(GemmSwiglu, (long)(M / 4) * (FF / 4), (const bf16_t*)WSB(WS_XN1), p.w_ffn1_in, WSB(WS_HB), D);
    NV_LAUNCH(Gemm<float>, (long)(M / 4) * (D / 4), (const bf16_t*)WSB(WS_HB), FF, p.w_ffn1_out, D, WSF(WS_T1), D, D, FF);
    NV_LAUNCH(AxpyIn, (long)M * D, p.x_prompt, p.x_sample, (const float*)WSF(WS_T1), 0.5f, WSF(WS_X1));
}
static void nb_inproj(const Ptrs& p, hipStream_t stream) {
    using namespace cfg; using namespace nv;
    NV_LAUNCH(Rmsnorm<bf16_t>, M, (const float*)WSF(WS_X1), p.norm_mix, WSB(WS_X1B));
    const bf16_t* A = WSB(WS_X1B);
    NV_LAUNCH(Gemm<bf16_t>, (long)(M / 4) * (CONV / 4), A, D, p.w_in + U_RAW, DIN, WSB(WS_RAW), CONV, CONV, D);
    NV_LAUNCH(Gemm<bf16_t>, (long)(M / 4) * (1024 / 4), A, D, p.w_in + U_Z, DIN, WSB(WS_Z), 1024, 1024, D);
    NV_LAUNCH(Gemm<float>, (long)(M / 4) * (16 / 4), A, D, p.w_in + U_A, DIN, WSF(WS_AB), 16, 16, D);
    NV_LAUNCH(Gemm<bf16_t>, (long)(M / 4) * (1024 / 4), A, D, p.w_in + U_QS, DIN, WSB(WS_QS), 1024, 1024, D);
    NV_LAUNCH(Gemm<bf16_t>, (long)(M / 4) * (256 / 4), A, D, p.w_in + U_KS, DIN, WSB(WS_KS), 256, 256, D);
    NV_LAUNCH(Gemm<bf16_t>, (long)(M / 4) * (256 / 4), A, D, p.w_in + U_VS, DIN, WSB(WS_VS), 256, 256, D);
    NV_LAUNCH(Gemm<bf16_t>, (long)(M / 4) * (1024 / 4), A, D, p.w_in + U_GA, DIN, WSB(WS_GA), 1024, 1024, D);
    NV_LAUNCH(Gemm<bf16_t>, (long)(M / 4) * (1024 / 4), A, D, p.w_in + U_GB, DIN, WSB(WS_GB), 1024, 1024, D);
}
static void nb_mixer(const Ptrs& p, hipStream_t stream) {
    using namespace cfg; using namespace nv;
    float* out = p.out;
    NV_LAUNCH(OutConv, (long)(BATCH + DB) * 3 * CONV, (const bf16_t*)WSB(WS_RAW), out + O_CP, out + O_CS);
    NV_LAUNCH(ConvInPlace, (long)(BATCH + DB) * CONV, WSB(WS_RAW), p.state_conv, p.conv_w);
    NV_LAUNCH(L2norm, (long)M * 16, WSB(WS_RAW));
    NV_LAUNCH(Gdn, (long)(BATCH + DB) * H * DV, (const float*)WSF(WS_AB), (const bf16_t*)WSB(WS_RAW), p.state_gdn, p.a_log, p.dt_bias, WSB(WS_OG), out + O_GP, out + O_GS);
    NV_LAUNCH(Rope, (long)M * 160, WSB(WS_QS), WSB(WS_KS));
    NV_LAUNCH(OutKV, (long)(BATCH + DB) * WIN * 256, (const bf16_t*)WSB(WS_KS), (const bf16_t*)WSB(WS_VS), p.cache_k, p.cache_v, out + O_KP, out + O_KS, out + O_VP, out + O_VS);
    NV_LAUNCH(SwaPrompt, (long)MP * QH, WSB(WS_QS), (const bf16_t*)WSB(WS_KS), (const bf16_t*)WSB(WS_VS), p.sinks);
    NV_LAUNCH(SwaSample, (long)MS * QH, WSB(WS_QS), (const bf16_t*)WSB(WS_KS), (const bf16_t*)WSB(WS_VS), p.cache_k, p.cache_v, p.sinks);
    NV_LAUNCH(Mix, (long)M * H, (const bf16_t*)WSB(WS_Z), WSB(WS_GA), (const bf16_t*)WSB(WS_GB), (const bf16_t*)WSB(WS_OG), (const bf16_t*)WSB(WS_OS), p.gdn_norm);
}
static void nb_tail(const Ptrs& p, hipStream_t stream) {
    using namespace cfg; using namespace nv;
    NV_LAUNCH(Gemm<float>, (long)(M / 4) * (D / 4), (const bf16_t*)WSB(WS_MIXED), 1024, p.w_out, D, WSF(WS_T1), D, D, 1024);
    NV_LAUNCH(Axpy, (long)M * D, (const float*)WSF(WS_X1), (const float*)WSF(WS_T1), 1.0f, WSF(WS_X1));
    NV_LAUNCH(Rmsnorm<bf16_t>, M, (const float*)WSF(WS_X1), p.norm_ffn2, WSB(WS_X2B));
    NV_LAUNCH(GemmSwiglu, (long)(M / 4) * (FF / 4), (const bf16_t*)WSB(WS_X2B), p.w_ffn2_in, WSB(WS_HB), D);
    NV_LAUNCH(Gemm<float>, (long)(M / 4) * (D / 4), (const bf16_t*)WSB(WS_HB), FF, p.w_ffn2_out, D, WSF(WS_T1), D, D, FF);
    NV_LAUNCH(Axpy, (long)M * D, (const float*)WSF(WS_X1), (const float*)WSF(WS_T1), 0.5f, WSF(WS_X1));
    NV_LAUNCH(Rmsnorm<float>, M, (const float*)WSF(WS_X1), p.norm_final, p.out + O_YP);
}
extern "C" void kernel_launch(void* const* d_in, const int* in_sizes, int n_in, void* d_out, int out_size, void* d_ws, size_t ws_size, hipStream_t stream) {
    (void)in_sizes; (void)n_in; (void)out_size;
    if (ws_size < lay::WS_END) return;
#ifndef CPU_EMU
    mk::mega_launch(d_in, d_out, d_ws, mk::P_PRO, mk::P_COUNT, stream);
#else
    const Ptrs p = make_ptrs(d_in, d_out, d_ws);
    nb_ffn1(p, stream); nb_inproj(p, stream); nb_mixer(p, stream); nb_tail(p, stream);
#endif
}
```

```cpp
#ifndef CPU_EMU
#include <hip/hip_runtime.h>
#endif
#include <cmath>
#include <cstdint>
#include <cstddef>

#ifndef CFG_D_MODEL
#define CFG_D_MODEL 1024
#define CFG_BATCH 4
#define CFG_SEQ 4096
#define CFG_DEC_BATCH 128
#define CFG_DEC_SEQ 8
#define CFG_D_FF 2816
#endif
namespace cfg {
constexpr int D = CFG_D_MODEL, BATCH = CFG_BATCH, SEQ = CFG_SEQ, DB = CFG_DEC_BATCH, DS = CFG_DEC_SEQ, FF = CFG_D_FF;
constexpr int PAST = 16384;
constexpr int MP = BATCH * SEQ, MS = DB * DS, M = MP + MS;
constexpr int H = 8, DK = 128, DV = 128, CONV = 3072, QH = 16, KVH = 4, HD = 64, WIN = 128;
constexpr int DIN = 3072 + 1024 + 16 + 1024 + 256 + 256 + 2 * D;
constexpr int U_RAW = 0, U_Z = 3072, U_A = 4096, U_B = 4104, U_QS = 4112, U_KS = 5136, U_VS = 5392, U_GA = 5648, U_GB = 5648 + D;
constexpr float EPS = 1e-6f;
constexpr size_t O_YP = 0, O_YS = O_YP + (size_t)MP * D, O_CP = O_YS + (size_t)MS * D, O_CS = O_CP + (size_t)BATCH * 3 * CONV,
                 O_GP = O_CS + (size_t)DB * 3 * CONV, O_GS = O_GP + (size_t)BATCH * H * DK * DV, O_KP = O_GS + (size_t)DB * H * DK * DV,
                 O_KS = O_KP + (size_t)BATCH * WIN * KVH * HD, O_VP = O_KS + (size_t)DB * WIN * KVH * HD,
                 O_VS = O_VP + (size_t)BATCH * WIN * KVH * HD, O_END = O_VS + (size_t)DB * WIN * KVH * HD;
}

#ifdef CPU_EMU
#define HDI inline
template <class K, class... A> void nv_launch(long n, A... a) { for (long g = 0; g < n; ++g) K::run(g, a...); }
#define NV_LAUNCH(K, n, ...) nv_launch<K>((long)(n), __VA_ARGS__)
#else
#define HDI __device__ __forceinline__
template <class K, class... A> __global__ void __launch_bounds__(256) nv_kernel(long n, A... a) {
    for (long g = (long)blockIdx.x * blockDim.x + threadIdx.x; g < n; g += (long)gridDim.x * blockDim.x) K::run(g, a...);
}
#define NV_LAUNCH(K, n, ...) do { long _n = (long)(n); long _b = (_n + 255) / 256; if (_b > 65536 * 4) _b = 65536 * 4; if (_b < 1) _b = 1; \
    nv_kernel<K><<<dim3((unsigned)_b), dim3(256), 0, stream>>>(_n, __VA_ARGS__); } while (0)
#endif

typedef unsigned short bf16_t;
namespace lay {
using namespace cfg;
constexpr size_t MiB = (size_t)1 << 20;
constexpr size_t WS_CTL = 0, WS_W1IN = 1 * MiB, WS_W1OUT = 12 * MiB, WS_WIN = 18 * MiB, WS_WAB = 33 * MiB, WS_WOUT = 34 * MiB, WS_W2IN = 36 * MiB, WS_W2OUT = 47 * MiB;
constexpr size_t WS_SSQ1 = 53 * MiB, WS_SSQ2 = 55 * MiB, WS_SSQ3 = 57 * MiB, WS_AB = 59 * MiB;
constexpr size_t WS_XN1 = 62 * MiB, WS_X2B = WS_XN1, WS_X1B = 96 * MiB, WS_X1 = 130 * MiB, WS_RAW = 198 * MiB, WS_Z = 300 * MiB, WS_QS = 334 * MiB, WS_OS = WS_QS;
constexpr size_t WS_KS = 368 * MiB, WS_VS = 377 * MiB, WS_GA = 386 * MiB, WS_MIXED = WS_GA, WS_GB = 420 * MiB, WS_OG = 454 * MiB, WS_HB = 488 * MiB, WS_END = 671 * MiB;
constexpr size_t WS_WK = 488 * MiB, WS_QG = 520 * MiB, WS_KGT = 552 * MiB, WS_QKP = 584 * MiB, WS_UV = 600 * MiB, WS_GL = 664 * MiB, WS_QKVS = 665 * MiB;
constexpr size_t WS_T1 = WS_RAW;
static_assert((size_t)M * D * 2 <= 34 * MiB && (size_t)M * D * 4 <= 68 * MiB && (size_t)M * CONV * 2 <= 102 * MiB && (size_t)M * FF * 2 <= 144 * MiB && (size_t)M * 256 * 2 <= 9 * MiB && (size_t)M * 16 * 4 <= 2 * MiB, "layout");
constexpr size_t WS_VN = 1 * MiB, WS_QN = 62 * MiB, WS_KN = 94 * MiB;
static_assert((size_t)MP * 1024 * 2 <= 32 * MiB, "layout");
}
namespace nv {
using namespace cfg;
HDI float bf2f(bf16_t v) { union { unsigned u; float f; } c; c.u = (unsigned)v << 16; return c.f; }
HDI bf16_t f2bf(float f) { union { unsigned u; float f; } c; c.f = f; return (bf16_t)((c.u + 0x7fffu + ((c.u >> 16) & 1u)) >> 16); }
HDI float ld(const float* p) { return *p; }
HDI float ld(const bf16_t* p) { return bf2f(*p); }
HDI void st(float* p, float v) { *p = v; }
HDI void st(bf16_t* p, float v) { *p = f2bf(v); }
HDI float silu_f(float x) { return x / (1.0f + expf(-x)); }
HDI float sigmoid_f(float x) { return 1.0f / (1.0f + expf(-x)); }
HDI float softplus_f(float x) { return x > 20.f ? x : log1pf(expf(x)); }
HDI const float* xrow(const float* xp, const float* xs, long r) { return r < MP ? xp + r * D : xs + (r - MP) * D; }

struct RmsnormIn {
    static HDI void run(long r, const float* xp, const float* xs, const float* w, bf16_t* out) {
        const float* xr = xrow(xp, xs, r); float s = 0.f;
        for (int c = 0; c < D; ++c) s += xr[c] * xr[c];
        const float rs = 1.0f / sqrtf(s / (float)D + EPS);
        for (int c = 0; c < D; ++c) out[r * D + c] = f2bf(xr[c] * rs * w[c]);
    }
};
template <class TO> struct Rmsnorm {
    static HDI void run(long r, const float* x, const float* w, TO* out) {
        const float* xr = x + r * D; float s = 0.f;
        for (int c = 0; c < D; ++c) s += xr[c] * xr[c];
        const float rs = 1.0f / sqrtf(s / (float)D + EPS);
        for (int c = 0; c < D; ++c) st(out + r * D + c, xr[c] * rs * w[c]);
    }
};
template <class TC> struct Gemm {
    static HDI void run(long g, const bf16_t* A, int lda, const float* B, int ldb, TC* C, int ldc, int N, int K) {
        const int nq = N / 4; const long mi = g / nq; const int ni = (int)(g % nq);
        float acc[4][4];
#pragma unroll
        for (int i = 0; i < 4; ++i)
#pragma unroll
            for (int j = 0; j < 4; ++j) acc[i][j] = 0.f;
        const bf16_t* a0 = A + (mi * 4) * lda; const float* bp = B + ni * 4;
        for (int k = 0; k < K; ++k) {
            const float b0 = bp[(long)k * ldb], b1 = bp[(long)k * ldb + 1], b2 = bp[(long)k * ldb + 2], b3 = bp[(long)k * ldb + 3];
#pragma unroll
            for (int i = 0; i < 4; ++i) { const float a = bf2f(a0[(long)i * lda + k]); acc[i][0] += a * b0; acc[i][1] += a * b1; acc[i][2] += a * b2; acc[i][3] += a * b3; }
        }
#pragma unroll
        for (int i = 0; i < 4; ++i)
#pragma unroll
            for (int j = 0; j < 4; ++j) st(C + (mi * 4 + i) * ldc + ni * 4 + j, acc[i][j]);
    }
};
struct GemmSwiglu {
    static HDI void run(long g, const bf16_t* A, const float* B, bf16_t* Hh, int K) {
        const int nq = FF / 4; const long mi = g / nq; const int ni = (int)(g % nq);
        float ag[4][4], au[4][4];
#pragma unroll
        for (int i = 0; i < 4; ++i)
#pragma unroll
            for (int j = 0; j < 4; ++j) { ag[i][j] = 0.f; au[i][j] = 0.f; }
        const bf16_t* a0 = A + (mi * 4) * K; const float* bp = B + ni * 4;
        for (int k = 0; k < K; ++k) {
            float bg[4], bu[4];
#pragma unroll
            for (int j = 0; j < 4; ++j) { bg[j] = bp[(long)k * 2 * FF + j]; bu[j] = bp[(long)k * 2 * FF + FF + j]; }
#pragma unroll
            for (int i = 0; i < 4; ++i) { const float a = bf2f(a0[(long)i * K + k]);
#pragma unroll
                for (int j = 0; j < 4; ++j) { ag[i][j] += a * bg[j]; au[i][j] += a * bu[j]; } }
        }
#pragma unroll
        for (int i = 0; i < 4; ++i)
#pragma unroll
            for (int j = 0; j < 4; ++j) Hh[(mi * 4 + i) * FF + ni * 4 + j] = f2bf(silu_f(ag[i][j]) * au[i][j]);
    }
};
struct AxpyIn {
    static HDI void run(long g, const float* xp, const float* xs, const float* T, float alpha, float* out) { const long r = g / D; const int c = (int)(g % D); out[g] = xrow(xp, xs, r)[c] + alpha * T[g]; }
};
struct Axpy {
    static HDI void run(long g, const float* a, const float* b, float alpha, float* out) { out[g] = a[g] + alpha * b[g]; }
};
HDI void row_info(long r, int& is_s, int& seq, int& t, int& L, long& base) {
    if (r < MP) { is_s = 0; seq = (int)(r / SEQ); t = (int)(r % SEQ); L = SEQ; base = (long)seq * SEQ; }
    else { const long rr = r - MP; is_s = 1; seq = (int)(rr / DS); t = (int)(rr % DS); L = DS; base = MP + (long)seq * DS; }
}
struct ConvInPlace {
    static HDI void run(long g, bf16_t* RAW, const float* state_conv, const float* conv_w) {
        const int c = (int)(g % CONV); const int sq = (int)(g / CONV);
        const int is_s = sq >= BATCH; const int seq = is_s ? sq - BATCH : sq; const int L = is_s ? DS : SEQ;
        const long base = is_s ? MP + (long)seq * DS : (long)seq * SEQ;
        const float w0 = conv_w[0 * CONV + c], w1 = conv_w[1 * CONV + c], w2 = conv_w[2 * CONV + c], w3 = conv_w[3 * CONV + c];
        float e0 = is_s ? state_conv[((long)seq * 3 + 0) * CONV + c] : 0.f;
        float e1 = is_s ? state_conv[((long)seq * 3 + 1) * CONV + c] : 0.f;
        float e2 = is_s ? state_conv[((long)seq * 3 + 2) * CONV + c] : 0.f;
        for (int t = 0; t < L; ++t) {
            const float e3 = bf2f(RAW[(base + t) * CONV + c]);
            RAW[(base + t) * CONV + c] = f2bf(silu_f(w0 * e0 + w1 * e1 + w2 * e2 + w3 * e3));
            e0 = e1; e1 = e2; e2 = e3;
        }
    }
};
struct L2norm {
    static HDI void run(long g, bf16_t* QKV) {
        const long r = g / 16; const int hh = (int)(g % 16);
        bf16_t* p = QKV + r * CONV + hh * 128; float s = 0.f;
        for (int j = 0; j < 128; ++j) { const float v = bf2f(p[j]); s += v * v; }
        const float rs = 1.0f / sqrtf(s + EPS);
        for (int j = 0; j < 128; ++j) p[j] = f2bf(bf2f(p[j]) * rs);
    }
};
struct Gdn {
    static HDI void run(long g, const float* AB, const bf16_t* QKV, const float* state_gdn, const float* a_log, const float* dt_bias,
                        bf16_t* OG, float* out_gp, float* out_gs) {
        const int dv = (int)(g % DV); const int h = (int)((g / DV) % H); const int sq = (int)(g / (DV * H));
        const int is_s = sq >= BATCH; const int seq = is_s ? sq - BATCH : sq; const int L = is_s ? DS : SEQ;
        const long base = is_s ? MP + (long)seq * DS : (long)seq * SEQ;
        float S[DK];
#pragma unroll
        for (int j = 0; j < DK; ++j) S[j] = is_s ? state_gdn[(((long)seq * H + h) * DK + j) * DV + dv] : 0.f;
        const float ea = expf(a_log[h]), dtb = dt_bias[h];
        for (int t = 0; t < L; ++t) {
            const long r = base + t;
            const float a = AB[r * 16 + h], b = AB[r * 16 + 8 + h];
            const float gg = -ea * softplus_f(a + dtb), beta = sigmoid_f(b), alpha = expf(gg);
            const bf16_t* q = QKV + r * CONV + h * DK; const bf16_t* k = QKV + r * CONV + 1024 + h * DK;
            const float v = bf2f(QKV[r * CONV + 2048 + h * DV + dv]);
            float ks = 0.f;
#pragma unroll
            for (int j = 0; j < DK; ++j) ks += bf2f(k[j]) * S[j];
            const float vn = beta * (v - alpha * ks);
            float o = 0.f;
#pragma unroll
            for (int j = 0; j < DK; ++j) { S[j] = alpha * S[j] + bf2f(k[j]) * vn; o += bf2f(q[j]) * S[j]; }
            OG[r * 1024 + h * DV + dv] = f2bf(o * 0.08838834764831845f);
        }
        float* so = is_s ? out_gs : out_gp;
#pragma unroll
        for (int j = 0; j < DK; ++j) so[(((long)seq * H + h) * DK + j) * DV + dv] = S[j];
    }
};
struct Rope {
    static HDI void run(long g, bf16_t* QS, bf16_t* KS) {
        const int i = (int)(g % 8); const int hh = (int)((g / 8) % 20); const long r = g / 160;
        int is_s, seq, t, L; long base; row_info(r, is_s, seq, t, L, base);
        const float pos = (float)(is_s ? PAST + t : t);
        const float inv = powf(500000.0f, -(float)(2 * i) / 16.0f);
        const float ang = pos * inv; const float cs = cosf(ang), sn = sinf(ang);
        bf16_t* p = hh < 16 ? QS + r * 1024 + hh * 64 : KS + r * 256 + (hh - 16) * 64;
        const float x1 = bf2f(p[i]), x2 = bf2f(p[i + 8]);
        p[i] = f2bf(x1 * cs - x2 * sn); p[i + 8] = f2bf(x2 * cs + x1 * sn);
    }
};
struct SwaPrompt {
    static HDI void run(long g, bf16_t* QS, const bf16_t* KS, const bf16_t* VS, const float* sinks) {
        const int qh = (int)(g % QH); const long r = g / QH; const int b = (int)(r / SEQ), t = (int)(r % SEQ); const int kvh = qh / 4;
        float q[HD], o[HD];
#pragma unroll
        for (int d = 0; d < HD; ++d) { q[d] = bf2f(QS[r * 1024 + qh * HD + d]); o[d] = 0.f; }
        float m = sinks[qh], l = 1.0f;
        const int j0 = t - (WIN - 1) < 0 ? 0 : t - (WIN - 1);
        for (int j = j0; j <= t; ++j) {
            const long rk = (long)b * SEQ + j; const bf16_t* kp = KS + rk * 256 + kvh * HD; const bf16_t* vp = VS + rk * 256 + kvh * HD;
            float s = 0.f;
#pragma unroll
            for (int d = 0; d < HD; ++d) s += q[d] * bf2f(kp[d]);
            s *= 0.125f;
            const float mn = fmaxf(m, s), sc = expf(m - mn), p = expf(s - mn);
            l = l * sc + p;
#pragma unroll
            for (int d = 0; d < HD; ++d) o[d] = o[d] * sc + p * bf2f(vp[d]);
            m = mn;
        }
        const float il = 1.0f / l;
#pragma unroll
        for (int d = 0; d < HD; ++d) QS[r * 1024 + qh * HD + d] = f2bf(o[d] * il);
    }
};
struct SwaSample {
    static HDI void run(long g, bf16_t* QS, const bf16_t* KS, const bf16_t* VS, const float* ck, const float* cv, const float* sinks) {
        const int qh = (int)(g % QH); const long rr = g / QH; const int b = (int)(rr / DS), t = (int)(rr % DS); const int kvh = qh / 4;
        const long r = MP + rr;
        float q[HD], o[HD];
#pragma unroll
        for (int d = 0; d < HD; ++d) { q[d] = bf2f(QS[r * 1024 + qh * HD + d]); o[d] = 0.f; }
        float m = sinks[qh], l = 1.0f;
        for (int j = t + 1; j < WIN + t + 1; ++j) {
            float s = 0.f; float vv[HD];
            if (j < WIN) { const float* kp = ck + (((long)b * WIN + j) * KVH + kvh) * HD; const float* vp = cv + (((long)b * WIN + j) * KVH + kvh) * HD;
#pragma unroll
                for (int d = 0; d < HD; ++d) { s += q[d] * kp[d]; vv[d] = vp[d]; } }
            else { const long rk = MP + (long)b * DS + (j - WIN); const bf16_t* kp = KS + rk * 256 + kvh * HD; const bf16_t* vp = VS + rk * 256 + kvh * HD;
#pragma unroll
                for (int d = 0; d < HD; ++d) { s += q[d] * bf2f(kp[d]); vv[d] = bf2f(vp[d]); } }
            s *= 0.125f;
            const float mn = fmaxf(m, s), sc = expf(m - mn), p = expf(s - mn);
            l = l * sc + p;
#pragma unroll
            for (int d = 0; d < HD; ++d) o[d] = o[d] * sc + p * vv[d];
            m = mn;
        }
        const float il = 1.0f / l;
#pragma unroll
        for (int d = 0; d < HD; ++d) QS[r * 1024 + qh * HD + d] = f2bf(o[d] * il);
    }
};
struct Mix {
    static HDI void run(long g, const bf16_t* Z, bf16_t* GA, const bf16_t* GB, const bf16_t* OG, const bf16_t* OS, const float* gdn_norm) {
        const int h = (int)(g % H); const long r = g / H;
        const bf16_t* og = OG + r * 1024 + h * DV; float s = 0.f;
        for (int j = 0; j < DV; ++j) { const float v = bf2f(og[j]); s += v * v; }
        const float rs = 1.0f / sqrtf(s / (float)DV + EPS);
        for (int j = 0; j < DV; ++j) {
            const long c = r * 1024 + h * DV + j;
            const float z = bf2f(Z[c]), ga = bf2f(GA[c]), gb = bf2f(GB[c]);
            GA[c] = f2bf(sigmoid_f(ga) * (bf2f(og[j]) * rs * gdn_norm[j] * silu_f(z)) + sigmoid_f(gb) * bf2f(OS[c]));
        }
    }
};
struct OutConv {
    static HDI void run(long g, const bf16_t* RAW, float* out_cp, float* out_cs) {
        const int c = (int)(g % CONV); const int i = (int)((g / CONV) % 3); const int sq = (int)(g / (3 * CONV));
        const int is_s = sq >= BATCH; const int seq = is_s ? sq - BATCH : sq; const int L = is_s ? DS : SEQ;
        const long base = is_s ? MP + (long)seq * DS : (long)seq * SEQ;
        const float v = bf2f(RAW[(base + L - 3 + i) * CONV + c]);
        (is_s ? out_cs : out_cp)[((long)seq * 3 + i) * CONV + c] = v;
    }
};
struct OutKV {
    static HDI void run(long g, const bf16_t* KS, const bf16_t* VS, const float* ck, const float* cv, float* out_kp, float* out_ks, float* out_vp, float* out_vs) {
        const int c = (int)(g % 256); const int j = (int)((g / 256) % WIN); const int sq = (int)(g / (256 * WIN));
        if (sq < BATCH) {
            const long r = (long)sq * SEQ + SEQ - WIN + j;
            out_kp[((long)sq * WIN + j) * 256 + c] = bf2f(KS[r * 256 + c]); out_vp[((long)sq * WIN + j) * 256 + c] = bf2f(VS[r * 256 + c]);
        } else {
            const int b = sq - BATCH; float kv, vv;
            if (j + DS < WIN) { kv = ck[((long)b * WIN + j + DS) * 256 + c]; vv = cv[((long)b * WIN + j + DS) * 256 + c]; }
            else { const long r = MP + (long)b * DS + (j + DS - WIN); kv = bf2f(KS[r * 256 + c]); vv = bf2f(VS[r * 256 + c]); }
            out_ks[((long)b * WIN + j) * 256 + c] = kv; out_vs[((long)b * WIN + j) * 256 + c] = vv;
        }
    }
};
}
namespace pg8 {
#define PG8_LAS __attribute__((address_space(3)))
typedef short bf16x8 __attribute__((ext_vector_type(8)));
typedef float f32x4 __attribute__((ext_vector_type(4)));
typedef unsigned u32x4 __attribute__((ext_vector_type(4)));
constexpr int BM = 256, BK = 64, HALF = 128, HTB = HALF * BK * 2  , STAGE_BYTES = 8 * HTB, NXCD = 8, WGM = 8;

__host__ __device__ __forceinline__ int lds_byte(int r, int c) { const int st = (r >> 4) * 2 + (c >> 5), rr = r & 15, cc = c & 31, ob = rr * 64 + cc * 2; return st * 1024 + (ob ^ (((ob >> 9) & 1) << 5)); }
__host__ __device__ __forceinline__ void stage_rc(int b, int& R, int& C) { const int st = b / 1024, sb = b % 1024, swz = sb ^ (((sb >> 9) & 1) << 5); R = (st >> 1) * 16 + swz / 64; C = (st & 1) * 32 + (swz % 64) / 2; }
__host__ __device__ __forceinline__ int perm32(int rho) { const int n = rho >> 4, i = rho & 15; return 8 * (i >> 2) + 4 * n + (i & 3); }

struct Unit { int pm, pn; };
struct Gemm { const bf16_t* A; const bf16_t* Bt; int M, N, K; };

struct StaticOrder {
    int nM, nN, nwg, G, c;
    __host__ __device__ void init(int M, int N, int G_, int c_) { nM = M / BM; nN = N / BM; nwg = nM * nN; G = G_; c = c_; }
    __host__ __device__ bool next(int i, Unit& u) const {
        const long L = (long)i * G + c; if (L >= nwg) return false;
        int wgid = (int)L; { const int q = nwg / NXCD, r = nwg % NXCD, xcd = wgid % NXCD, off = wgid / NXCD; wgid = (xcd < r ? xcd * (q + 1) : r * (q + 1) + (xcd - r) * q) + off; }
        const int nig = WGM * nN, gid = wgid / nig, fm = gid * WGM, gsz = (nM - fm) < WGM ? (nM - fm) : WGM;
        u.pm = fm + ((wgid % nig) % gsz); u.pn = (wgid % nig) / gsz; return true;
    }
    __device__ __forceinline__ void a_ready(const Unit&) const {}
    __device__ __forceinline__ void done(const Unit&) const {}
};
typedef unsigned u32x2 __attribute__((ext_vector_type(2)));
__device__ __forceinline__ unsigned cvt_pk_bf16(float lo, float hi) { unsigned r; asm volatile("v_cvt_pk_bf16_f32 %0, %1, %2" : "=v"(r) : "v"(lo), "v"(hi)); return r; }
__device__ __forceinline__ float fast_sigmoid(float x) { return __builtin_amdgcn_rcpf(1.0f + __builtin_amdgcn_exp2f(-1.4426950408889634f * x)); }
__device__ __forceinline__ float fast_silu(float x) { return x * fast_sigmoid(x); }
__device__ __forceinline__ void load_rs(float (&rs)[2][4], const float* ssq, int pm, int wr, int fr, int fq) {
#pragma unroll
    for (int ai = 0; ai < 2; ++ai)
#pragma unroll
        for (int m = 0; m < 4; ++m) {
            const int row = pm * BM + ai * HALF + wr * 64 + m * 16 + fr;
            const f32x4 v = *(const f32x4*)(ssq + (size_t)row * 16 + 4 * fq);
            float s = (v[0] + v[1]) + (v[2] + v[3]);
            s += __shfl_xor(s, 16); s += __shfl_xor(s, 32);
            rs[ai][m] = 1.0f / sqrtf(s * (1.0f / 1024.0f) + 1e-6f);
        }
}
struct EpiSwiglu {
    static constexpr bool PERM = true, AFTER_DRAIN = false;
    bf16_t* Hh; int ldh; const float* ssq;
    __device__ __forceinline__ void operator()(const f32x4 (&acc)[2][2][4][2], const Unit& u, int wr, int wc, int fr, int fq) const {
        float rs[2][4];
        if (ssq) load_rs(rs, ssq, u.pm, wr, fr, fq);
        const int col0 = u.pn * HALF + wc * 32 + 8 * fq;
#pragma unroll
        for (int ai = 0; ai < 2; ++ai)
#pragma unroll
            for (int m = 0; m < 4; ++m) {
                const float r_ = ssq ? rs[ai][m] : 1.0f;
                const int row = u.pm * BM + ai * HALF + wr * 64 + m * 16 + fr;
                float hv[8];
#pragma unroll
                for (int n = 0; n < 2; ++n)
#pragma unroll
                    for (int i = 0; i < 4; ++i) { const float g = acc[ai][0][m][n][i] * r_, up = acc[ai][1][m][n][i] * r_; hv[4 * n + i] = fast_silu(g) * up; }
                u32x4 w; w.x = cvt_pk_bf16(hv[0], hv[1]); w.y = cvt_pk_bf16(hv[2], hv[3]); w.z = cvt_pk_bf16(hv[4], hv[5]); w.w = cvt_pk_bf16(hv[6], hv[7]);
                *(u32x4*)(Hh + (size_t)row * ldh + col0) = w;
            }
    }
};
struct EpiInProj {
    static constexpr bool PERM = true, AFTER_DRAIN = false;
    bf16_t *raw, *z, *qs, *ks, *vs, *ga, *gb; const float* ssq;
    __device__ __forceinline__ void operator()(const f32x4 (&acc)[2][2][4][2], const Unit& u, int wr, int wc, int fr, int fq) const {
        float rs[2][4]; load_rs(rs, ssq, u.pm, wr, fr, fq);
        bf16_t* base; int ldc, colt; const int pn = u.pn;
        if (pn < 12) { base = raw; ldc = 3072; colt = pn * 256; }
        else if (pn < 16) { base = z; ldc = 1024; colt = (pn - 12) * 256; }
        else if (pn < 20) { base = qs; ldc = 1024; colt = (pn - 16) * 256; }
        else if (pn == 20) { base = ks; ldc = 256; colt = 0; }
        else if (pn == 21) { base = vs; ldc = 256; colt = 0; }
        else if (pn < 26) { base = ga; ldc = 1024; colt = (pn - 22) * 256; }
        else { base = gb; ldc = 1024; colt = (pn - 26) * 256; }
        const int col0 = colt + wc * 32 + 8 * fq;
#pragma unroll
        for (int ai = 0; ai < 2; ++ai)
#pragma unroll
            for (int m = 0; m < 4; ++m) {
                const float r_ = rs[ai][m];
                bf16_t* rowp = base + (size_t)(u.pm * BM + ai * HALF + wr * 64 + m * 16 + fr) * ldc + col0;
#pragma unroll
                for (int bj = 0; bj < 2; ++bj) { const f32x4 v0 = acc[ai][bj][m][0] * r_, v1 = acc[ai][bj][m][1] * r_;
                    u32x4 w; w.x = cvt_pk_bf16(v0[0], v0[1]); w.y = cvt_pk_bf16(v0[2], v0[3]); w.z = cvt_pk_bf16(v1[0], v1[1]); w.w = cvt_pk_bf16(v1[2], v1[3]);
                    *(u32x4*)(rowp + bj * HALF) = w; }
            }
    }
};
struct EpiResid {
    static constexpr bool PERM = false, AFTER_DRAIN = false;
    const float* xin_p; const float* xin_s; int split_row; float alpha; float* xout; bf16_t* xb; float* ssq;
    __device__ __forceinline__ void operator()(const f32x4 (&acc)[2][2][4][2], const Unit& u, int wr, int wc, int fr, int fq) const {
        const int col0 = u.pn * BM + wc * 32 + 4 * fq;
#pragma unroll
        for (int ai = 0; ai < 2; ++ai)
#pragma unroll
            for (int m = 0; m < 4; ++m) {
                const int row = u.pm * BM + ai * HALF + wr * 64 + m * 16 + fr;
                const float* xr = (row < split_row ? xin_p + (size_t)row * 1024 : xin_s + (size_t)(row - split_row) * 1024) + col0;
                float* orow = xout + (size_t)row * 1024 + col0;
                float ss = 0.f;
#pragma unroll
                for (int bj = 0; bj < 2; ++bj)
#pragma unroll
                    for (int n = 0; n < 2; ++n) {
                        const f32x4 xi = *(const f32x4*)(xr + bj * HALF + n * 16);
                        const f32x4 o = xi + acc[ai][bj][m][n] * alpha;
                        *(f32x4*)(orow + bj * HALF + n * 16) = o;
                        if (xb) { u32x2 w; w.x = cvt_pk_bf16(o[0], o[1]); w.y = cvt_pk_bf16(o[2], o[3]); *(u32x2*)(xb + (size_t)row * 1024 + col0 + bj * HALF + n * 16) = w; }
                        ss += (o[0] * o[0] + o[1] * o[1]) + (o[2] * o[2] + o[3] * o[3]);
                    }
                ss += __shfl_xor(ss, 16); ss += __shfl_xor(ss, 32);
                if (fq == 0) ssq[(size_t)row * 16 + u.pn * 4 + wc] = ss;
                if (m & 1) asm volatile("" ::: "memory");
            }
    }
};
template <class Epi, class Sched, bool ALIGN_EPI = false, bool SP2 = false>
__device__ __forceinline__ void gemm_phase(PG8_LAS unsigned char* lds, const Gemm g, const Sched& S, const Epi& E) {
    const int tid = threadIdx.x, wid = __builtin_amdgcn_readfirstlane(tid >> 6), lane = tid & 63, wr = wid >> 2, wc = wid & 3, fr = lane & 15, fq = lane >> 4;
    const int K = g.K, nt = K / BK;
    unsigned voffA[2], voffB[2];
#pragma unroll
    for (int i = 0; i < 2; ++i) { int R, C; stage_rc(tid * 16 + i * 8192, R, C); const int Rb = Epi::PERM ? ((R & ~31) + perm32(R & 31)) : R;
        voffA[i] = (unsigned)(R * K + C) * 2u; voffB[i] = (unsigned)(Rb * K + C) * 2u; }
    const size_t kstep = (size_t)(BK * 2);
    const size_t hstep = (size_t)HALF * K * 2;
    const size_t tstep = 2 * hstep;
    const unsigned ldsw = (unsigned)wid * 1024u;
    const int aoff = lds_byte(wr * 64 + fr, fq * 8), boff = lds_byte(wc * 32 + fr, fq * 8);
#define PG8_SA(b, h) (((b) * 2 + (h)) * HTB)
#define PG8_SB(b, h) ((4 + (b) * 2 + (h)) * HTB)
#define PG8_STAGE(bufoff, gbase, voff) do { _Pragma("unroll") for (int _i = 0; _i < 2; ++_i) \
        __builtin_amdgcn_global_load_lds((const unsigned*)((const char*)(gbase) + (voff)[_i]), (PG8_LAS unsigned*)(lds + (bufoff) + ldsw + _i * 8192), 16, 0, 0); } while (0)
#define PG8_LDA(dst, b, h) do { _Pragma("unroll") for (int m = 0; m < 4; ++m) _Pragma("unroll") for (int k = 0; k < 2; ++k) dst[m][k] = *(const PG8_LAS bf16x8*)(lds + PG8_SA(b, h) + aoff + m * 2048 + k * 1024); } while (0)
#define PG8_LDB(dst, b, h) do { _Pragma("unroll") for (int n = 0; n < 2; ++n) _Pragma("unroll") for (int k = 0; k < 2; ++k) dst[n][k] = *(const PG8_LAS bf16x8*)(lds + PG8_SB(b, h) + boff + n * 2048 + k * 1024); } while (0)
#define PG8_MMA(ai, bj, At, Bt) do { __builtin_amdgcn_s_setprio(1); _Pragma("unroll") for (int m = 0; m < 4; ++m) _Pragma("unroll") for (int n = 0; n < 2; ++n) _Pragma("unroll") for (int k = 0; k < 2; ++k) \
        acc[ai][bj][m][n] = __builtin_amdgcn_mfma_f32_16x16x32_bf16(Bt[n][k], At[m][k], acc[ai][bj][m][n], 0, 0, 0); __builtin_amdgcn_s_setprio(0); } while (0)
#define PG8_WAIT_V(n) asm volatile("s_waitcnt vmcnt(" #n ")" ::: "memory")
#define PG8_WAIT_L(n) asm volatile("s_waitcnt lgkmcnt(" #n ")" ::: "memory")
#define PG8_BAR __builtin_amdgcn_s_barrier()
#define PG8_SCHED __builtin_amdgcn_sched_barrier(0)
    Unit cur, nxt; int ui = 0;
    if (!S.next(0, cur)) return;
    f32x4 acc[2][2][4][2];
#pragma unroll
    for (int a = 0; a < 2; ++a)
#pragma unroll
        for (int b = 0; b < 2; ++b)
#pragma unroll
            for (int m = 0; m < 4; ++m)
#pragma unroll
                for (int n = 0; n < 2; ++n) acc[a][b][m][n] = (f32x4){0.f, 0.f, 0.f, 0.f};
    bf16x8 At[4][2], B0[2][2], B1[2][2];
    const char* cA = (const char*)g.A + (size_t)cur.pm * tstep; const char* cB = (const char*)g.Bt + (size_t)cur.pn * tstep;
    S.a_ready(cur);
    if constexpr (SP2) {
        PG8_STAGE(PG8_SB(0, 0), cB, voffB); PG8_STAGE(PG8_SB(0, 1), cB + hstep, voffB); PG8_STAGE(PG8_SA(0, 0), cA, voffA); PG8_STAGE(PG8_SA(0, 1), cA + hstep, voffA);
        if (wr == 1) PG8_BAR;
        PG8_WAIT_V(2); PG8_BAR;
        PG8_STAGE(PG8_SB(1, 0), cB + kstep, voffB); PG8_STAGE(PG8_SA(1, 0), cA + kstep, voffA); PG8_STAGE(PG8_SB(1, 1), cB + hstep + kstep, voffB);
        PG8_WAIT_V(6); PG8_BAR;
    } else {
        PG8_STAGE(PG8_SB(0, 0), cB, voffB); PG8_STAGE(PG8_SA(0, 0), cA, voffA); PG8_STAGE(PG8_SB(0, 1), cB + hstep, voffB); PG8_STAGE(PG8_SA(0, 1), cA + hstep, voffA);
        if (wr == 1) PG8_BAR;
        PG8_WAIT_V(4); PG8_BAR;
        PG8_STAGE(PG8_SB(1, 0), cB + kstep, voffB); PG8_STAGE(PG8_SA(1, 0), cA + kstep, voffA); PG8_STAGE(PG8_SB(1, 1), cB + hstep + kstep, voffB);
        PG8_WAIT_V(6); PG8_BAR;
    }
    for (;;) {
        const bool has_next = S.next(ui + 1, nxt);
        const char* nA = has_next ? (const char*)g.A + (size_t)nxt.pm * tstep : cA; const char* nB = has_next ? (const char*)g.Bt + (size_t)nxt.pn * tstep : cB;
        for (int t = 0; t < nt; t += 2) {
            const bool last = (t == nt - 2);
            const char* a1 = cA + (size_t)(t + 1) * kstep;
            const char* a2 = last ? nA : cA + (size_t)(t + 2) * kstep; const char* b2 = last ? nB : cB + (size_t)(t + 2) * kstep;
            const char* a3 = a2 + kstep; const char* b3 = b2 + kstep;
            if (last && has_next) S.a_ready(nxt);
            if constexpr (SP2) {
            PG8_LDB(B0, 0, 0); PG8_LDB(B1, 0, 1); PG8_SCHED; PG8_LDA(At, 0, 0); PG8_STAGE(PG8_SA(1, 1), a1 + hstep, voffA);
            PG8_WAIT_V(8); PG8_WAIT_L(0); PG8_BAR; PG8_MMA(0, 0, At, B0); PG8_MMA(0, 1, At, B1); PG8_BAR; PG8_SCHED;
            PG8_LDA(At, 0, 1); PG8_STAGE(PG8_SB(0, 0), b2, voffB); PG8_STAGE(PG8_SB(0, 1), b2 + hstep, voffB); PG8_STAGE(PG8_SA(0, 0), a2, voffA);
            PG8_WAIT_V(8); PG8_WAIT_L(0); PG8_BAR; PG8_MMA(1, 0, At, B0); PG8_MMA(1, 1, At, B1); PG8_BAR; PG8_SCHED;
            PG8_LDB(B0, 1, 0); PG8_LDB(B1, 1, 1); PG8_SCHED; PG8_LDA(At, 1, 0); PG8_STAGE(PG8_SA(0, 1), a2 + hstep, voffA);
            PG8_WAIT_V(8); PG8_WAIT_L(0); PG8_BAR; PG8_MMA(0, 0, At, B0); PG8_MMA(0, 1, At, B1); PG8_BAR; PG8_SCHED;
            PG8_LDA(At, 1, 1); PG8_STAGE(PG8_SB(1, 0), b3, voffB); PG8_STAGE(PG8_SB(1, 1), b3 + hstep, voffB); PG8_STAGE(PG8_SA(1, 0), a3, voffA);
            PG8_WAIT_V(8); PG8_WAIT_L(0); PG8_BAR; PG8_MMA(1, 0, At, B0); PG8_MMA(1, 1, At, B1); PG8_BAR; PG8_SCHED;
            } else {
            PG8_LDB(B0, 0, 0); PG8_SCHED; PG8_LDA(At, 0, 0); PG8_STAGE(PG8_SA(1, 1), a1 + hstep, voffA);
            PG8_WAIT_L(8); PG8_BAR; PG8_WAIT_L(0); PG8_MMA(0, 0, At, B0); PG8_BAR; PG8_SCHED;
            PG8_LDB(B1, 0, 1); PG8_STAGE(PG8_SB(0, 0), b2, voffB);
            PG8_BAR; PG8_WAIT_L(0); PG8_MMA(0, 1, At, B1); PG8_BAR;
            PG8_LDA(At, 0, 1); PG8_STAGE(PG8_SA(0, 0), a2, voffA);
            PG8_BAR; PG8_WAIT_L(0); PG8_MMA(1, 0, At, B0); PG8_BAR; PG8_SCHED;
            PG8_STAGE(PG8_SB(0, 1), b2 + hstep, voffB);
            PG8_WAIT_V(6); PG8_BAR; PG8_MMA(1, 1, At, B1); PG8_BAR;
            PG8_LDB(B0, 1, 0); PG8_SCHED; PG8_LDA(At, 1, 0); PG8_STAGE(PG8_SA(0, 1), a2 + hstep, voffA);
            PG8_WAIT_L(8); PG8_BAR; PG8_WAIT_L(0); PG8_MMA(0, 0, At, B0); PG8_BAR; PG8_SCHED;
            PG8_LDB(B1, 1, 1); PG8_STAGE(PG8_SB(1, 0), b3, voffB);
            PG8_BAR; PG8_WAIT_L(0); PG8_MMA(0, 1, At, B1); PG8_BAR;
            PG8_LDA(At, 1, 1); PG8_STAGE(PG8_SA(1, 0), a3, voffA);
            PG8_BAR; PG8_WAIT_L(0); PG8_MMA(1, 0, At, B0); PG8_BAR; PG8_SCHED;
            PG8_STAGE(PG8_SB(1, 1), b3 + hstep, voffB);
            PG8_WAIT_V(6); PG8_BAR; PG8_MMA(1, 1, At, B1); PG8_BAR;
            }
        }
        if constexpr (ALIGN_EPI) { if (wr == 0) PG8_BAR; }
        if constexpr (!Epi::AFTER_DRAIN) { E(acc, cur, wr, wc, fr, fq); S.done(cur); }
        if (!has_next) break;
#pragma unroll
        for (int a = 0; a < 2; ++a)
#pragma unroll
            for (int b = 0; b < 2; ++b)
#pragma unroll
                for (int m = 0; m < 4; ++m)
#pragma unroll
                    for (int n = 0; n < 2; ++n) acc[a][b][m][n] = (f32x4){0.f, 0.f, 0.f, 0.f};
        cur = nxt; cA = nA; cB = nB; ++ui;
        if constexpr (ALIGN_EPI) { if (wr == 1) PG8_BAR; }
    }
    PG8_WAIT_V(0);
    if constexpr (!ALIGN_EPI) { if (wr == 0) PG8_BAR; }
    PG8_BAR;
    if constexpr (Epi::AFTER_DRAIN) { E.fused(acc, cur, wr, wc, fr, fq, lds, wid, lane); S.done(cur); }
#undef PG8_SA
#undef PG8_SB
#undef PG8_STAGE
#undef PG8_LDA
#undef PG8_LDB
#undef PG8_MMA
#undef PG8_WAIT_V
#undef PG8_WAIT_L
#undef PG8_BAR
#undef PG8_SCHED
}
}
#ifndef CPU_EMU
#include <hip/hip_cooperative_groups.h>
#include <cstdio>
namespace mk {
namespace cg = cooperative_groups;
using namespace cfg;
#define LAS __attribute__((address_space(3)))
#define GAS __attribute__((address_space(1)))
typedef float f32x4 __attribute__((ext_vector_type(4)));
typedef unsigned v4u __attribute__((ext_vector_type(4)));
typedef short bf16x8 __attribute__((ext_vector_type(8)));
constexpr int NWAVES = 8, NTHREADS = NWAVES * 64;
constexpr int LDS_BYTES = 163840;
#ifndef MK_EMBED_NB
#define MK_EMBED_NB 1
#endif
enum Phase { P_PRO = 0, P_FFN1A, P_FFN1B, P_INPROJ, P_PREP, P_MIXER, P_MERGE, P_OUTPROJ, P_FFN2A, P_FFN2B, P_FINAL, P_COUNT };

struct MArgs { const float* in[21]; float* out; unsigned char* ws; int ph_lo, ph_hi; };

__device__ __forceinline__ unsigned f2bf_u(float f) { unsigned u = __builtin_bit_cast(unsigned, f); return (u + 0x7fffu + ((u >> 16) & 1u)) >> 16; }
__device__ __forceinline__ unsigned pk2(float lo, float hi) { return f2bf_u(lo) | (f2bf_u(hi) << 16); }
__device__ __forceinline__ float wave_sum(float v) {
#pragma unroll
    for (int o = 1; o < 64; o <<= 1) v += __shfl_xor(v, o);
    return v;
}
__device__ __forceinline__ void transpose_item(const float* W, int ldw, int src_col0, bf16_t* WT, int K, int dst_row0, int nvalid, const float* kscale, LAS float* scr, int k0, int lane) {
#pragma unroll
    for (int i = 0; i < 8; ++i) { const int kk = 8 * i + (lane >> 3), c4 = 4 * (lane & 7); f32x4 v = *(const f32x4*)(W + (size_t)(k0 + kk) * ldw + src_col0 + c4); if (kscale) v = v * kscale[k0 + kk];
        scr[kk * 33 + c4] = v[0]; scr[kk * 33 + c4 + 1] = v[1]; scr[kk * 33 + c4 + 2] = v[2]; scr[kk * 33 + c4 + 3] = v[3]; }
    asm volatile("s_waitcnt lgkmcnt(0)" ::: "memory");
    const int c = lane & 7;
#pragma unroll
    for (int j = 0; j < 4; ++j) { const int n = (lane >> 3) + 8 * j; const LAS float* s = scr + (8 * c) * 33 + n;
        v4u o; o.x = pk2(s[0 * 33], s[1 * 33]); o.y = pk2(s[2 * 33], s[3 * 33]); o.z = pk2(s[4 * 33], s[5 * 33]); o.w = pk2(s[6 * 33], s[7 * 33]);
        if (n < nvalid) *(v4u*)(WT + (size_t)(dst_row0 + n) * K + k0 + 8 * c) = o; }
    asm volatile("s_waitcnt lgkmcnt(0)" ::: "memory");
}
struct Frame {
    LAS unsigned char* lds; int tid, lane, wave, G;
    const float* const* in; float* out; unsigned char* ws;
};
#define FB(off) ((bf16_t*)(F.ws + lay::off))
#define FF32(off) ((float*)(F.ws + lay::off))
enum { I_XP = 0, I_XS, I_SCONV, I_SGDN, I_CK, I_CV, I_NF1, I_W1IN, I_W1OUT, I_NMIX, I_WIN, I_CONVW, I_ALOG, I_DTB, I_GNORM, I_SINKS, I_WOUT, I_NF2, I_W2IN, I_W2OUT, I_NFIN };

#define XB_TMO      128
#define XB_XCNT(j)  (256  + 64 * (j))
#define XB_XSUB(j)  (1280 + 64 * (j))
#define XB_XGEN(j)  (2304 + 64 * (j))
#define XB_TOP      3328
#define XB_TOPGEN   3392
#define XCD_BAR_WORDS 3456
#define XB_SPIN_CAP (1u << 18)

__device__ __forceinline__ unsigned xb_ld(unsigned* p)              { return __hip_atomic_load(p, __ATOMIC_RELAXED, __HIP_MEMORY_SCOPE_AGENT); }
__device__ __forceinline__ unsigned xb_add(unsigned* p, unsigned v) { return __hip_atomic_fetch_add(p, v, __ATOMIC_RELAXED, __HIP_MEMORY_SCOPE_AGENT); }
__device__ __forceinline__ unsigned xb_xcc_id() { return (unsigned)__builtin_amdgcn_s_getreg((3 << 11) | 20) & 0xFu; }
#define XB_SPIN(cond, bar) do { unsigned _sp = 0; while (cond) { __builtin_amdgcn_s_sleep(1); \
    if ((++_sp & 255u) == 0u) { if (xb_ld(&(bar)[XB_TMO])) break; if (_sp > XB_SPIN_CAP) { atomicAdd(&(bar)[XB_TMO], 1u); break; } } } } while (0)

struct XcdBarrier {
    unsigned* bar; unsigned x;
    volatile LAS unsigned* st;
};

__device__ __forceinline__ XcdBarrier xcd_barrier_post(unsigned* bar, volatile LAS unsigned* st) {
    XcdBarrier b; b.bar = bar; b.x = xb_xcc_id(); b.st = st;
    if (threadIdx.x == 0) (void)xb_add(&bar[XB_XCNT(b.x)], 1u);
    return b;
}
__device__ __forceinline__ void xcd_barrier_complete(unsigned* bar, unsigned x, unsigned& nloc, unsigned& nx) {
    const unsigned G = gridDim.x * gridDim.y * gridDim.z;
    unsigned sum, cnt, mine, sp = 0u;
    for (;;) {
        sum = 0u; cnt = 0u; mine = 0u;
#pragma unroll
        for (unsigned j = 0; j < 16; ++j) { const unsigned c = xb_ld(&bar[XB_XCNT(j)]); sum += c; cnt += (c > 0u) ? 1u : 0u; mine = (j == x) ? c : mine; }
        if (sum == G) break;
        __builtin_amdgcn_s_sleep(1);
        if ((++sp & 255u) == 0u) { if (xb_ld(&bar[XB_TMO])) break; if (sp > XB_SPIN_CAP) { atomicAdd(&bar[XB_TMO], 1u); break; } }
    }
    nloc = mine > 0u ? mine : 1u; nx = cnt > 0u ? cnt : 1u;
}

__device__ __forceinline__ void xcd_barrier(const XcdBarrier& b) {
    asm volatile("s_waitcnt vmcnt(0)" ::: "memory");
    __syncthreads();
    if (threadIdx.x == 0) {
        unsigned* bar = b.bar;
        __builtin_amdgcn_s_waitcnt(0);
        unsigned nloc = b.st[0], nx = b.st[1];
        if (nloc == 0u) { xcd_barrier_complete(bar, b.x, nloc, nx); b.st[0] = nloc; b.st[1] = nx; }
        const unsigned old = xb_add(&bar[XB_XSUB(b.x)], 1u);
        const unsigned gen = old / nloc;
        if (old + 1u == (gen + 1u) * nloc) {
            __builtin_amdgcn_fence(__ATOMIC_RELEASE, "agent");
            asm volatile("s_waitcnt vmcnt(0)" ::: "memory");
            const unsigned og = xb_add(&bar[XB_TOP], 1u);
            const unsigned tg = og / nx;
            if (og + 1u == (tg + 1u) * nx) xb_add(&bar[XB_TOPGEN], 1u);
            else XB_SPIN(xb_ld(&bar[XB_TOPGEN]) == tg, bar);
            __builtin_amdgcn_fence(__ATOMIC_ACQUIRE, "agent");
            xb_add(&bar[XB_XGEN(b.x)], 1u);
            asm volatile("s_waitcnt vmcnt(0)" ::: "memory");
        } else {
            XB_SPIN(xb_ld(&bar[XB_XGEN(b.x)]) == gen, bar);
            __builtin_amdgcn_fence(__ATOMIC_ACQUIRE, "agent");
            asm volatile("s_waitcnt vmcnt(0)" ::: "memory");
        }
    }
    __syncthreads();
}

constexpr int XB_LDS_OFF = LDS_BYTES - 64;

__device__ __forceinline__ void p0_prologue(Frame& F, int which, int gw, int NGW) {
    LAS float* scr = (LAS float*)(F.lds + F.wave * 16384);
    constexpr int KB1 = D / 64, KB2 = FF / 64;
    constexpr int N_W1IN = KB1 * (2 * FF / 32), N_W1OUT = KB2 * (D / 32), N_WIN = KB1 * (7680 / 32), N_WAB = KB1, N_WOUT = KB1 * (D / 32);
    constexpr int NITEMS = 2 * N_W1IN + 2 * N_W1OUT + N_WIN + N_WAB + N_WOUT;
    for (int it = gw; it < NITEMS; it += NGW) {
        int r = it;
        if (r < 2 * N_W1IN) {
            const int second = r >= N_W1IN; if (second) r -= N_W1IN;
            if (second != which) continue;
            const int nbs = 2 * FF / 32, kb = r / nbs, nb = r % nbs, pn = nb >> 3, bj = (nb >> 2) & 1, wi = nb & 3;
            transpose_item(F.in[second ? I_W2IN : I_W1IN], 2 * FF, bj * FF + pn * 128 + wi * 32, second ? FB(WS_W2IN) : FB(WS_W1IN), D, nb * 32, 32, second ? F.in[I_NF2] : nullptr, scr, kb * 64, F.lane);
            continue; }
        r -= 2 * N_W1IN;
        if (r < 2 * N_W1OUT) {
            const int second = r >= N_W1OUT; if (second) r -= N_W1OUT;
            if (second != which) continue;
            const int nbs = D / 32, kb = r / nbs, nb = r % nbs;
            transpose_item(F.in[second ? I_W2OUT : I_W1OUT], D, nb * 32, second ? FB(WS_W2OUT) : FB(WS_W1OUT), FF, nb * 32, 32, nullptr, scr, kb * 64, F.lane);
            continue; }
        r -= 2 * N_W1OUT;
        if (r < N_WIN) {
            if (which) continue;
            const int nbs = 7680 / 32, kb = r / nbs, nb = r % nbs, drow = nb * 32;
            transpose_item(F.in[I_WIN], DIN, drow + (drow >= 4096 ? 16 : 0), FB(WS_WIN), D, drow, 32, F.in[I_NMIX], scr, kb * 64, F.lane);
            continue; }
        r -= N_WIN;
        if (r < N_WAB) { if (which) continue; transpose_item(F.in[I_WIN], DIN, 4096, FB(WS_WAB), D, 0, 16, F.in[I_NMIX], scr, r * 64, F.lane); continue; }
        r -= N_WAB;
        if (which) { const int nbs = D / 32, kb = r / nbs, nb = r % nbs; transpose_item(F.in[I_WOUT], D, nb * 32, FB(WS_WOUT), D, nb * 32, 32, nullptr, scr, kb * 64, F.lane); }
    }
    if (which) return;
    const float* nw = F.in[I_NF1];
    f32x4 wv[4];
#pragma unroll
    for (int j = 0; j < 4; ++j) wv[j] = *(const f32x4*)(nw + 4 * F.lane + 256 * j);
    for (int m = gw; m < M; m += NGW) {
        const float* xr = (m < MP ? F.in[I_XP] + (size_t)m * D : F.in[I_XS] + (size_t)(m - MP) * D) + 4 * F.lane;
        f32x4 v[4]; float s = 0.f;
#pragma unroll
        for (int j = 0; j < 4; ++j) { v[j] = *(const f32x4*)(xr + 256 * j); s += (v[j][0] * v[j][0] + v[j][1] * v[j][1]) + (v[j][2] * v[j][2] + v[j][3] * v[j][3]); }
        const float rs = 1.0f / sqrtf(wave_sum(s) * (1.0f / D) + EPS);
        unsigned long long* o8 = (unsigned long long*)(FB(WS_XN1) + (size_t)m * D) + F.lane;
#pragma unroll
        for (int j = 0; j < 4; ++j) { const f32x4 o = v[j] * rs * wv[j]; o8[64 * j] = (unsigned long long)pk2(o[0], o[1]) | ((unsigned long long)pk2(o[2], o[3]) << 32); }
    }
}
__device__ __forceinline__ void ab_tiles(Frame& F) {
    const int gw = blockIdx.x * NWAVES + F.wave, NGW = F.G * NWAVES; const int lane = F.lane, q = lane >> 4, c = lane & 15;
    const bf16_t* x1b = FB(WS_X1B); const bf16_t* wab = FB(WS_WAB); const float* ssq = FF32(WS_SSQ1); float* AB = FF32(WS_AB);
    for (int tile = gw; tile < M / 16; tile += NGW) {
        f32x4 acc = {0.f, 0.f, 0.f, 0.f};
        const bf16_t* ap = x1b + (size_t)(tile * 16 + c) * D + 8 * q; const bf16_t* bp = wab + (size_t)c * D + 8 * q;
#pragma unroll 8
        for (int s = 0; s < D / 32; ++s) { const bf16x8 a = *(const bf16x8*)(ap + 32 * s), b = *(const bf16x8*)(bp + 32 * s); acc = __builtin_amdgcn_mfma_f32_16x16x32_bf16(a, b, acc, 0, 0, 0); }
#pragma unroll
        for (int r = 0; r < 4; ++r) { const int row = tile * 16 + 4 * q + r; const float* sp = ssq + (size_t)row * 16;
            float s = 0.f;
#pragma unroll
            for (int i = 0; i < 4; ++i) { const f32x4 v = *(const f32x4*)(sp + 4 * i); s += (v[0] + v[1]) + (v[2] + v[3]); }
            AB[(size_t)row * 16 + c] = acc[r] * (1.0f / sqrtf(s * (1.0f / D) + EPS)); }
    }
}
__device__ __forceinline__ void final_norm(Frame& F) {
    const int gw = blockIdx.x * NWAVES + F.wave, NGW = F.G * NWAVES; const float* nw = F.in[I_NFIN];
    f32x4 wv[4];
#pragma unroll
    for (int j = 0; j < 4; ++j) wv[j] = *(const f32x4*)(nw + 4 * F.lane + 256 * j);
    for (int m = gw; m < M; m += NGW) {
        float* xr = F.out + O_YP + (size_t)m * D + 4 * F.lane;
        f32x4 v[4]; float s = 0.f;
#pragma unroll
        for (int j = 0; j < 4; ++j) { v[j] = *(const f32x4*)(xr + 256 * j); s += (v[j][0] * v[j][0] + v[j][1] * v[j][1]) + (v[j][2] * v[j][2] + v[j][3] * v[j][3]); }
        const float rs = 1.0f / sqrtf(wave_sum(s) * (1.0f / D) + EPS);
#pragma unroll
        for (int j = 0; j < 4; ++j) *(f32x4*)(xr + 256 * j) = v[j] * rs * wv[j];
    }
}

struct Gdn2 {
    static __device__ __forceinline__ void run(long g, const float* AB, const bf16_t* QKV, const float* state_gdn, const float* a_log, const float* dt_bias,
                        bf16_t* OG, float* out_gp, float* out_gs) {
        using namespace nv;
        const int half = (int)(g & 1); const long col = g >> 1;
        const int dv = (int)(col % DV); const int h = (int)((col / DV) % H); const int sq = (int)(col / (DV * H));
        const int is_s = sq >= BATCH; const int seq = is_s ? sq - BATCH : sq; const int L = is_s ? DS : SEQ;
        const long base = is_s ? MP + (long)seq * DS : (long)seq * SEQ;
        float S[64];
#pragma unroll
        for (int j = 0; j < 64; ++j) S[j] = is_s ? state_gdn[(((long)seq * H + h) * DK + 64 * half + j) * DV + dv] : 0.f;
        const float ea = expf(a_log[h]), dtb = dt_bias[h];
        for (int t = 0; t < L; ++t) {
            const long r = base + t;
            const float a = AB[r * 16 + h], b = AB[r * 16 + 8 + h];
            const float gg = -ea * softplus_f(a + dtb), beta = sigmoid_f(b), alpha = expf(gg);
            const bf16_t* q = QKV + r * CONV + h * DK + 64 * half; const bf16_t* k = QKV + r * CONV + 1024 + h * DK + 64 * half;
            const float v = bf2f(QKV[r * CONV + 2048 + h * DV + dv]);
            float ks = 0.f;
#pragma unroll
            for (int j = 0; j < 64; ++j) ks += bf2f(k[j]) * S[j];
            ks += __shfl_xor(ks, 1);
            const float vn = beta * (v - alpha * ks);
            float o = 0.f;
#pragma unroll
            for (int j = 0; j < 64; ++j) { S[j] = alpha * S[j] + bf2f(k[j]) * vn; o += bf2f(q[j]) * S[j]; }
            o += __shfl_xor(o, 1);
            if (half == 0) OG[r * 1024 + h * DV + dv] = f2bf(o * 0.08838834764831845f);
        }
        float* so = is_s ? out_gs : out_gp;
#pragma unroll
        for (int j = 0; j < 64; ++j) so[(((long)seq * H + h) * DK + 64 * half + j) * DV + dv] = S[j];
    }
};
namespace att {
typedef float f32x16 __attribute__((ext_vector_type(16)));
typedef unsigned u32x2 __attribute__((ext_vector_type(2)));
constexpr int KPB = 144;
constexpr int VPE = 196;
constexpr int NSLOT = 192;
constexpr int K_OFF = 0, V_OFF = NSLOT * KPB, BUF_BYTES = V_OFF + 64 * VPE * 2;
constexpr float LOG2E = 1.4426950408889634f;
__device__ __forceinline__ int crow(int r, int h) { return (r & 3) + 8 * (r >> 2) + 4 * h; }
__device__ __forceinline__ unsigned cvtpk(float lo, float hi) { unsigned r; asm volatile("v_cvt_pk_bf16_f32 %0, %1, %2" : "=v"(r) : "v"(lo), "v"(hi)); return r; }

__device__ __forceinline__ void attn_wave(const LAS unsigned char* Kl, const LAS unsigned char* Vl, const bf16x8 (&qf)[4], int kt0, int kpos0, int qpos, float sink, f32x16 (&o)[2], int lane) {
    const int r32 = lane & 31, h = lane >> 5;
    f32x16 S[5];
#pragma unroll
    for (int j = 0; j < 5; ++j) {
#pragma unroll
        for (int e = 0; e < 16; ++e) S[j][e] = 0.f;
        const LAS unsigned char* kp = Kl + (32 * (kt0 + j) + r32) * KPB + 16 * h;
#pragma unroll
        for (int s = 0; s < 4; ++s) { const bf16x8 a = *(const LAS bf16x8*)(kp + 32 * s); S[j] = __builtin_amdgcn_mfma_f32_32x32x16_bf16(a, qf[s], S[j], 0, 0, 0); }
    }
    const float sink2 = sink * LOG2E; float m = sink2;
    const int rel0 = qpos - kpos0 - 32 * kt0;
#pragma unroll
    for (int j = 0; j < 5; ++j)
#pragma unroll
        for (int e = 0; e < 16; ++e) { const int x = 32 * j + crow(e, h); const int rel = rel0 - x; const bool ok = (rel >= 0) && (rel <= 127) && (kpos0 + 32 * kt0 + x >= 0);
            const float v = ok ? S[j][e] * LOG2E : -INFINITY; S[j][e] = v; m = fmaxf(m, v); }
    m = fmaxf(m, __shfl_xor(m, 32));
    float l = 0.f;
#pragma unroll
    for (int j = 0; j < 5; ++j)
#pragma unroll
        for (int e = 0; e < 16; ++e) { const float p = __builtin_amdgcn_exp2f(S[j][e] - m); S[j][e] = p; l += p; }
    l += __shfl_xor(l, 32); l += __builtin_amdgcn_exp2f(sink2 - m);
    const float il = 1.0f / l;
#pragma unroll
    for (int mt = 0; mt < 2; ++mt) {
#pragma unroll
        for (int e = 0; e < 16; ++e) o[mt][e] = 0.f;
        const LAS unsigned char* vp = Vl + ((32 * mt + r32) * VPE + 32 * kt0 + 4 * h) * 2;
#pragma unroll
        for (int j = 0; j < 5; ++j)
#pragma unroll
            for (int s = 0; s < 2; ++s) {
                const u32x2 lo = *(const LAS u32x2*)(vp + (32 * j + 16 * s) * 2), hi = *(const LAS u32x2*)(vp + (32 * j + 16 * s + 8) * 2);
                v4u av; av.x = lo.x; av.y = lo.y; av.z = hi.x; av.w = hi.y;
                v4u pv; pv.x = cvtpk(S[j][8 * s + 0], S[j][8 * s + 1]); pv.y = cvtpk(S[j][8 * s + 2], S[j][8 * s + 3]); pv.z = cvtpk(S[j][8 * s + 4], S[j][8 * s + 5]); pv.w = cvtpk(S[j][8 * s + 6], S[j][8 * s + 7]);
                o[mt] = __builtin_amdgcn_mfma_f32_32x32x16_bf16(__builtin_bit_cast(bf16x8, av), __builtin_bit_cast(bf16x8, pv), o[mt], 0, 0, 0);
            }
#pragma unroll
        for (int e = 0; e < 16; ++e) o[mt][e] *= il;
    }
}
__device__ __forceinline__ void load_q(bf16x8 (&qf)[4], const bf16_t* qrow, int h) {
#pragma unroll
    for (int s = 0; s < 4; ++s) { const v4u w = *(const v4u*)(qrow + 16 * s + 8 * h); v4u o;
#pragma unroll
        for (int i = 0; i < 4; ++i) { const float a = __builtin_bit_cast(float, w[i] << 16) * 0.125f, b = __builtin_bit_cast(float, w[i] & 0xffff0000u) * 0.125f;
            o[i] = (__builtin_bit_cast(unsigned, a) >> 16) | (__builtin_bit_cast(unsigned, b) & 0xffff0000u); }
        qf[s] = __builtin_bit_cast(bf16x8, o); }
}
__device__ __forceinline__ void store_o(const f32x16 (&o)[2], bf16_t* orow, int h) {
#pragma unroll
    for (int mt = 0; mt < 2; ++mt)
#pragma unroll
        for (int g4 = 0; g4 < 4; ++g4) { u32x2 w; w.x = cvtpk(o[mt][4 * g4 + 0], o[mt][4 * g4 + 1]); w.y = cvtpk(o[mt][4 * g4 + 2], o[mt][4 * g4 + 3]);
            *(u32x2*)(orow + 32 * mt + 8 * g4 + 4 * h) = w; }
}
__device__ __forceinline__ void put_kv(LAS unsigned char* Kl, LAS unsigned char* Vl, int i, int part, v4u kv, v4u vv) {
    *(LAS v4u*)(Kl + i * KPB + part * 16) = kv;
#pragma unroll
    for (int e = 0; e < 8; ++e) { const unsigned short val = (unsigned short)((vv[e >> 1] >> (16 * (e & 1))) & 0xffffu); *(LAS unsigned short*)(Vl + ((part * 8 + e) * VPE + i) * 2) = val; }
}
__device__ __forceinline__ void attn_phase(Frame& F, int wg, int nwg) {
    LAS unsigned char* Kl = F.lds + K_OFF; LAS unsigned char* Vl = F.lds + V_OFF;
    bf16_t* QS = FB(WS_QS); const bf16_t* KS = FB(WS_KS); const bf16_t* VS = FB(WS_VS);
    const int lane = F.lane, r32 = lane & 31, h = lane >> 5, w = F.wave;
    constexpr int NPU = BATCH * KVH * (SEQ / 64), NSU = DB * KVH;
    for (int u = wg; u < NPU + NSU; u += nwg) {
        if (u < NPU) {
            const int b = u / (KVH * (SEQ / 64)), kvh = (u / (SEQ / 64)) % KVH, q0 = (u % (SEQ / 64)) * 64;
            for (int c = F.tid; c < NSLOT * 8; c += NTHREADS) { const int i = c >> 3, part = c & 7, kpos = q0 - 128 + i;
                v4u kv = {0u, 0u, 0u, 0u}, vv = {0u, 0u, 0u, 0u};
                if (kpos >= 0) { const size_t off = ((size_t)b * SEQ + kpos) * 256 + kvh * 64 + part * 8; kv = *(const v4u*)(KS + off); vv = *(const v4u*)(VS + off); }
                put_kv(Kl, Vl, i, part, kv, vv); }
            const int head = kvh * 4 + (w >> 1), hf = w & 1; const size_t row = (size_t)b * SEQ + q0 + 32 * hf + r32;
            bf16x8 qf[4]; load_q(qf, QS + row * 1024 + head * 64, h);
            __syncthreads();
            f32x16 o[2]; attn_wave(Kl, Vl, qf, hf, q0 - 128, q0 + 32 * hf + r32, F.in[I_SINKS][head], o, lane);
            store_o(o, QS + row * 1024 + head * 64, h);
            __syncthreads();
        } else {
            const int su = u - NPU, b = su / KVH, kvh = su % KVH;
            const float* ck = F.in[I_CK]; const float* cv = F.in[I_CV];
            for (int c = F.tid; c < 160 * 8; c += NTHREADS) { const int i = c >> 3, part = c & 7;
                v4u kv = {0u, 0u, 0u, 0u}, vv = {0u, 0u, 0u, 0u};
                if (i < WIN) { const size_t off = (((size_t)b * WIN + i) * KVH + kvh) * HD + part * 8;
                    const f32x4 k0 = *(const f32x4*)(ck + off), k1 = *(const f32x4*)(ck + off + 4), v0 = *(const f32x4*)(cv + off), v1 = *(const f32x4*)(cv + off + 4);
                    kv.x = pk2(k0[0], k0[1]); kv.y = pk2(k0[2], k0[3]); kv.z = pk2(k1[0], k1[1]); kv.w = pk2(k1[2], k1[3]);
                    vv.x = pk2(v0[0], v0[1]); vv.y = pk2(v0[2], v0[3]); vv.z = pk2(v1[0], v1[1]); vv.w = pk2(v1[2], v1[3]); }
                else if (i < WIN + DS) { const size_t off = ((size_t)MP + (size_t)b * DS + (i - WIN)) * 256 + kvh * 64 + part * 8; kv = *(const v4u*)(KS + off); vv = *(const v4u*)(VS + off); }
                put_kv(Kl, Vl, i, part, kv, vv); }
            const int head = kvh * 4 + (r32 >> 3), t = r32 & 7; const size_t row = (size_t)MP + (size_t)b * DS + t;
            bf16x8 qf[4];
            if (w == 0) load_q(qf, QS + row * 1024 + head * 64, h);
            __syncthreads();
            if (w == 0) { f32x16 o[2]; attn_wave(Kl, Vl, qf, 0, PAST - WIN, PAST + t, F.in[I_SINKS][head], o, lane); store_o(o, QS + row * 1024 + head * 64, h); }
            __syncthreads();
        }
    }
}
}
namespace gdn {
typedef unsigned u32x2 __attribute__((ext_vector_type(2)));
constexpr int NCH = SEQ / 64, NU = BATCH * H * NCH;
constexpr size_t WKB = 16384, QKPB = 8192, UVB = 32768;
constexpr int TEAM_LDS = 81920, PK = 272;
constexpr int KB_OFF = 0, QB_OFF = 17408, VB_OFF = 34816, A_OFF = 52224, QKP_OFF = 68608, SM_OFF = 76800;
__device__ __forceinline__ int permpos(int j) { return (j & ~31) + 8 * ((j >> 2) & 3) + 4 * ((j >> 4) & 1) + (j & 3); }
__device__ __forceinline__ float bfl(unsigned w) { return __builtin_bit_cast(float, w << 16); }
__device__ __forceinline__ float bfh(unsigned w) { return __builtin_bit_cast(float, w & 0xffff0000u); }
__device__ __forceinline__ unsigned cvtpk(float lo, float hi) { unsigned r; asm volatile("v_cvt_pk_bf16_f32 %0, %1, %2" : "=v"(r) : "v"(lo), "v"(hi)); return r; }
__device__ __forceinline__ float silu_a(float x) { return x * __builtin_amdgcn_rcpf(1.0f + __builtin_amdgcn_exp2f(-1.4426950408889634f * x)); }

__device__ __forceinline__ void prep_phase(Frame& F) {
    const int team = F.tid >> 8, lt0 = F.tid & 255, tw = lt0 >> 6, lane = F.lane;
    LAS unsigned char* L = F.lds + team * TEAM_LDS;
    LAS float* sm = (LAS float*)(L + SM_OFF);
    LAS float* Am = (LAS float*)(L + A_OFF);
    const int tg = blockIdx.x * 2 + team, ntg = F.G * 2;
    const int rounds = (NU + ntg - 1) / ntg;
#pragma unroll 1
    for (int rd = 0; rd < rounds; ++rd) {
        int lt = lt0; asm volatile("" : "+v"(lt));
        unsigned char* wsb = F.ws; asm volatile("" : "+s"(wsb));
        const float* AB = (const float*)(wsb + lay::WS_AB);
        unsigned char* wkb = wsb + lay::WS_WK; unsigned char* qgb = wsb + lay::WS_QG; unsigned char* kgtb = wsb + lay::WS_KGT; unsigned char* qkpb = wsb + lay::WS_QKP;
        float* uvb = (float*)(wsb + lay::WS_UV); float* glb = (float*)(wsb + lay::WS_GL);
        const int uid = tg + rd * ntg; const bool act = uid < NU;
        const int n = uid % NCH, h = (uid / NCH) % H, b = uid / (NCH * H);
        const size_t r0 = (size_t)b * SEQ + (size_t)n * 64;
        if (act && tw == 0) {
            const float a = AB[(r0 + lane) * 16 + h], bb = AB[(r0 + lane) * 16 + 8 + h];
            const float xg = a + F.in[I_DTB][h]; const float sp = xg > 20.f ? xg : log1pf(expf(xg));
            float v = -expf(F.in[I_ALOG][h]) * sp;
#pragma unroll
            for (int d = 1; d < 64; d <<= 1) { const float t2 = __shfl_up(v, d); if (lane >= d) v += t2; }
            const float gl = __shfl(v, 63);
            sm[lane] = v; sm[64 + lane] = 1.0f / (1.0f + expf(-bb)); sm[128 + lane] = expf(v); sm[192 + lane] = expf(gl - v);
            if (lane == 0) glb[uid] = expf(gl);
        }
        { v4u z = {0u, 0u, 0u, 0u}; *(LAS v4u*)(L + QKP_OFF + lt * 32) = z; *(LAS v4u*)(L + QKP_OFF + lt * 32 + 16) = z; }
        if (act) {
#pragma unroll
            for (int k = 0; k < 12; ++k) { const int id = lt + 256 * k, mat = id >> 10, i = (id >> 4) & 63, part = id & 15;
                const bf16_t* src = (const bf16_t*)(wsb + (mat == 0 ? lay::WS_QN : mat == 1 ? lay::WS_KN : lay::WS_VN));
                const v4u w = *(const v4u*)(src + (r0 + i) * 1024 + h * 128 + part * 8);
                *(LAS v4u*)(L + (mat == 0 ? QB_OFF : mat == 1 ? KB_OFF : VB_OFF) + i * PK + part * 16) = w; }
        }
        __syncthreads();
        if (act) {
            const int c = lane & 15, q = lane >> 4;
#pragma unroll 1
            for (int job = tw; job < 20; job += 4) {
                const int mat = job / 10, tau = job % 10, ti = tau >= 6 ? 3 : tau >= 3 ? 2 : tau >= 1 ? 1 : 0, tj = tau - ti * (ti + 1) / 2;
                const LAS unsigned char* ap = L + (mat == 0 ? KB_OFF : QB_OFF) + (16 * ti + c) * PK + 16 * q; const LAS unsigned char* bp = L + KB_OFF + (16 * tj + c) * PK + 16 * q;
                f32x4 acc = {0.f, 0.f, 0.f, 0.f};
#pragma unroll
                for (int s = 0; s < 4; ++s) acc = __builtin_amdgcn_mfma_f32_16x16x32_bf16(*(const LAS bf16x8*)(ap + 64 * s), *(const LAS bf16x8*)(bp + 64 * s), acc, 0, 0, 0);
                const int j = 16 * tj + c; const float gcj = sm[j];
#pragma unroll
                for (int r = 0; r < 4; ++r) { const int i = 16 * ti + 4 * q + r; const float dec = expf(sm[i] - gcj);
                    if (mat == 0) Am[i * 64 + j] = (i > j) ? acc[r] * sm[64 + i] * dec : 0.f;
                    else *(LAS unsigned short*)(L + QKP_OFF + i * 128 + permpos(j) * 2) = (unsigned short)f2bf_u((i >= j) ? acc[r] * dec : 0.f); }
            }
        }
        __syncthreads();
        float x[64];
        if (act) {
            if (lt < 128) {
#pragma unroll
                for (int i = 0; i < 64; ++i) x[i] = bfl((unsigned)*(const LAS unsigned short*)(L + VB_OFF + i * PK + lt * 2)) * sm[64 + i];
            } else {
#pragma unroll
                for (int i = 0; i < 64; ++i) x[i] = bfl((unsigned)*(const LAS unsigned short*)(L + KB_OFF + i * PK + (lt - 128) * 2)) * sm[64 + i] * sm[128 + i];
            }
#pragma clang loop unroll(full)
            for (int i = 1; i < 64; ++i) {
                float acc = x[i];
#pragma clang loop unroll(full)
                for (int j4 = 0; j4 < 16; ++j4) if (4 * j4 < i) { const f32x4 a = *(const LAS f32x4*)(Am + i * 64 + 4 * j4);
                    acc -= a[0] * x[4 * j4]; if (4 * j4 + 1 < i) acc -= a[1] * x[4 * j4 + 1]; if (4 * j4 + 2 < i) acc -= a[2] * x[4 * j4 + 2]; if (4 * j4 + 3 < i) acc -= a[3] * x[4 * j4 + 3]; }
                x[i] = acc;
            }
        }
        __syncthreads();
        const int lo_ = lt;
        if (act) {
            if (lt < 128) {
                float* up = uvb + (size_t)uid * (UVB / 4) + (size_t)((lo_ >> 4) * 4) * 256 + (lo_ & 15) * 4;
#pragma unroll
                for (int mt = 0; mt < 4; ++mt)
#pragma unroll
                    for (int q = 0; q < 4; ++q) { f32x4 o = {x[16 * mt + 4 * q], x[16 * mt + 4 * q + 1], x[16 * mt + 4 * q + 2], x[16 * mt + 4 * q + 3]}; *(f32x4*)(up + mt * 256 + q * 64) = o; }
            } else {
#pragma unroll
                for (int i = 0; i < 64; ++i) *(LAS unsigned short*)(L + VB_OFF + i * PK + (lo_ - 128) * 2) = (unsigned short)f2bf_u(x[i]);
            }
        }
        __syncthreads();
        if (act) {
#pragma unroll
            for (int k = 0; k < 4; ++k) { const int id = lo_ + 256 * k, i = id >> 4, s = (id >> 2) & 3, q = id & 3;
                { const LAS unsigned char* p = L + VB_OFF + i * PK + (32 * s + 4 * q) * 2; const u32x2 lo = *(const LAS u32x2*)p, hi = *(const LAS u32x2*)(p + 32);
                  v4u o; o.x = lo.x; o.y = lo.y; o.z = hi.x; o.w = hi.y; *(v4u*)(wkb + (size_t)uid * WKB + (size_t)id * 16) = o; }
                { const LAS unsigned char* p = L + QB_OFF + i * PK + (32 * s + 4 * q) * 2; const u32x2 lo = *(const LAS u32x2*)p, hi = *(const LAS u32x2*)(p + 32); const float e = sm[128 + i];
                  v4u o; o.x = cvtpk(bfl(lo.x) * e, bfh(lo.x) * e); o.y = cvtpk(bfl(lo.y) * e, bfh(lo.y) * e); o.z = cvtpk(bfl(hi.x) * e, bfh(hi.x) * e); o.w = cvtpk(bfl(hi.y) * e, bfh(hi.y) * e);
                  *(v4u*)(qgb + (size_t)uid * WKB + (size_t)id * 16) = o; }
            }
#pragma unroll
            for (int k = 0; k < 4; ++k) { const int id = lo_ + 256 * k, dk = id >> 3, s = (id >> 2) & 1, q = id & 3; float v[8];
#pragma unroll
                for (int j = 0; j < 8; ++j) { const int tok = 32 * s + 16 * (j >> 2) + 4 * q + (j & 3); v[j] = bfl((unsigned)*(const LAS unsigned short*)(L + KB_OFF + tok * PK + dk * 2)) * sm[192 + tok]; }
                v4u o; o.x = cvtpk(v[0], v[1]); o.y = cvtpk(v[2], v[3]); o.z = cvtpk(v[4], v[5]); o.w = cvtpk(v[6], v[7]);
                *(v4u*)(kgtb + (size_t)uid * WKB + (size_t)id * 16) = o; }
#pragma unroll
            for (int k = 0; k < 2; ++k) { const int id = lo_ + 256 * k; *(v4u*)(qkpb + (size_t)uid * QKPB + (size_t)id * 16) = *(const LAS v4u*)(L + QKP_OFF + id * 16); }
        }
        __syncthreads();
    }
}

constexpr int SC_WK = 0, SC_QG = 17408, SC_KGT = 34816, SC_QKP = 34816 + 18432, SC_BUF = SC_QKP + 9216;
__device__ __forceinline__ void scan_phase(Frame& F, int blk) {
#define SCBAR() __syncthreads()
    const int lane = F.lane, w = F.wave, c = lane & 15, q = lane >> 4;
    const int bh = blk >> 1, dvh = blk & 1, b = bh / H, h = bh % H, uid0 = bh * NCH;
    const unsigned char* wkb = F.ws + lay::WS_WK; const unsigned char* qgb = F.ws + lay::WS_QG; const unsigned char* kgtb = F.ws + lay::WS_KGT; const unsigned char* qkpb = F.ws + lay::WS_QKP;
    if (w >= 4) {
        const int lt = F.tid - 256;
        v4u sa[14], sb[14];
#define LD_LOAD(dstv, uid) do { _Pragma("unroll") for (int k = 0; k < 14; ++k) { const int g = lt + 256 * k; const unsigned char* src = g < 1024 ? wkb + (size_t)(uid) * WKB + (size_t)g * 16 : g < 2048 ? qgb + (size_t)(uid) * WKB + (size_t)(g - 1024) * 16 \
        : g < 3072 ? kgtb + (size_t)(uid) * WKB + (size_t)(g - 2048) * 16 : qkpb + (size_t)(uid) * QKPB + (size_t)(g - 3072) * 16; dstv[k] = *(const v4u*)src; } } while (0)
#define LD_WRITE(srcv, buf) do { _Pragma("unroll") for (int k = 0; k < 14; ++k) { const int g = lt + 256 * k; int off; \
        if (g < 1024) off = SC_WK + (g >> 4) * PK + (g & 15) * 16; else if (g < 2048) off = SC_QG + ((g - 1024) >> 4) * PK + (g & 15) * 16; \
        else if (g < 3072) off = SC_KGT + ((g - 2048) >> 3) * 144 + (g & 7) * 16; else off = SC_QKP + ((g - 3072) >> 3) * 144 + (g & 7) * 16; \
        *(LAS v4u*)(F.lds + (buf) * SC_BUF + off) = srcv[k]; } } while (0)
        LD_LOAD(sa, uid0); LD_LOAD(sb, uid0 + 1);
        LD_WRITE(sa, 0);
        SCBAR();
        for (int n = 0; n < NCH; n += 2) {
            LD_WRITE(sb, 1); if (n + 2 < NCH) LD_LOAD(sa, uid0 + n + 2);
            SCBAR();
            if (n + 2 < NCH) LD_WRITE(sa, 0);
            if (n + 3 < NCH) LD_LOAD(sb, uid0 + n + 3);
            SCBAR();
        }
#undef LD_LOAD
#undef LD_WRITE
        return;
    }
    const float* uvb = (const float*)(F.ws + lay::WS_UV); const float* glb = (const float*)(F.ws + lay::WS_GL);
    bf16_t* OG = FB(WS_OG);
    const int dvw = 4 * dvh + w;
    f32x4 Sacc[8]; bf16x8 Sb[4];
#pragma unroll
    for (int i = 0; i < 8; ++i) Sacc[i] = (f32x4){0.f, 0.f, 0.f, 0.f};
#pragma unroll
    for (int i = 0; i < 4; ++i) Sb[i] = (bf16x8){0, 0, 0, 0, 0, 0, 0, 0};
    f32x4 un[4]; float gln;
#define UV_LOAD(dstv, dstg, uid) do { _Pragma("unroll") for (int mt = 0; mt < 4; ++mt) dstv[mt] = *(const f32x4*)(uvb + (size_t)(uid) * (UVB / 4) + (size_t)((dvw * 4 + mt) * 64 + lane) * 4); dstg = glb[(uid)]; } while (0)
    UV_LOAD(un, gln, uid0);
    SCBAR();
#define SB_ __builtin_amdgcn_sched_barrier(0)
#define MF_(a_, b_, c_) __builtin_amdgcn_mfma_f32_16x16x32_bf16(a_, b_, c_, 0, 0, 0)
#define LDROWS(dst, off_, pitch_, r0_) do { _Pragma("unroll") for (int i_ = 0; i_ < 2; ++i_) _Pragma("unroll") for (int s_ = 0; s_ < 4; ++s_) dst[4 * i_ + s_] = *(const LAS bf16x8*)(B + (off_) + (16 * ((r0_) + i_) + c) * (pitch_) + 16 * q + 64 * s_); } while (0)
#define LDROWS2(dst, off_, r0_) do { _Pragma("unroll") for (int i_ = 0; i_ < 4; ++i_) _Pragma("unroll") for (int s_ = 0; s_ < 2; ++s_) dst[2 * i_ + s_] = *(const LAS bf16x8*)(B + (off_) + (16 * ((r0_) + i_) + c) * 144 + 16 * q + 64 * s_); } while (0)
#define SC_CHUNK(n_, uc, gl_) do { \
        const LAS unsigned char* B = F.lds + ((n_) & 1) * SC_BUF; \
        bf16x8 fa[8], fb[8]; f32x4 vn[4], o[4]; const f32x4 z4 = {0.f, 0.f, 0.f, 0.f}; \
        LDROWS(fa, SC_WK, PK, 0); LDROWS(fb, SC_WK, PK, 2); SB_; \
        { f32x4 r0 = z4, r1 = z4; _Pragma("unroll") for (int s = 0; s < 4; ++s) { r0 = MF_(fa[s], Sb[s], r0); r1 = MF_(fa[4 + s], Sb[s], r1); } vn[0] = uc[0] - r0; vn[1] = uc[1] - r1; } \
        LDROWS(fa, SC_QG, PK, 0); SB_; \
        { f32x4 r0 = z4, r1 = z4; _Pragma("unroll") for (int s = 0; s < 4; ++s) { r0 = MF_(fb[s], Sb[s], r0); r1 = MF_(fb[4 + s], Sb[s], r1); } vn[2] = uc[2] - r0; vn[3] = uc[3] - r1; } \
        LDROWS(fb, SC_QG, PK, 2); SB_; \
        bf16x8 Vb[2]; \
        _Pragma("unroll") for (int s = 0; s < 2; ++s) { v4u p; p.x = cvtpk(vn[2 * s][0], vn[2 * s][1]); p.y = cvtpk(vn[2 * s][2], vn[2 * s][3]); p.z = cvtpk(vn[2 * s + 1][0], vn[2 * s + 1][1]); p.w = cvtpk(vn[2 * s + 1][2], vn[2 * s + 1][3]); Vb[s] = __builtin_bit_cast(bf16x8, p); } \
        { f32x4 r0 = z4, r1 = z4; _Pragma("unroll") for (int s = 0; s < 4; ++s) { r0 = MF_(fa[s], Sb[s], r0); r1 = MF_(fa[4 + s], Sb[s], r1); } o[0] = r0; o[1] = r1; } \
        LDROWS2(fa, SC_QKP, 0); SB_; \
        { f32x4 r0 = z4, r1 = z4; _Pragma("unroll") for (int s = 0; s < 4; ++s) { r0 = MF_(fb[s], Sb[s], r0); r1 = MF_(fb[4 + s], Sb[s], r1); } o[2] = r0; o[3] = r1; } \
        LDROWS2(fb, SC_KGT, 0); SB_; \
        _Pragma("unroll") for (int mt = 0; mt < 4; ++mt) { o[mt] = MF_(fa[2 * mt], Vb[0], o[mt]); o[mt] = MF_(fa[2 * mt + 1], Vb[1], o[mt]); } \
        LDROWS2(fa, SC_KGT, 4); SB_; \
        _Pragma("unroll") for (int dt = 0; dt < 4; ++dt) { f32x4 a = Sacc[dt] * (gl_); a = MF_(fb[2 * dt], Vb[0], a); a = MF_(fb[2 * dt + 1], Vb[1], a); Sacc[dt] = a; } \
        _Pragma("unroll") for (int mt = 0; mt < 4; ++mt) { bf16_t* op = OG + ((size_t)b * SEQ + (size_t)(n_) * 64 + 16 * mt + 4 * q) * 1024 + h * 128 + 16 * dvw + c; \
            _Pragma("unroll") for (int r = 0; r < 4; ++r) op[(size_t)r * 1024] = (bf16_t)f2bf_u(o[mt][r]); } \
        SB_; \
        _Pragma("unroll") for (int dt = 4; dt < 8; ++dt) { f32x4 a = Sacc[dt] * (gl_); a = MF_(fa[2 * (dt - 4)], Vb[0], a); a = MF_(fa[2 * (dt - 4) + 1], Vb[1], a); Sacc[dt] = a; } \
        _Pragma("unroll") for (int s = 0; s < 4; ++s) { v4u p; p.x = cvtpk(Sacc[2 * s][0], Sacc[2 * s][1]); p.y = cvtpk(Sacc[2 * s][2], Sacc[2 * s][3]); p.z = cvtpk(Sacc[2 * s + 1][0], Sacc[2 * s + 1][1]); p.w = cvtpk(Sacc[2 * s + 1][2], Sacc[2 * s + 1][3]); Sb[s] = __builtin_bit_cast(bf16x8, p); } \
    } while (0)
#pragma unroll 1
    for (int n = 0; n < NCH; ++n) {
        f32x4 u[4]; _Pragma("unroll") for (int mt = 0; mt < 4; ++mt) u[mt] = un[mt]; const float gl = gln;
        if (n + 1 < NCH) UV_LOAD(un, gln, uid0 + n + 1);
        SC_CHUNK(n, u, gl);
        SCBAR();
    }
#undef SC_CHUNK
#undef SCBAR
#undef UV_LOAD
#undef LDROWS
#undef LDROWS2
#undef MF_
#undef SB_
    float* so = F.out + O_GP + ((size_t)(b * H + h) * DK) * DV + 16 * dvw + c;
#pragma unroll
    for (int dt = 0; dt < 8; ++dt)
#pragma unroll
        for (int r = 0; r < 4; ++r) so[(size_t)(16 * dt + 4 * q + r) * DV] = Sacc[dt][r];
}

__device__ __forceinline__ void sample_qkv(Frame& F) {
    const int gw = blockIdx.x * NWAVES + F.wave, NGW = F.G * NWAVES, lane = F.lane;
    const bf16_t* RAW = FB(WS_RAW); bf16_t* QKVS = FB(WS_QKVS); const float* sc = F.in[I_SCONV]; const float* conv_w = F.in[I_CONVW];
    for (int task = gw; task < DB * 24; task += NGW) {
        const int b = task / 24, hm = task % 24, col = hm * 128 + 2 * lane;
        float w0[4], w1[4], e0[3], e1[3];
#pragma unroll
        for (int j = 0; j < 4; ++j) { w0[j] = conv_w[j * CONV + col]; w1[j] = conv_w[j * CONV + col + 1]; }
#pragma unroll
        for (int j = 0; j < 3; ++j) { e0[j] = sc[((size_t)b * 3 + j) * CONV + col]; e1[j] = sc[((size_t)b * 3 + j) * CONV + col + 1]; }
        for (int t = 0; t < DS; ++t) {
            const unsigned rw = *(const unsigned*)(RAW + ((size_t)MP + (size_t)b * DS + t) * CONV + col);
            const float c0 = bfl(rw), c1 = bfh(rw);
            float v0 = silu_a(w0[0] * e0[0] + w0[1] * e0[1] + w0[2] * e0[2] + w0[3] * c0), v1 = silu_a(w1[0] * e1[0] + w1[1] * e1[1] + w1[2] * e1[2] + w1[3] * c1);
            e0[0] = e0[1]; e0[1] = e0[2]; e0[2] = c0; e1[0] = e1[1]; e1[1] = e1[2]; e1[2] = c1;
            if (hm < 16) { const float rs = 1.0f / sqrtf(wave_sum(v0 * v0 + v1 * v1) + EPS); v0 *= rs; v1 *= rs; }
            *(unsigned*)(QKVS + ((size_t)b * DS + t) * CONV + col) = cvtpk(v0, v1);
        }
    }
}
__device__ __forceinline__ void qkvn_pass(Frame& F) {
    const int gw = blockIdx.x * NWAVES + F.wave, NGW = F.G * NWAVES, lane = F.lane;
    const bf16_t* RAW = FB(WS_RAW); const float* conv_w = F.in[I_CONVW];
    for (int task = gw; task < BATCH * 24 * NCH; task += NGW) {
        const int st = task % NCH, hm = (task / NCH) % 24, b = task / (NCH * 24), col = hm * 128 + 2 * lane, mat = hm >> 3;
        bf16_t* dst = (mat == 0 ? FB(WS_QN) : mat == 1 ? FB(WS_KN) : FB(WS_VN)) + (hm & 7) * 128 + 2 * lane;
        float w0[4], w1[4], e0[3], e1[3];
#pragma unroll
        for (int j = 0; j < 4; ++j) { w0[j] = conv_w[j * CONV + col]; w1[j] = conv_w[j * CONV + col + 1]; }
        const size_t rb = (size_t)b * SEQ; const int t0 = st * 64;
#pragma unroll
        for (int j = 0; j < 3; ++j) { const int t = t0 - 3 + j; unsigned rw = 0u; if (t >= 0) rw = *(const unsigned*)(RAW + (rb + t) * CONV + col); e0[j] = bfl(rw); e1[j] = bfh(rw); }
#pragma unroll 1
        for (int tb = t0; tb < t0 + 64; tb += 8) {
            unsigned rw[8]; float v0[8], v1[8], ss[8];
#pragma unroll
            for (int i = 0; i < 8; ++i) rw[i] = *(const unsigned*)(RAW + (rb + tb + i) * CONV + col);
#pragma unroll
            for (int i = 0; i < 8; ++i) { const float c0 = bfl(rw[i]), c1 = bfh(rw[i]);
                v0[i] = silu_a(w0[0] * e0[0] + w0[1] * e0[1] + w0[2] * e0[2] + w0[3] * c0); v1[i] = silu_a(w1[0] * e1[0] + w1[1] * e1[1] + w1[2] * e1[2] + w1[3] * c1);
                e0[0] = e0[1]; e0[1] = e0[2]; e0[2] = c0; e1[0] = e1[1]; e1[1] = e1[2]; e1[2] = c1; ss[i] = v0[i] * v0[i] + v1[i] * v1[i]; }
            if (mat < 2) {
#pragma unroll
                for (int d = 1; d < 64; d <<= 1)
#pragma unroll
                    for (int i = 0; i < 8; ++i) ss[i] += __shfl_xor(ss[i], d);
#pragma unroll
                for (int i = 0; i < 8; ++i) { float rs = 1.0f / sqrtf(ss[i] + EPS); if (mat == 0) rs *= 0.08838834764831845f; v0[i] *= rs; v1[i] *= rs; }
            }
#pragma unroll
            for (int i = 0; i < 8; ++i) *(unsigned*)(dst + (rb + tb + i) * 1024) = cvtpk(v0[i], v1[i]);
        }
    }
}
__device__ __forceinline__ void merge_phase(Frame& F) {
    const int gw = blockIdx.x * NWAVES + F.wave, NGW = F.G * NWAVES, lane = F.lane;
    const bf16_t* OGp = FB(WS_OG); const bf16_t* OSp = FB(WS_OS); const bf16_t* Zp = FB(WS_Z); bf16_t* GAp = FB(WS_GA); const bf16_t* GBp = FB(WS_GB);
    float gn[16];
#pragma unroll
    for (int i = 0; i < 4; ++i) { const f32x4 v = *(const f32x4*)(F.in[I_GNORM] + (lane & 7) * 16 + 4 * i); gn[4 * i] = v[0]; gn[4 * i + 1] = v[1]; gn[4 * i + 2] = v[2]; gn[4 * i + 3] = v[3]; }
    for (int m = gw; m < M; m += NGW) {
        const size_t off = (size_t)m * 1024 + 16 * lane;
        v4u og[2], os[2], z[2], ga[2], gb[2];
#pragma unroll
        for (int k = 0; k < 2; ++k) { og[k] = *(const v4u*)(OGp + off + 8 * k); os[k] = *(const v4u*)(OSp + off + 8 * k); z[k] = *(const v4u*)(Zp + off + 8 * k); ga[k] = *(const v4u*)(GAp + off + 8 * k); gb[k] = *(const v4u*)(GBp + off + 8 * k); }
        float o[16]; float ss = 0.f;
#pragma unroll
        for (int k = 0; k < 2; ++k)
#pragma unroll
            for (int e = 0; e < 4; ++e) { o[8 * k + 2 * e] = bfl(og[k][e]); o[8 * k + 2 * e + 1] = bfh(og[k][e]); }
#pragma unroll
        for (int e = 0; e < 16; ++e) ss += o[e] * o[e];
        ss += __shfl_xor(ss, 1); ss += __shfl_xor(ss, 2); ss += __shfl_xor(ss, 4);
        const float rs = 1.0f / sqrtf(ss * (1.0f / 128.0f) + EPS);
        v4u out[2];
#pragma unroll
        for (int k = 0; k < 2; ++k)
#pragma unroll
            for (int e = 0; e < 4; ++e) {
                const float r0 = pg8::fast_sigmoid(bfl(ga[k][e])) * (o[8 * k + 2 * e] * rs * gn[8 * k + 2 * e] * pg8::fast_silu(bfl(z[k][e]))) + pg8::fast_sigmoid(bfl(gb[k][e])) * bfl(os[k][e]);
                const float r1 = pg8::fast_sigmoid(bfh(ga[k][e])) * (o[8 * k + 2 * e + 1] * rs * gn[8 * k + 2 * e + 1] * pg8::fast_silu(bfh(z[k][e]))) + pg8::fast_sigmoid(bfh(gb[k][e])) * bfh(os[k][e]);
                out[k][e] = cvtpk(r0, r1); }
#pragma unroll
        for (int k = 0; k < 2; ++k) *(v4u*)(GAp + off + 8 * k) = out[k];
    }
}
__device__ __forceinline__ void sample_gdn(Frame& F, int wg, int nwg) {
    const int team = F.tid >> 8, lt = F.tid & 255, dv = lt >> 1, half = lt & 1;
    LAS float* T = (LAS float*)(F.lds + team * 16384);
    const bf16_t* QKVS = FB(WS_QKVS); const float* AB = FF32(WS_AB); bf16_t* OG = FB(WS_OG);
    constexpr int NPAIR = DB * H / 2;
    for (int pr = wg; pr < NPAIR; pr += nwg) {
        const int unit = 2 * pr + team, b = unit / H, h = unit % H;
#pragma unroll
        for (int k = 0; k < 12; ++k) { const int id = lt + 256 * k, mat = id >> 10, t = (id >> 7) & 7, j = id & 127;
            const float v = bfl((unsigned)QKVS[((size_t)b * DS + t) * CONV + (mat == 0 ? 1024 : mat == 1 ? 0 : 2048) + h * 128 + j]);
            T[mat * 1024 + t * 128 + j] = mat == 1 ? v * 0.08838834764831845f : v; }
        if (lt < DS) { const size_t r = (size_t)MP + (size_t)b * DS + lt; const float a = AB[r * 16 + h], bb = AB[r * 16 + 8 + h];
            const float xg = a + F.in[I_DTB][h]; const float sp = xg > 20.f ? xg : log1pf(expf(xg));
            T[3072 + lt] = expf(-expf(F.in[I_ALOG][h]) * sp); T[3080 + lt] = 1.0f / (1.0f + expf(-bb)); }
        float S[64];
        const float* sp0 = F.in[I_SGDN] + (((size_t)b * H + h) * DK + 64 * half) * DV + dv;
#pragma unroll
        for (int j = 0; j < 64; ++j) S[j] = sp0[(size_t)j * DV];
        __syncthreads();
#pragma unroll 1
        for (int t = 0; t < DS; ++t) {
            const LAS float* kp = T + t * 128 + 64 * half; const LAS float* qp = T + 1024 + t * 128 + 64 * half;
            const float alpha = T[3072 + t], beta = T[3080 + t], v = T[2048 + t * 128 + dv];
            float ks = 0.f;
#pragma unroll
            for (int j4 = 0; j4 < 16; ++j4) { const f32x4 k4 = *(const LAS f32x4*)(kp + 4 * j4); ks += k4[0] * S[4 * j4] + k4[1] * S[4 * j4 + 1] + k4[2] * S[4 * j4 + 2] + k4[3] * S[4 * j4 + 3]; }
            ks += __shfl_xor(ks, 1);
            const float vn = beta * (v - alpha * ks);
            float o = 0.f;
#pragma unroll
            for (int j4 = 0; j4 < 16; ++j4) { const f32x4 k4 = *(const LAS f32x4*)(kp + 4 * j4), q4 = *(const LAS f32x4*)(qp + 4 * j4);
#pragma unroll
                for (int e = 0; e < 4; ++e) { S[4 * j4 + e] = alpha * S[4 * j4 + e] + k4[e] * vn; o += q4[e] * S[4 * j4 + e]; } }
            o += __shfl_xor(o, 1);
            if (half == 0) OG[((size_t)MP + (size_t)b * DS + t) * 1024 + h * DV + dv] = (bf16_t)f2bf_u(o);
        }
        float* so = F.out + O_GS + (((size_t)b * H + h) * DK + 64 * half) * DV + dv;
#pragma unroll
        for (int j = 0; j < 64; ++j) so[(size_t)j * DV] = S[j];
        __syncthreads();
    }
}
__device__ __forceinline__ void outkv_vec(Frame& F, int wg, int nwg) {
    const bf16_t* KS = FB(WS_KS); const bf16_t* VS = FB(WS_VS); const float* ck = F.in[I_CK]; const float* cv = F.in[I_CV];
    const long n = (long)(BATCH + DB) * WIN * 64;
    for (long g = (long)wg * NTHREADS + F.tid; g < n; g += (long)nwg * NTHREADS) {
        const int c4 = (int)(g & 63) * 4, j = (int)((g >> 6) & (WIN - 1)), sq = (int)(g >> 13);
        f32x4 kv, vv; float *ko, *vo;
        if (sq < BATCH) { const size_t r = (size_t)sq * SEQ + SEQ - WIN + j; const u32x2 a = *(const u32x2*)(KS + r * 256 + c4), bq = *(const u32x2*)(VS + r * 256 + c4);
            kv = (f32x4){bfl(a.x), bfh(a.x), bfl(a.y), bfh(a.y)}; vv = (f32x4){bfl(bq.x), bfh(bq.x), bfl(bq.y), bfh(bq.y)};
            ko = F.out + O_KP + ((size_t)sq * WIN + j) * 256 + c4; vo = F.out + O_VP + ((size_t)sq * WIN + j) * 256 + c4; }
        else { const int b = sq - BATCH;
            if (j + DS < WIN) { kv = *(const f32x4*)(ck + ((size_t)b * WIN + j + DS) * 256 + c4); vv = *(const f32x4*)(cv + ((size_t)b * WIN + j + DS) * 256 + c4); }
            else { const size_t r = (size_t)MP + (size_t)b * DS + (j + DS - WIN); const u32x2 a = *(const u32x2*)(KS + r * 256 + c4), bq = *(const u32x2*)(VS + r * 256 + c4);
                kv = (f32x4){bfl(a.x), bfh(a.x), bfl(a.y), bfh(a.y)}; vv = (f32x4){bfl(bq.x), bfh(bq.x), bfl(bq.y), bfh(bq.y)}; }
            ko = F.out + O_KS + ((size_t)b * WIN + j) * 256 + c4; vo = F.out + O_VS + ((size_t)b * WIN + j) * 256 + c4; }
        *(f32x4*)ko = kv; *(f32x4*)vo = vv;
    }
}
__device__ __forceinline__ void rope_pass(Frame& F) {
    bf16_t* QS = FB(WS_QS); bf16_t* KS = FB(WS_KS);
    for (long g = (long)blockIdx.x * NTHREADS + F.tid; g < (long)M * 8; g += (long)F.G * NTHREADS) {
        const int i = (int)(g & 7); const long r = g >> 3;
        const int t = r < MP ? (int)(r % SEQ) : PAST + (int)((r - MP) % DS);
        const float ang = (float)t * powf(500000.0f, -(float)(2 * i) / 16.0f); const float cs = cosf(ang), sn = sinf(ang);
#pragma unroll 4
        for (int hh = 0; hh < 20; ++hh) { bf16_t* p = hh < 16 ? QS + r * 1024 + hh * 64 : KS + r * 256 + (hh - 16) * 64;
            const float x1 = bfl((unsigned)p[i]), x2 = bfl((unsigned)p[i + 8]);
            p[i] = (bf16_t)f2bf_u(x1 * cs - x2 * sn); p[i + 8] = (bf16_t)f2bf_u(x2 * cs + x1 * sn); }
    }
}
}
template <class K, class... A> __device__ __forceinline__ void run_items(long n, A... a) {
    for (long g = (long)blockIdx.x * NTHREADS + threadIdx.x; g < n; g += (long)gridDim.x * NTHREADS) K::run(g, a...);
}

template <class K, class... A> __device__ __forceinline__ void run_items_sub(long lo, long hi, int wg, int nwg, A... a) {
    for (long g = lo + (long)wg * NTHREADS + threadIdx.x; g < hi; g += (long)nwg * NTHREADS) K::run(g, a...);
}

__global__ void __launch_bounds__(NTHREADS, 2) mega_fwd(MArgs args) {
    extern __shared__ __attribute__((aligned(16))) unsigned char lds_raw[];
    Frame F;
    F.lds = (LAS unsigned char*)lds_raw; F.tid = threadIdx.x; F.lane = F.tid & 63; F.wave = __builtin_amdgcn_readfirstlane(F.tid >> 6); F.G = gridDim.x;
    F.in = args.in; F.out = args.out; F.ws = args.ws;
    const int lo = args.ph_lo, hi = args.ph_hi;
    if (F.tid < 16) ((LAS unsigned*)(F.lds + XB_LDS_OFF))[F.tid] = 0u;
    __syncthreads();
    XcdBarrier bar = xcd_barrier_post((unsigned*)(F.ws + lay::WS_CTL), (volatile LAS unsigned*)(F.lds + XB_LDS_OFF));
#define IN(k) (lo <= (k) && (k) < hi)
#ifndef MK_PROBE
#define MK_PROBE (-1)
#endif
#if MK_PROBE >= 0
    unsigned long long ts_prev = __builtin_amdgcn_s_memrealtime(), ts_dt = 0ull;
#define SEAM(k) do { if (IN(k) && IN((k) + 1)) { if ((k) == P_PRO) cg::this_grid().sync(); else xcd_barrier(bar); } { const unsigned long long t_ = __builtin_amdgcn_s_memrealtime(); if ((k) == MK_PROBE) ts_dt = t_ - ts_prev; ts_prev = t_; } } while (0)
#else
#define SEAM(k) do { if (IN(k) && IN((k) + 1)) { if ((k) == P_PRO) cg::this_grid().sync(); else xcd_barrier(bar); } } while (0)
#endif
    typedef pg8::StaticOrder SO;
    if (IN(P_PRO)) { p0_prologue(F, 0, blockIdx.x * NWAVES + F.wave, F.G * NWAVES); } SEAM(P_PRO);
    if (IN(P_FFN1A)) {
        pg8::Gemm g{FB(WS_XN1), FB(WS_W1IN), M, 2 * FF, D}; SO S; S.init(M, 2 * FF, F.G, (int)blockIdx.x);
        pg8::EpiSwiglu E{FB(WS_HB), FF, nullptr};
        pg8::gemm_phase<pg8::EpiSwiglu, SO, true, true>(F.lds, g, S, E);
    } SEAM(P_FFN1A);
    if (IN(P_FFN1B)) {
        pg8::Gemm g{FB(WS_HB), FB(WS_W1OUT), M, D, FF}; SO S; S.init(M, D, F.G, (int)blockIdx.x);
        pg8::EpiResid E{F.in[I_XP], F.in[I_XS], MP, 0.5f, FF32(WS_X1), FB(WS_X1B), FF32(WS_SSQ1)};
        pg8::gemm_phase<pg8::EpiResid, SO, true, true>(F.lds, g, S, E);
        { const int nsec = (M / 256) * (D / 256) - F.G; if (nsec >= 0 && (int)blockIdx.x >= nsec) { __syncthreads(); p0_prologue(F, 1, ((int)blockIdx.x - nsec) * NWAVES + F.wave, (F.G - nsec) * NWAVES); } }
    } SEAM(P_FFN1B);
    if (IN(P_INPROJ)) {
        ab_tiles(F);
        pg8::Gemm g{FB(WS_X1B), FB(WS_WIN), M, 7680, D}; SO S; S.init(M, 7680, F.G, (int)blockIdx.x);
        pg8::EpiInProj E{FB(WS_RAW), FB(WS_Z), FB(WS_QS), FB(WS_KS), FB(WS_VS), FB(WS_GA), FB(WS_GB), FF32(WS_SSQ1)};
        pg8::gemm_phase<pg8::EpiInProj, SO, true, true>(F.lds, g, S, E);
    } SEAM(P_INPROJ);
#if MK_EMBED_NB
    if (IN(P_PREP)) {
        run_items<nv::OutConv>((long)(BATCH + DB) * 3 * CONV, (const bf16_t*)FB(WS_RAW), F.out + O_CP, F.out + O_CS);
        gdn::rope_pass(F);
        gdn::sample_qkv(F);
        gdn::qkvn_pass(F);
        xcd_barrier(bar);
#if MK_PROBE == 40 || MK_PROBE == 41
        { const unsigned long long t_ = __builtin_amdgcn_s_memrealtime(); if (MK_PROBE == 40) ts_dt = t_ - ts_prev; ts_prev = t_; }
#endif
        gdn::prep_phase(F);
#if MK_PROBE == 41
        cg::this_grid().sync();
        { const unsigned long long t_ = __builtin_amdgcn_s_memrealtime(); ts_dt = t_ - ts_prev; ts_prev = t_; }
#endif
    } SEAM(P_PREP);
    if (IN(P_MIXER)) {
        constexpr int NSCAN = BATCH * H * 2;
        if ((int)blockIdx.x < NSCAN) gdn::scan_phase(F, (int)blockIdx.x);
        else {
            const int wg = (int)blockIdx.x - NSCAN, nwg = F.G - NSCAN;
            gdn::outkv_vec(F, wg, nwg);
            gdn::sample_gdn(F, wg, nwg);
            att::attn_phase(F, wg, nwg);
        }
    } SEAM(P_MIXER);
    if (IN(P_MERGE)) {
        gdn::merge_phase(F);
    } SEAM(P_MERGE);
#endif
    if (IN(P_OUTPROJ)) {
        pg8::Gemm g{FB(WS_MIXED), FB(WS_WOUT), M, D, D}; SO S; S.init(M, D, F.G, (int)blockIdx.x);
        pg8::EpiResid E{FF32(WS_X1), FF32(WS_X1), M, 1.0f, FF32(WS_X1), FB(WS_X2B), FF32(WS_SSQ2)};
        pg8::gemm_phase<pg8::EpiResid, SO, true, true>(F.lds, g, S, E);
    } SEAM(P_OUTPROJ);
    if (IN(P_FFN2A)) {
        pg8::Gemm g{FB(WS_X2B), FB(WS_W2IN), M, 2 * FF, D}; SO S; S.init(M, 2 * FF, F.G, (int)blockIdx.x);
        pg8::EpiSwiglu E{FB(WS_HB), FF, FF32(WS_SSQ2)};
        pg8::gemm_phase<pg8::EpiSwiglu, SO, true, true>(F.lds, g, S, E);
    } SEAM(P_FFN2A);
    if (IN(P_FFN2B)) {
        pg8::Gemm g{FB(WS_HB), FB(WS_W2OUT), M, D, FF}; SO S; S.init(M, D, F.G, (int)blockIdx.x);
        pg8::EpiResid E{FF32(WS_X1), FF32(WS_X1), M, 0.5f, F.out + O_YP, nullptr, FF32(WS_SSQ3)};
        pg8::gemm_phase<pg8::EpiResid, SO, true, true>(F.lds, g, S, E);
    } SEAM(P_FFN2B);
    if (IN(P_FINAL)) { final_norm(F); }
#if MK_PROBE >= 0
    { const unsigned long long t_ = __builtin_amdgcn_s_memrealtime(); if (MK_PROBE == P_FINAL) ts_dt = t_ - ts_prev;
      if (blockIdx.x == 0 && threadIdx.x == 0) F.out[0] += (float)ts_dt * (1.0f / 500.0f); }
#endif
#undef IN
#undef SEAM
}

static int g_grid = 0;
static bool mega_setup() {
    if (g_grid != 0) return g_grid > 0;
    int dev = 0, cus = 0, per_cu = 0;
    if (hipGetDevice(&dev) != hipSuccess || hipDeviceGetAttribute(&cus, hipDeviceAttributeMultiprocessorCount, dev) != hipSuccess) { g_grid = -1; return false; }
    if (hipFuncSetAttribute((const void*)mega_fwd, hipFuncAttributeMaxDynamicSharedMemorySize, LDS_BYTES) != hipSuccess) { fprintf(stderr, "mega: hipFuncSetAttribute failed\n"); g_grid = -1; return false; }
    if (hipOccupancyMaxActiveBlocksPerMultiprocessor(&per_cu, (const void*)mega_fwd, NTHREADS, LDS_BYTES) != hipSuccess || per_cu < 1) { fprintf(stderr, "mega: occupancy query says %d blocks per CU\n", per_cu); g_grid = -1; return false; }
    g_grid = cus;
    return true;
}
static void mega_launch(void* const* d_in, void* d_out, void* d_ws, int ph_lo, int ph_hi, hipStream_t stream) {
    if (!mega_setup()) return;
    MArgs a{};
    for (int i = 0; i < 21; ++i) a.in[i] = (const float*)d_in[i];
    a.out = (float*)d_out; a.ws = (unsigned char*)d_ws; a.ph_lo = ph_lo; a.ph_hi = ph_hi;
    (void)hipMemsetAsync((char*)d_ws + lay::WS_CTL, 0, XCD_BAR_WORDS * 4, stream);
    void* kargs[] = {&a};
    const hipError_t e = hipLaunchCooperativeKernel((const void*)mega_fwd, dim3(g_grid), dim3(NTHREADS), kargs, LDS_BYTES, stream);
    if (e != hipSuccess) fprintf(stderr, "mega: cooperative launch failed: %s (grid %d)\n", hipGetErrorString(e), g_grid);
}
}
#endif
#ifdef CPU_EMU
typedef int hipStream_t;
#endif

struct Ptrs {
    const float *x_prompt, *x_sample, *state_conv, *state_gdn, *cache_k, *cache_v, *norm_ffn1, *w_ffn1_in, *w_ffn1_out, *norm_mix, *w_in, *conv_w,
                *a_log, *dt_bias, *gdn_norm, *sinks, *w_out, *norm_ffn2, *w_ffn2_in, *w_ffn2_out, *norm_final;
    float* out; unsigned char* ws;
};
static Ptrs make_ptrs(void* const* d_in, void* d_out, void* d_ws) {
    Ptrs p;
    p.x_prompt = (const float*)d_in[0]; p.x_sample = (const float*)d_in[1]; p.state_conv = (const float*)d_in[2]; p.state_gdn = (const float*)d_in[3];
    p.cache_k = (const float*)d_in[4]; p.cache_v = (const float*)d_in[5]; p.norm_ffn1 = (const float*)d_in[6]; p.w_ffn1_in = (const float*)d_in[7];
    p.w_ffn1_out = (const float*)d_in[8]; p.norm_mix = (const float*)d_in[9]; p.w_in = (const float*)d_in[10]; p.conv_w = (const float*)d_in[11];
    p.a_log = (const float*)d_in[12]; p.dt_bias = (const float*)d_in[13]; p.gdn_norm = (const float*)d_in[14]; p.sinks = (const float*)d_in[15];
    p.w_out = (const float*)d_in[16]; p.norm_ffn2 = (const float*)d_in[17]; p.w_ffn2_in = (const float*)d_in[18]; p.w_ffn2_out = (const float*)d_in[19];
    p.norm_final = (const float*)d_in[20]; p.out = (float*)d_out; p.ws = (unsigned char*)d_ws; return p;
}
#define WSB(off) ((bf16_t*)(p.ws + lay::off))
#define WSF(off) ((float*)(p.ws + lay::off))

static void nb_ffn1(const Ptrs& p, hipStream_t stream) {
    using namespace cfg; using namespace nv;
    NV_LAUNCH(RmsnormIn, M, p.x_prompt, p.x_sample, p.norm_ffn1, WSB(WS_XN1));
    NV_LAUNCH(GemmSwiglu, (long)(M / 4) * (FF / 4), (const bf16_t*)WSB(WS_XN1), p.w_ffn1_in, WSB(WS_HB), D);
    NV_LAUNCH(Gemm<float>, (long)(M / 4) * (D / 4), (const bf16_t*)WSB(WS_HB), FF, p.w_ffn1_out, D, WSF(WS_T1), D, D, FF);
    NV_LAUNCH(AxpyIn, (long)M * D, p.x_prompt, p.x_sample, (const float*)WSF(WS_T1), 0.5f, WSF(WS_X1));
}
static void nb_inproj(const Ptrs& p, hipStream_t stream) {
    using namespace cfg; using namespace nv;
    NV_LAUNCH(Rmsnorm<bf16_t>, M, (const float*)WSF(WS_X1), p.norm_mix, WSB(WS_X1B));
    const bf16_t* A = WSB(WS_X1B);
    NV_LAUNCH(Gemm<bf16_t>, (long)(M / 4) * (CONV / 4), A, D, p.w_in + U_RAW, DIN, WSB(WS_RAW), CONV, CONV, D);
    NV_LAUNCH(Gemm<bf16_t>, (long)(M / 4) * (1024 / 4), A, D, p.w_in + U_Z, DIN, WSB(WS_Z), 1024, 1024, D);
    NV_LAUNCH(Gemm<float>, (long)(M / 4) * (16 / 4), A, D, p.w_in + U_A, DIN, WSF(WS_AB), 16, 16, D);
    NV_LAUNCH(Gemm<bf16_t>, (long)(M / 4) * (1024 / 4), A, D, p.w_in + U_QS, DIN, WSB(WS_QS), 1024, 1024, D);
    NV_LAUNCH(Gemm<bf16_t>, (long)(M / 4) * (256 / 4), A, D, p.w_in + U_KS, DIN, WSB(WS_KS), 256, 256, D);
    NV_LAUNCH(Gemm<bf16_t>, (long)(M / 4) * (256 / 4), A, D, p.w_in + U_VS, DIN, WSB(WS_VS), 256, 256, D);
    NV_LAUNCH(Gemm<bf16_t>, (long)(M / 4) * (1024 / 4), A, D, p.w_in + U_GA, DIN, WSB(WS_GA), 1024, 1024, D);
    NV_LAUNCH(Gemm<bf16_t>, (long)(M / 4) * (1024 / 4), A, D, p.w_in + U_GB, DIN, WSB(WS_GB), 1024, 1024, D);
}
static void nb_mixer(const Ptrs& p, hipStream_t stream) {
    using namespace cfg; using namespace nv;
    float* out = p.out;
    NV_LAUNCH(OutConv, (long)(BATCH + DB) * 3 * CONV, (const bf16_t*)WSB(WS_RAW), out + O_CP, out + O_CS);
    NV_LAUNCH(ConvInPlace, (long)(BATCH + DB) * CONV, WSB(WS_RAW), p.state_conv, p.conv_w);
    NV_LAUNCH(L2norm, (long)M * 16, WSB(WS_RAW));
    NV_LAUNCH(Gdn, (long)(BATCH + DB) * H * DV, (const float*)WSF(WS_AB), (const bf16_t*)WSB(WS_RAW), p.state_gdn, p.a_log, p.dt_bias, WSB(WS_OG), out + O_GP, out + O_GS);
    NV_LAUNCH(Rope, (long)M * 160, WSB(WS_QS), WSB(WS_KS));
    NV_LAUNCH(OutKV, (long)(BATCH + DB) * WIN * 256, (const bf16_t*)WSB(WS_KS), (const bf16_t*)WSB(WS_VS), p.cache_k, p.cache_v, out + O_KP, out + O_KS, out + O_VP, out + O_VS);
    NV_LAUNCH(SwaPrompt, (long)MP * QH, WSB(WS_QS), (const bf16_t*)WSB(WS_KS), (const bf16_t*)WSB(WS_VS), p.sinks);
    NV_LAUNCH(SwaSample, (long)MS * QH, WSB(WS_QS), (const bf16_t*)WSB(WS_KS), (const bf16_t*)WSB(WS_VS), p.cache_k, p.cache_v, p.sinks);
    NV_LAUNCH(Mix, (long)M * H, (const bf16_t*)WSB(WS_Z), WSB(WS_GA), (const bf16_t*)WSB(WS_GB), (const bf16_t*)WSB(WS_OG), (const bf16_t*)WSB(WS_OS), p.gdn_norm);
}
static void nb_tail(const Ptrs& p, hipStream_t stream) {
    using namespace cfg; using namespace nv;
    NV_LAUNCH(Gemm<float>, (long)(M / 4) * (D / 4), (const bf16_t*)WSB(WS_MIXED), 1024, p.w_out, D, WSF(WS_T1), D, D, 1024);
    NV_LAUNCH(Axpy, (long)M * D, (const float*)WSF(WS_X1), (const float*)WSF(WS_T1), 1.0f, WSF(WS_X1));
    NV_LAUNCH(Rmsnorm<bf16_t>, M, (const float*)WSF(WS_X1), p.norm_ffn2, WSB(WS_X2B));
    NV_LAUNCH(GemmSwiglu, (long)(M / 4) * (FF / 4), (const bf16_t*)WSB(WS_X2B), p.w_ffn2_in, WSB(WS_HB), D);
    NV_LAUNCH(Gemm<float>, (long)(M / 4) * (D / 4), (const bf16_t*)WSB(WS_HB), FF, p.w_ffn2_out, D, WSF(WS_T1), D, D, FF);
    NV_LAUNCH(Axpy, (long)M * D, (const float*)WSF(WS_X1), (const float*)WSF(WS_T1), 0.5f, WSF(WS_X1));
    NV_LAUNCH(Rmsnorm<float>, M, (const float*)WSF(WS_X1), p.norm_final, p.out + O_YP);
}
extern "C" void kernel_launch(void* const* d_in, const int* in_sizes, int n_in, void* d_out, int out_size, void* d_ws, size_t ws_size, hipStream_t stream) {
    (void)in_sizes; (void)n_in; (void)out_size;
    if (ws_size < lay::WS_END) return;
#ifndef CPU_EMU
    mk::mega_launch(d_in, d_out, d_ws, mk::P_PRO, mk::P_COUNT, stream);
#else
    const Ptrs p = make_ptrs(d_in, d_out, d_ws);
    nb_ffn1(p, stream); nb_inproj(p, stream); nb_mixer(p, stream); nb_tail(p, stream);
#endif
}
```
